# Optimizing an MI355X kernel written in HIP

```python
import jax, jax.numpy as jnp
from jax import lax
import numpy as np

D_MODEL = 1024
BATCH = 4
SEQ = 8192
DEPTH = 2

NORM_EPS = 1e-6
GN_EPS = 1e-5
NEG_INF = -1e30

GLA_HEADS = 4
GLA_DK = 128
GLA_DV = 256
GLA_GATE_RANK = 16
GLA_TAU = 16.0
GLA_CHUNK = 64

DIL_HEADS = 8
DIL_HD = 64
DIL_PATTERNS = ((128, 1), (512, 4), (2048, 16))
DIL_BLOCK = 128

RET_HEADS = 4
RET_DK = 256
RET_DV = 512
RET_CHUNK = 128

FFN_DENSE = 2816
N_EXPERTS = 8
TOP_K = 2
FFN_EXPERT = 3584
MOE_BLOCK = 256

EVEN_COLS = (GLA_HEADS * GLA_DK, GLA_HEADS * GLA_DK, GLA_HEADS * GLA_DV, GLA_HEADS * GLA_DV,
             GLA_GATE_RANK, DIL_HEADS * DIL_HD, DIL_HEADS * DIL_HD, DIL_HEADS * DIL_HD)
EVEN_IN = sum(EVEN_COLS)
EVEN_MIX = GLA_HEADS * GLA_DV + DIL_HEADS * DIL_HD
ODD_COLS = (RET_HEADS * RET_DK, RET_HEADS * RET_DK, RET_HEADS * RET_DV, RET_HEADS * RET_DV)
ODD_IN = sum(ODD_COLS)
ODD_MIX = RET_HEADS * RET_DV
N_EVEN = (DEPTH + 1) // 2
N_ODD = DEPTH // 2

kernel_name = 'hybrid_gla_dilated_retention_moe'


def rms_norm(x, w):
    xf = x.astype(jnp.float32)
    return xf * lax.rsqrt(jnp.mean(xf * xf, axis=-1, keepdims=True) + NORM_EPS) * w.astype(jnp.float32)


def split_cols(h, cols):
    return jnp.split(h, [int(c) for c in np.cumsum(cols)[:-1]], axis=-1)


def to_chunks(t, n_heads, d, chunk):
    b, s, _ = t.shape
    return t.astype(jnp.float32).reshape(b, s // chunk, chunk, n_heads, d).transpose(0, 3, 1, 2, 4)


def from_chunks(t):
    b, h, n, c, d = t.shape
    return t.transpose(0, 2, 3, 1, 4).reshape(b, n * c, h, d)


def swiglu(x, w_gate, w_up, w_down):
    return (jax.nn.silu(x @ w_gate) * (x @ w_up)) @ w_down


def gla_mixer(q, k, v, r, gate_lr, w_gate_up, b_gate, out_norm):
    bsz, s, _ = q.shape
    h, dk, dv, c = GLA_HEADS, GLA_DK, GLA_DV, GLA_CHUNK
    log_a = jax.nn.log_sigmoid((gate_lr @ w_gate_up + b_gate).astype(jnp.float32)) / GLA_TAU
    qh = to_chunks(q, h, dk, c) * dk ** -0.5
    kh = to_chunks(k, h, dk, c)
    vh = to_chunks(v, h, dv, c)
    cum = jnp.cumsum(to_chunks(log_a, h, dk, c), axis=3)
    total = cum[:, :, :, -1]
    q_dec = qh * jnp.exp(cum)
    k_inv = kh * jnp.exp(-cum)
    k_end = kh * jnp.exp(total[:, :, :, None] - cum)
    causal = jnp.tril(jnp.ones((c, c), dtype=bool))
    att = jnp.where(causal, jnp.einsum('bhnik,bhnjk->bhnij', q_dec, k_inv), 0.0)
    o_intra = jnp.einsum('bhnij,bhnjv->bhniv', att, vh)

    def step(state, inp):
        q_c, k_c, v_c, g_c = inp
        o_c = jnp.einsum('bhik,bhkv->bhiv', q_c, state)
        state = state * jnp.exp(g_c)[..., None] + jnp.einsum('bhik,bhiv->bhkv', k_c, v_c)
        return state, o_c

    xs = tuple(jnp.moveaxis(t, 2, 0) for t in (q_dec, k_end, vh, total))
    _, o_inter = lax.scan(step, jnp.zeros((bsz, h, dk, dv), jnp.float32), xs)
    o = from_chunks(o_intra + jnp.moveaxis(o_inter, 0, 2))
    gate = jax.nn.silu(r.astype(jnp.float32)).reshape(bsz, s, h, dv)
    return (rms_norm(o, out_norm) * gate).reshape(bsz, s, h * dv)


def dilated_pattern(q, k, v, slopes, window, dilation):
    bsz, h, s, hd = q.shape
    blk = DIL_BLOCK
    span = window // dilation
    seg = s // dilation
    nb = -(-seg // blk)
    seg_p = nb * blk

    def to_residue(t):
        t = t.reshape(bsz, h, seg, dilation, hd).transpose(0, 1, 3, 2, 4)
        return jnp.pad(t, ((0, 0), (0, 0), (0, 0), (0, seg_p - seg), (0, 0)))

    def band(t):
        t = jnp.pad(t, ((0, 0), (0, 0), (0, 0), (blk, 0), (0, 0))).reshape(bsz, h, dilation, nb + 1, blk, hd)
        return jnp.concatenate([t[:, :, :, :-1], t[:, :, :, 1:]], axis=4)

    qb = to_residue(q).reshape(bsz, h, dilation, nb, blk, hd)
    kb = band(to_residue(k))
    vb = band(to_residue(v))
    steps = (jnp.arange(blk)[:, None] + blk) - jnp.arange(2 * blk)[None, :]
    key_pos = (jnp.arange(nb) * blk - blk)[:, None, None] + jnp.arange(2 * blk)[None, None, :]
    valid = (steps >= 0) & (steps <= span) & (key_pos >= 0)
    bias = -slopes[:, None, None, None, None] * (steps * dilation).astype(jnp.float32)
    sc = jnp.einsum('bhrnqd,bhrnkd->bhrnqk', qb, kb) * hd ** -0.5 + bias
    sc = jnp.where(valid, sc, NEG_INF)
    m = jnp.max(sc, axis=-1, keepdims=True)
    p = jnp.exp(sc - m)
    l = jnp.sum(p, axis=-1, keepdims=True)
    o = jnp.einsum('bhrnqk,bhrnkd->bhrnqd', p, vb) / l
    lse = (m + jnp.log(l))[..., 0]

    def from_residue(t):
        rest = t.shape[5:]
        t = t.reshape((bsz, h, dilation, seg_p) + rest)[:, :, :, :seg]
        return jnp.swapaxes(t, 2, 3).reshape((bsz, h, s) + rest)

    return from_residue(o), from_residue(lse)


def dilated_mixer(q, k, v, q_norm, k_norm):
    bsz, s, _ = q.shape
    h, hd = DIL_HEADS, DIL_HD

    def heads(t, w):
        return rms_norm(t.reshape(bsz, s, h, hd), w).transpose(0, 2, 1, 3)

    qh, kh = heads(q, q_norm), heads(k, k_norm)
    vh = v.astype(jnp.float32).reshape(bsz, s, h, hd).transpose(0, 2, 1, 3)
    slopes = jnp.exp2(-8.0 * jnp.arange(1, h + 1, dtype=jnp.float32) / h)
    outs, lses = zip(*[dilated_pattern(qh, kh, vh, slopes, w, d) for w, d in DIL_PATTERNS])
    mix_w = jax.nn.softmax(jnp.stack(lses), axis=0)
    o = jnp.einsum('pbhs,pbhsd->bshd', mix_w, jnp.stack(outs))
    return o.reshape(bsz, s, h * hd)


def retention_mixer(q, k, v, g, group_norm_w):
    bsz, s, _ = q.shape
    h, dk, dv, c = RET_HEADS, RET_DK, RET_DV, RET_CHUNK
    log_gamma = jnp.log1p(-jnp.exp2(-5.0 - jnp.arange(h, dtype=jnp.float32)))
    qh = to_chunks(q, h, dk, c)
    kh = to_chunks(k, h, dk, c) * dk ** -0.5
    vh = to_chunks(v, h, dv, c)
    pos = jnp.arange(c, dtype=jnp.float32)
    rel = pos[:, None] - pos[None, :]
    decay = jnp.where(rel >= 0, jnp.exp(log_gamma[:, None, None] * jnp.maximum(rel, 0.0)), 0.0)
    att = jnp.einsum('bhnik,bhnjk->bhnij', qh, kh) * decay[:, None]
    o_intra = jnp.einsum('bhnij,bhnjv->bhniv', att, vh)
    q_dec = qh * jnp.exp(log_gamma[:, None] * (pos + 1.0))[:, None, :, None]
    k_dec = kh * jnp.exp(log_gamma[:, None] * (c - 1.0 - pos))[:, None, :, None]
    chunk_decay = jnp.exp(log_gamma * c)[:, None, None]

    def step(state, inp):
        q_c, k_c, v_c = inp
        o_c = jnp.einsum('bhik,bhkv->bhiv', q_c, state)
        state = state * chunk_decay + jnp.einsum('bhik,bhiv->bhkv', k_c, v_c)
        return state, o_c

    xs = tuple(jnp.moveaxis(t, 2, 0) for t in (q_dec, k_dec, vh))
    _, o_inter = lax.scan(step, jnp.zeros((bsz, h, dk, dv), jnp.float32), xs)
    o = from_chunks(o_intra + jnp.moveaxis(o_inter, 0, 2))
    mu = jnp.mean(o, axis=-1, keepdims=True)
    var = jnp.mean(jnp.square(o - mu), axis=-1, keepdims=True)
    o = (o - mu) * lax.rsqrt(var + GN_EPS) * group_norm_w.astype(jnp.float32).reshape(h, dv)
    gate = jax.nn.silu(g.astype(jnp.float32)).reshape(bsz, s, h, dv)
    return (o * gate).reshape(bsz, s, h * dv)


def moe_ffn(x, w_router, w_gate, w_up, w_down):
    bsz, s, d = x.shape
    t = bsz * s
    xf = x.reshape(t, d)
    logits = (xf @ w_router).astype(jnp.float32)
    top_logit, top_idx = lax.top_k(logits, TOP_K)
    gates = jax.nn.softmax(top_logit, axis=-1)
    n_assign = t * TOP_K
    e_flat = top_idx.reshape(n_assign)
    tok_flat = (jnp.arange(n_assign) // TOP_K).astype(jnp.int32)
    g_flat = gates.reshape(n_assign)
    order = jnp.argsort(e_flat)
    e_s, tok_s, g_s = e_flat[order], tok_flat[order], g_flat[order]
    counts = jnp.bincount(e_flat, length=N_EXPERTS)
    starts = jnp.cumsum(counts) - counts
    padded = (counts + MOE_BLOCK - 1) // MOE_BLOCK * MOE_BLOCK
    pends = jnp.cumsum(padded)
    pstarts = pends - padded
    dest = pstarts[e_s] + jnp.arange(n_assign) - starts[e_s]
    n_blocks = -(-n_assign // MOE_BLOCK) + N_EXPERTS
    n_rows = n_blocks * MOE_BLOCK
    buf_tok = jnp.zeros((n_rows,), jnp.int32).at[dest].set(tok_s)
    buf_gate = jnp.zeros((n_rows,), jnp.float32).at[dest].set(g_s)
    block_expert = jnp.minimum(jnp.searchsorted(pends, jnp.arange(n_blocks) * MOE_BLOCK, side='right'), N_EXPERTS - 1)
    xb = xf[buf_tok].reshape(n_blocks, MOE_BLOCK, d)

    def expert_block(args):
        xblk, e = args
        return (jax.nn.silu(xblk @ w_gate[e]) * (xblk @ w_up[e])) @ w_down[e]

    yb = lax.map(expert_block, (xb, block_expert))
    y = yb.reshape(n_rows, d).astype(jnp.float32) * buf_gate[:, None]
    out = jnp.zeros((t, d), jnp.float32).at[buf_tok].add(y)
    return out.astype(x.dtype).reshape(bsz, s, d)


def setup_inputs(seed: int = 0) -> dict:
    key = jax.random.key(seed)
    keys = iter(jax.random.split(key, 24))
    f32 = jnp.float32
    D = D_MODEL

    def dense(shape, fan_in):
        return jax.random.normal(next(keys), shape, f32) * fan_in ** -0.5

    def gain(shape):
        return 1.0 + 0.02 * jax.random.normal(next(keys), shape, f32)

    def small(shape, scale):
        return scale * jax.random.normal(next(keys), shape, f32)

    return {
        'x': jax.random.normal(next(keys), (BATCH, SEQ, D), f32),
        'mix_norm_even': gain((N_EVEN, D)),
        'w_in_even': dense((N_EVEN, D, EVEN_IN), D),
        'w_gla_gate_up': dense((N_EVEN, GLA_GATE_RANK, GLA_HEADS * GLA_DK), GLA_GATE_RANK),
        'b_gla_gate': small((N_EVEN, GLA_HEADS * GLA_DK), 0.1),
        'gla_out_norm': gain((N_EVEN, GLA_DV)),
        'q_norm': gain((N_EVEN, DIL_HD)),
        'k_norm': gain((N_EVEN, DIL_HD)),
        'w_out_even': dense((N_EVEN, EVEN_MIX, D), EVEN_MIX),
        'ffn_norm_even': gain((N_EVEN, D)),
        'w_ffn_gate': dense((N_EVEN, D, FFN_DENSE), D),
        'w_ffn_up': dense((N_EVEN, D, FFN_DENSE), D),
        'w_ffn_down': dense((N_EVEN, FFN_DENSE, D), FFN_DENSE),
        'mix_norm_odd': gain((N_ODD, D)),
        'w_in_odd': dense((N_ODD, D, ODD_IN), D),
        'ret_group_norm': gain((N_ODD, ODD_MIX)),
        'w_out_odd': dense((N_ODD, ODD_MIX, D), ODD_MIX),
        'ffn_norm_odd': gain((N_ODD, D)),
        'w_router': dense((N_ODD, D, N_EXPERTS), D),
        'w_exp_gate': dense((N_ODD, N_EXPERTS, D, FFN_EXPERT), D),
        'w_exp_up': dense((N_ODD, N_EXPERTS, D, FFN_EXPERT), D),
        'w_exp_down': dense((N_ODD, N_EXPERTS, FFN_EXPERT, D), FFN_EXPERT),
    }


def reference(x, mix_norm_even, w_in_even, w_gla_gate_up, b_gla_gate, gla_out_norm, q_norm, k_norm,
              w_out_even, ffn_norm_even, w_ffn_gate, w_ffn_up, w_ffn_down, mix_norm_odd, w_in_odd,
              ret_group_norm, w_out_odd, ffn_norm_odd, w_router, w_exp_gate, w_exp_up, w_exp_down):
    dt = x.dtype
    for layer in range(DEPTH):
        i = layer // 2
        if layer % 2 == 0:
            hcat = rms_norm(x, mix_norm_even[i]).astype(dt) @ w_in_even[i]
            q_a, k_a, v_a, r_a, lr_a, q_b, k_b, v_b = split_cols(hcat, EVEN_COLS)
            o_a = gla_mixer(q_a, k_a, v_a, r_a, lr_a, w_gla_gate_up[i], b_gla_gate[i], gla_out_norm[i])
            o_b = dilated_mixer(q_b, k_b, v_b, q_norm[i], k_norm[i])
            x = x + jnp.concatenate([o_a, o_b], axis=-1).astype(dt) @ w_out_even[i]
            x = x + swiglu(rms_norm(x, ffn_norm_even[i]).astype(dt), w_ffn_gate[i], w_ffn_up[i], w_ffn_down[i])
        else:
            hcat = rms_norm(x, mix_norm_odd[i]).astype(dt) @ w_in_odd[i]
            q_c, k_c, v_c, g_c = split_cols(hcat, ODD_COLS)
            o_c = retention_mixer(q_c, k_c, v_c, g_c, ret_group_norm[i])
            x = x + o_c.astype(dt) @ w_out_odd[i]
            x = x + moe_ffn(rms_norm(x, ffn_norm_odd[i]).astype(dt), w_router[i], w_exp_gate[i], w_exp_up[i], w_exp_down[i])
    return x
```

```cpp
#include <hip/hip_runtime.h>
#include <cstdio>
#include <cstdint>

#define LAS __attribute__((address_space(3)))
#define GAS __attribute__((address_space(1)))
typedef unsigned short bf16_t;
typedef short bf16x8 __attribute__((ext_vector_type(8)));
typedef float f32x4 __attribute__((ext_vector_type(4)));
typedef float f32x2 __attribute__((ext_vector_type(2)));
typedef unsigned u32x4 __attribute__((ext_vector_type(4)));
typedef unsigned u32x2 __attribute__((ext_vector_type(2)));
typedef GAS unsigned gu32;
#define RLX_AGENT __ATOMIC_RELAXED, __HIP_MEMORY_SCOPE_AGENT
#define LDS_WAIT() asm volatile("s_waitcnt lgkmcnt(0)" ::: "memory")
#define VM_WAIT() asm volatile("s_waitcnt vmcnt(0)" ::: "memory")

constexpr int NBATCH = 4, SEQ = 8192, T = NBATCH * SEQ, D = 1024;
constexpr float NORM_EPS = 1e-6f, GN_EPS = 1e-5f;
constexpr int LDW0 = 4624, LD0 = 4608;
constexpr int C0_QA = 0, C0_KA = 512, C0_VA = 1024, C0_RA = 2048, C0_QB = 3072, C0_KB = 3584, C0_VB = 4096;
constexpr int W0_LR = 3072;
constexpr int MIX0 = 1536, FF0 = 2816;
constexpr int LD1 = 6144, C1_Q = 0, C1_K = 1024, C1_V = 2048, C1_G = 4096, MIX1 = 2048;
constexpr int NEXP = 8, FFE = 3584;
constexpr int MOE_ROWS = 34816, MOE_BLKS = 136;

constexpr size_t MiB = 1u << 20;
constexpr size_t WS_CTL = 0, CTL_ZERO_BYTES = 1 * MiB;
constexpr size_t WS_WIN0 = 1 * MiB, WS_WOUT0 = 10 * MiB, WS_WGU0 = 13 * MiB, WS_WD0 = 24 * MiB, WS_WIN1 = 30 * MiB, WS_WOUT1 = 42 * MiB;
constexpr size_t WS_LR = 46 * MiB, WS_DECAY = 48 * MiB, WS_LSE = 49 * MiB, WS_ROUTE = 52 * MiB;
constexpr size_t WS_XN = 56 * MiB;
constexpr size_t WS_BIG = 120 * MiB;
constexpr size_t B_HCAT0 = 0, B_ATT0 = 288 * MiB, B_KENDT = 304 * MiB, B_OP2 = 336 * MiB;
constexpr size_t B_H0 = 0;
constexpr size_t B_HCAT1 = 0, B_ATT1 = 384 * MiB;
constexpr size_t B_WEGU = 0, B_WED = 112 * MiB, B_HMOE = 168 * MiB;
constexpr size_t WS_END = WS_BIG + 416 * MiB;
constexpr size_t R_TOKINFO = 0, R_ROWTOK = 512 * 1024, R_ROWGATE = R_ROWTOK + 2 * MOE_ROWS * 4, R_BLKEXP = R_ROWGATE + 2 * MOE_ROWS * 4, R_NBLK = R_BLKEXP + 2 * MOE_BLKS * 4;
constexpr int CW_TMO = 0, CW_CODE = 1, CW_BAR = 4096;

constexpr int LDS_BYTES = 147456;
constexpr int RING_BYTES = 131072;
constexpr int LDSCTL_OFF = 139264;
constexpr int NWAVES = 8, NTHREADS = 512;

__device__ __forceinline__ float bf2f(bf16_t b) { return __uint_as_float(((unsigned)b) << 16); }
__device__ __forceinline__ unsigned f2bf(float f) { unsigned u = __float_as_uint(f); return (u + 0x7fffu + ((u >> 16) & 1u)) >> 16; }
__device__ __forceinline__ unsigned pk2(float lo, float hi) { return f2bf(lo) | (f2bf(hi) << 16); }
__device__ __forceinline__ float bfround(float f) { return __uint_as_float(f2bf(f) << 16); }
__device__ __forceinline__ unsigned cvt_pk_bf16(float lo, float hi) { unsigned r; asm volatile("v_cvt_pk_bf16_f32 %0, %1, %2" : "=v"(r) : "v"(lo), "v"(hi)); return r; }
__device__ __forceinline__ float wave_sum(float v) {
#pragma unroll
    for (int o = 1; o < 64; o <<= 1) v += __shfl_xor(v, o);
    return v;
}
__device__ __forceinline__ float silu_f(float v) { return v / (1.f + __expf(-v)); }
__device__ __forceinline__ float logsigmoid_f(float z) { return fminf(z, 0.f) - log1pf(__expf(-fabsf(z))); }

#define XB_TMO      128
#define XB_XCNT(j)  (256  + 64 * (j))
#define XB_XSUB(j)  (1280 + 64 * (j))
#define XB_XGEN(j)  (2304 + 64 * (j))
#define XB_TOP      3328
#define XB_TOPGEN   3392
#define XCD_BAR_WORDS 3456
#define XB_SPIN_CAP (1u << 22)
__device__ __forceinline__ unsigned xb_ld(unsigned* p)              { return __hip_atomic_load(p, __ATOMIC_RELAXED, __HIP_MEMORY_SCOPE_AGENT); }
__device__ __forceinline__ unsigned xb_add(unsigned* p, unsigned v) { return __hip_atomic_fetch_add(p, v, __ATOMIC_RELAXED, __HIP_MEMORY_SCOPE_AGENT); }
__device__ __forceinline__ unsigned xb_xcc_id() { return (unsigned)__builtin_amdgcn_s_getreg((3 << 11) | 20) & 0xFu; }
#define XB_SPIN(cond, bar) do { unsigned _sp = 0; while (cond) { __builtin_amdgcn_s_sleep(1); \
    if ((++_sp & 255u) == 0u) { if (xb_ld(&(bar)[XB_TMO])) break; if (_sp > XB_SPIN_CAP) { atomicAdd(&(bar)[XB_TMO], 1u); break; } } } } while (0)
struct XcdBarrier { unsigned* bar; unsigned x; volatile LAS unsigned* st; };
__device__ __forceinline__ XcdBarrier xcd_barrier_post(unsigned* bar, volatile LAS unsigned* st) {
    XcdBarrier b; b.bar = bar; b.x = xb_xcc_id(); b.st = st;
    if (threadIdx.x == 0) (void)xb_add(&bar[XB_XCNT(b.x)], 1u);
    return b;
}
__device__ __forceinline__ void xcd_barrier_complete(unsigned* bar, unsigned x, unsigned& nloc, unsigned& nx) {
    const unsigned G = gridDim.x * gridDim.y * gridDim.z;
    unsigned sum, cnt, mine, sp = 0u;
    for (;;) {
        sum = 0u; cnt = 0u; mine = 0u;
#pragma unroll
        for (unsigned j = 0; j < 16; ++j) { const unsigned c = xb_ld(&bar[XB_XCNT(j)]); sum += c; cnt += (c > 0u) ? 1u : 0u; mine = (j == x) ? c : mine; }
        if (sum == G) break;
        __builtin_amdgcn_s_sleep(1);
        if ((++sp & 255u) == 0u) { if (xb_ld(&bar[XB_TMO])) break; if (sp > XB_SPIN_CAP) { atomicAdd(&bar[XB_TMO], 1u); break; } }
    }
    nloc = mine > 0u ? mine : 1u; nx = cnt > 0u ? cnt : 1u;
}
__device__ __forceinline__ void xcd_barrier(const XcdBarrier& b) {
    asm volatile("s_waitcnt vmcnt(0)" ::: "memory");
    __syncthreads();
    if (threadIdx.x == 0) {
        unsigned* bar = b.bar;
        __builtin_amdgcn_s_waitcnt(0);
        unsigned nloc = b.st[0], nx = b.st[1];
        if (nloc == 0u) { xcd_barrier_complete(bar, b.x, nloc, nx); b.st[0] = nloc; b.st[1] = nx; }
        const unsigned old = xb_add(&bar[XB_XSUB(b.x)], 1u);
        const unsigned gen = old / nloc;
        if (old + 1u == (gen + 1u) * nloc) {
            __builtin_amdgcn_fence(__ATOMIC_RELEASE, "agent");
            asm volatile("s_waitcnt vmcnt(0)" ::: "memory");
            const unsigned og = xb_add(&bar[XB_TOP], 1u);
            const unsigned tg = og / nx;
            if (og + 1u == (tg + 1u) * nx) xb_add(&bar[XB_TOPGEN], 1u);
            else XB_SPIN(xb_ld(&bar[XB_TOPGEN]) == tg, bar);
            __builtin_amdgcn_fence(__ATOMIC_ACQUIRE, "agent");
            xb_add(&bar[XB_XGEN(b.x)], 1u);
            asm volatile("s_waitcnt vmcnt(0)" ::: "memory");
        } else {
            XB_SPIN(xb_ld(&bar[XB_XGEN(b.x)]) == gen, bar);
            __builtin_amdgcn_fence(__ATOMIC_ACQUIRE, "agent");
            asm volatile("s_waitcnt vmcnt(0)" ::: "memory");
        }
    }
    __syncthreads();
}

namespace pg8 {
constexpr int BM = 256, BK = 64, HALF = 128, HTB = HALF * BK * 2, STAGE_BYTES = 8 * HTB;
__device__ __forceinline__ int lds_byte(int r, int c) { const int st = (r >> 4) * 2 + (c >> 5), rr = r & 15, cc = c & 31, ob = rr * 64 + cc * 2; return st * 1024 + (ob ^ (((ob >> 9) & 1) << 5)); }
__device__ __forceinline__ void stage_rc(int b, int& R, int& C) { const int st = b / 1024, sb = b % 1024, swz = sb ^ (((sb >> 9) & 1) << 5); R = (st >> 1) * 16 + swz / 64; C = (st & 1) * 32 + (swz % 64) / 2; }
__device__ __forceinline__ int perm32(int rho) { const int n = rho >> 4, i = rho & 15; return 8 * (i >> 2) + 4 * n + (i & 3); }
struct Unit { int pm, pn; };

struct DenseOrder {
    int nM, nN, nwg, G, c;
    __device__ void init(int M, int N, int G_, int c_) { nM = M / BM; nN = N / BM; nwg = nM * nN; G = G_; c = c_; }
    __device__ bool next(int i, Unit& u) const {
        const long L = (long)i * G + c; if (L >= nwg) return false;
        int wgid = (int)L; { const int q = nwg / 8, r = nwg % 8, xcd = wgid % 8, off = wgid / 8; wgid = (xcd < r ? xcd * (q + 1) : r * (q + 1) + (xcd - r) * q) + off; }
        const int nig = 8 * nN, gid = wgid / nig, fm = gid * 8, gsz = (nM - fm) < 8 ? (nM - fm) : 8;
        u.pm = fm + ((wgid % nig) % gsz); u.pn = (wgid % nig) / gsz; return true;
    }
};
struct PlainMap {
    __device__ __forceinline__ unsigned arow(int pm, int r) const { return (unsigned)(pm * BM + r); }
    __device__ __forceinline__ size_t brow0(const Unit& u) const { return (size_t)u.pn * BM; }
};
struct MoeMap {
    const int* rowtok; const int* blkexp; int nexp_rows;
    __device__ __forceinline__ unsigned arow(int pm, int r) const { if (!rowtok) return (unsigned)(pm * BM + r); const int t = rowtok[pm * BM + r]; return (unsigned)(t < 0 ? 0 : t); }
    __device__ __forceinline__ size_t brow0(const Unit& u) const { return (size_t)blkexp[u.pm] * nexp_rows + (size_t)u.pn * BM; }
};

template <class Epi, class Sched, class Map>
__device__ __forceinline__ void gemm_phase(LAS unsigned char* lds, const bf16_t* A, int lda, const bf16_t* Bt, int K, const Sched& S, const Map& MP, const Epi& E) {
    const int tid = threadIdx.x, wid = __builtin_amdgcn_readfirstlane(tid >> 6), lane = tid & 63, wr = wid >> 2, wc = wid & 3, fr = lane & 15, fq = lane >> 4;
    const int nt = K / BK;
    int Rst[2], Cst[2]; unsigned voffB[2];
#pragma unroll
    for (int i = 0; i < 2; ++i) { int R, C; stage_rc(tid * 16 + i * 8192, R, C); Rst[i] = R; Cst[i] = C; const int Rb = Epi::PERM ? ((R & ~31) + perm32(R & 31)) : R; voffB[i] = (unsigned)(Rb * K + C) * 2u; }
    const size_t kstep = (size_t)(BK * 2);
    const size_t hstepB = (size_t)HALF * K * 2;
    const unsigned ldsw = (unsigned)wid * 1024u;
    const int aoff = lds_byte(wr * 64 + fr, fq * 8), boff = lds_byte(wc * 32 + fr, fq * 8);
#define PG8_SA(b, h) (((b) * 2 + (h)) * HTB)
#define PG8_SB(b, h) ((4 + (b) * 2 + (h)) * HTB)
#define PG8_STAGE(bufoff, gbase, voff) do { _Pragma("unroll") for (int _i = 0; _i < 2; ++_i) \
        __builtin_amdgcn_global_load_lds((const unsigned*)((const char*)(gbase) + (voff)[_i]), (LAS unsigned*)(lds + (bufoff) + ldsw + _i * 8192), 16, 0, 0); } while (0)
#define PG8_LDA(dst, b, h) do { _Pragma("unroll") for (int m = 0; m < 4; ++m) _Pragma("unroll") for (int k = 0; k < 2; ++k) dst[m][k] = *(const LAS bf16x8*)(lds + PG8_SA(b, h) + aoff + m * 2048 + k * 1024); } while (0)
#define PG8_LDB(dst, b, h) do { _Pragma("unroll") for (int n = 0; n < 2; ++n) _Pragma("unroll") for (int k = 0; k < 2; ++k) dst[n][k] = *(const LAS bf16x8*)(lds + PG8_SB(b, h) + boff + n * 2048 + k * 1024); } while (0)
#define PG8_MMA(ai, bj, At, Bt_) do { __builtin_amdgcn_s_setprio(1); _Pragma("unroll") for (int m = 0; m < 4; ++m) _Pragma("unroll") for (int n = 0; n < 2; ++n) _Pragma("unroll") for (int k = 0; k < 2; ++k) \
        acc[ai][bj][m][n] = __builtin_amdgcn_mfma_f32_16x16x32_bf16(Bt_[n][k], At[m][k], acc[ai][bj][m][n], 0, 0, 0); __builtin_amdgcn_s_setprio(0); } while (0)
#define PG8_WAIT_V(n) asm volatile("s_waitcnt vmcnt(" #n ")" ::: "memory")
#define PG8_WAIT_L(n) asm volatile("s_waitcnt lgkmcnt(" #n ")" ::: "memory")
#define PG8_BAR __builtin_amdgcn_s_barrier()
#define PG8_SCHED __builtin_amdgcn_sched_barrier(0)
#define PG8_VOFFA(dst, u_) do { _Pragma("unroll") for (int _h = 0; _h < 2; ++_h) _Pragma("unroll") for (int _i = 0; _i < 2; ++_i) \
        dst[_h][_i] = (MP.arow((u_).pm, _h * HALF + Rst[_i]) * (unsigned)lda + (unsigned)Cst[_i]) * 2u; } while (0)
    Unit cur, nxt; int ui = 0;
    if (!S.next(0, cur)) return;
    f32x4 acc[2][2][4][2];
#pragma unroll
    for (int a = 0; a < 2; ++a)
#pragma unroll
        for (int b = 0; b < 2; ++b)
#pragma unroll
            for (int m = 0; m < 4; ++m)
#pragma unroll
                for (int n = 0; n < 2; ++n) acc[a][b][m][n] = (f32x4){0.f, 0.f, 0.f, 0.f};
    bf16x8 At[4][2], B0[2][2], B1[2][2];
    unsigned vc[2][2], vn[2][2], v2[2][2];
    PG8_VOFFA(vc, cur);
    const char* cA = (const char*)A; const char* cB = (const char*)Bt + MP.brow0(cur) * (size_t)K * 2;
    PG8_STAGE(PG8_SB(0, 0), cB, voffB); PG8_STAGE(PG8_SB(0, 1), cB + hstepB, voffB); PG8_STAGE(PG8_SA(0, 0), cA, vc[0]); PG8_STAGE(PG8_SA(0, 1), cA, vc[1]);
    if (wr == 1) PG8_BAR;
    PG8_WAIT_V(2); PG8_BAR;
    PG8_STAGE(PG8_SB(1, 0), cB + kstep, voffB); PG8_STAGE(PG8_SA(1, 0), cA + kstep, vc[0]); PG8_STAGE(PG8_SB(1, 1), cB + hstepB + kstep, voffB);
    PG8_WAIT_V(6); PG8_BAR;
    for (;;) {
        const bool has_next = S.next(ui + 1, nxt);
        const char* nB = cB;
        if (has_next) { PG8_VOFFA(vn, nxt); nB = (const char*)Bt + MP.brow0(nxt) * (size_t)K * 2; }
        else {
#pragma unroll
            for (int h = 0; h < 2; ++h)
#pragma unroll
                for (int i = 0; i < 2; ++i) vn[h][i] = vc[h][i];
        }
        for (int t = 0; t < nt; t += 2) {
            const bool last = (t == nt - 2);
            const char* a1 = cA + (size_t)(t + 1) * kstep;
            const char* a2 = last ? cA : cA + (size_t)(t + 2) * kstep; const char* b2 = last ? nB : cB + (size_t)(t + 2) * kstep;
            const char* a3 = a2 + kstep; const char* b3 = b2 + kstep;
#pragma unroll
            for (int h = 0; h < 2; ++h)
#pragma unroll
                for (int i = 0; i < 2; ++i) v2[h][i] = last ? vn[h][i] : vc[h][i];
            PG8_LDB(B0, 0, 0); PG8_LDB(B1, 0, 1); PG8_SCHED; PG8_LDA(At, 0, 0); PG8_STAGE(PG8_SA(1, 1), a1, vc[1]);
            PG8_WAIT_V(8); PG8_WAIT_L(0); PG8_BAR; PG8_MMA(0, 0, At, B0); PG8_MMA(0, 1, At, B1); PG8_BAR; PG8_SCHED;
            PG8_LDA(At, 0, 1); PG8_STAGE(PG8_SB(0, 0), b2, voffB); PG8_STAGE(PG8_SB(0, 1), b2 + hstepB, voffB); PG8_STAGE(PG8_SA(0, 0), a2, v2[0]);
            PG8_WAIT_V(8); PG8_WAIT_L(0); PG8_BAR; PG8_MMA(1, 0, At, B0); PG8_MMA(1, 1, At, B1); PG8_BAR; PG8_SCHED;
            PG8_LDB(B0, 1, 0); PG8_LDB(B1, 1, 1); PG8_SCHED; PG8_LDA(At, 1, 0); PG8_STAGE(PG8_SA(0, 1), a2, v2[1]);
            PG8_WAIT_V(8); PG8_WAIT_L(0); PG8_BAR; PG8_MMA(0, 0, At, B0); PG8_MMA(0, 1, At, B1); PG8_BAR; PG8_SCHED;
            PG8_LDA(At, 1, 1); PG8_STAGE(PG8_SB(1, 0), b3, voffB); PG8_STAGE(PG8_SB(1, 1), b3 + hstepB, voffB); PG8_STAGE(PG8_SA(1, 0), a3, v2[0]);
            PG8_WAIT_V(8); PG8_WAIT_L(0); PG8_BAR; PG8_MMA(1, 0, At, B0); PG8_MMA(1, 1, At, B1); PG8_BAR; PG8_SCHED;
        }
        if (wr == 0) PG8_BAR;
        E(acc, cur, wr, wc, fr, fq);
        if (!has_next) break;
#pragma unroll
        for (int a = 0; a < 2; ++a)
#pragma unroll
            for (int b = 0; b < 2; ++b)
#pragma unroll
                for (int m = 0; m < 4; ++m)
#pragma unroll
                    for (int n = 0; n < 2; ++n) acc[a][b][m][n] = (f32x4){0.f, 0.f, 0.f, 0.f};
        cur = nxt; cB = nB; ++ui;
#pragma unroll
        for (int h = 0; h < 2; ++h)
#pragma unroll
            for (int i = 0; i < 2; ++i) vc[h][i] = vn[h][i];
        if (wr == 1) PG8_BAR;
    }
    PG8_WAIT_V(0);
    PG8_BAR;
#undef PG8_SA
#undef PG8_SB
#undef PG8_STAGE
#undef PG8_LDA
#undef PG8_LDB
#undef PG8_MMA
#undef PG8_WAIT_V
#undef PG8_WAIT_L
#undef PG8_BAR
#undef PG8_SCHED
#undef PG8_VOFFA
}

struct EpiBf16 {
    static constexpr bool PERM = true;
    bf16_t* O; int ldc;
    __device__ __forceinline__ void operator()(const f32x4 (&acc)[2][2][4][2], const Unit& u, int wr, int wc, int fr, int fq) const {
        const int row0 = u.pm * BM + wr * 64 + fr, col0 = u.pn * BM + wc * 32 + 8 * fq;
#pragma unroll
        for (int ai = 0; ai < 2; ++ai)
#pragma unroll
            for (int m = 0; m < 4; ++m) { bf16_t* rowp = O + (size_t)(row0 + ai * HALF + m * 16) * ldc + col0;
#pragma unroll
                for (int bj = 0; bj < 2; ++bj) { const f32x4 v0 = acc[ai][bj][m][0], v1 = acc[ai][bj][m][1];
                    u32x4 w; w.x = cvt_pk_bf16(v0[0], v0[1]); w.y = cvt_pk_bf16(v0[2], v0[3]); w.z = cvt_pk_bf16(v1[0], v1[1]); w.w = cvt_pk_bf16(v1[2], v1[3]);
                    *(u32x4*)(rowp + bj * HALF) = w; } }
    }
};
struct EpiSwiGLU {
    static constexpr bool PERM = true;
    bf16_t* H; int ldh;
    __device__ __forceinline__ void operator()(const f32x4 (&acc)[2][2][4][2], const Unit& u, int wr, int wc, int fr, int fq) const {
        const int row0 = u.pm * BM + wr * 64 + fr, col0 = u.pn * HALF + wc * 32 + 8 * fq;
#pragma unroll
        for (int ai = 0; ai < 2; ++ai)
#pragma unroll
            for (int m = 0; m < 4; ++m) { bf16_t* rowp = H + (size_t)(row0 + ai * HALF + m * 16) * ldh + col0;
                f32x4 h0, h1;
#pragma unroll
                for (int j = 0; j < 4; ++j) { const float g0 = acc[ai][0][m][0][j], g1 = acc[ai][0][m][1][j];
                    h0[j] = g0 * __builtin_amdgcn_rcpf(1.f + __expf(-g0)) * acc[ai][1][m][0][j]; h1[j] = g1 * __builtin_amdgcn_rcpf(1.f + __expf(-g1)) * acc[ai][1][m][1][j]; }
                u32x4 w; w.x = cvt_pk_bf16(h0[0], h0[1]); w.y = cvt_pk_bf16(h0[2], h0[3]); w.z = cvt_pk_bf16(h1[0], h1[1]); w.w = cvt_pk_bf16(h1[2], h1[3]);
                *(u32x4*)rowp = w; }
    }
};
struct EpiResF32 {
    static constexpr bool PERM = false;
    const float* base; float* out; int ldc;
    __device__ __forceinline__ void operator()(const f32x4 (&acc)[2][2][4][2], const Unit& u, int wr, int wc, int fr, int fq) const {
        const int row0 = u.pm * BM + wr * 64 + fr, col0 = u.pn * BM + wc * 32 + 4 * fq;
#pragma unroll
        for (int ai = 0; ai < 2; ++ai)
#pragma unroll
            for (int m = 0; m < 4; ++m) { const size_t off = (size_t)(row0 + ai * HALF + m * 16) * ldc + col0;
#pragma unroll
                for (int bj = 0; bj < 2; ++bj)
#pragma unroll
                    for (int n = 0; n < 2; ++n) { const f32x4 bs = *(const f32x4*)(base + off + bj * HALF + n * 16); *(f32x4*)(out + off + bj * HALF + n * 16) = bs + acc[ai][bj][m][n]; } }
    }
};
struct EpiMoeDown {
    static constexpr bool PERM = false;
    float* out; const int* rowtok; const float* rowgate;
    __device__ __forceinline__ void operator()(const f32x4 (&acc)[2][2][4][2], const Unit& u, int wr, int wc, int fr, int fq) const {
        const int row0 = u.pm * BM + wr * 64 + fr, col0 = u.pn * BM + wc * 32 + 4 * fq;
#pragma unroll
        for (int ai = 0; ai < 2; ++ai)
#pragma unroll
            for (int m = 0; m < 4; ++m) { const int r = row0 + ai * HALF + m * 16; const int tok = rowtok[r]; const float g = rowgate[r];
                if (tok >= 0) { float* op = out + (size_t)tok * D + col0;
#pragma unroll
                    for (int bj = 0; bj < 2; ++bj)
#pragma unroll
                        for (int n = 0; n < 2; ++n) { const f32x4 bs = *(const f32x4*)(op + bj * HALF + n * 16); *(f32x4*)(op + bj * HALF + n * 16) = bs + g * acc[ai][bj][m][n]; } } }
    }
};
}

struct MoeOrder {
    int nwg, nN, G, c;
    __device__ void init(int nblk, int nN_, int G_, int c_) { nN = nN_; nwg = nblk * nN_; G = G_; c = c_; }
    __device__ bool next(int i, pg8::Unit& u) const { const long L = (long)i * G + c; if (L >= nwg) return false; u.pm = (int)(L / nN); u.pn = (int)(L % nN); return true; }
};

struct Frame {
    LAS unsigned char* lds;
    gu32* ctl;
    int tid, lane, wave, G, gw, NGW;
    unsigned char* ws;
    float* out;
};
__device__ __forceinline__ const float* inptr(int i) {
    unsigned off = (unsigned)i * 8u; asm volatile("" : "+s"(off));
    return *(const float* const*)((const char*)__builtin_amdgcn_kernarg_segment_ptr() + off);
}
enum { I_X = 0, I_MN0, I_WIN0, I_WGATEUP, I_BGATE, I_GLANORM, I_QNORM, I_KNORM, I_WOUT0, I_FN0, I_WFG, I_WFU, I_WFD, I_MN1, I_WIN1, I_RETGN, I_WOUT1, I_FN1, I_WROUTER, I_WEG, I_WEU, I_WED };

__device__ __forceinline__ void transpose_item(const float* W, int ldw, int src_col0, bf16_t* WT, int ldt, int dst_row0, int k0, LAS float* scr, int lane) {
#pragma unroll 8
    for (int i = 0; i < 32; ++i) { const int kk = 2 * i + (lane >> 5); scr[kk * 33 + (lane & 31)] = W[(size_t)(k0 + kk) * ldw + src_col0 + (lane & 31)]; }
    LDS_WAIT(); asm volatile("" ::: "memory");
    const int c = lane & 7;
#pragma unroll
    for (int j = 0; j < 4; ++j) { const int n = (lane >> 3) + 8 * j; const LAS float* s = scr + (8 * c) * 33 + n;
        u32x4 o; o.x = pk2(s[0 * 33], s[1 * 33]); o.y = pk2(s[2 * 33], s[3 * 33]); o.z = pk2(s[4 * 33], s[5 * 33]); o.w = pk2(s[6 * 33], s[7 * 33]);
        *(u32x4*)(WT + (size_t)(dst_row0 + n) * ldt + k0 + 8 * c) = o; }
    LDS_WAIT(); asm volatile("" ::: "memory");
}
__device__ __forceinline__ void transpose_plain(const float* W, int K, int N, bf16_t* WT, int it, LAS float* scr, int lane) {
    const int nblk = N / 32, kb = it / nblk, nb = it % nblk; transpose_item(W, N, 32 * nb, WT, K, 32 * nb, 64 * kb, scr, lane);
}
__device__ __forceinline__ void transpose_gateup(const float* Wg, const float* Wu, int K, int F, bf16_t* WT, int it, LAS float* scr, int lane) {
    const int nblk = 2 * F / 32, kb = it / nblk, nb = it % nblk, dr = 32 * nb, tile = dr >> 8, within = dr & 255;
    const float* W = within < 128 ? Wg : Wu; const int sc = tile * 128 + (within & 127);
    transpose_item(W, F, sc, WT, K, dr, 64 * kb, scr, lane);
}

__device__ __forceinline__ void rmsnorm_row(const float* xrow, const float* w, bf16_t* orow, int lane, f32x4 (&v)[4]) {
    const f32x4* xr = (const f32x4*)xrow + lane; float s = 0.f;
#pragma unroll
    for (int j = 0; j < 4; ++j) { v[j] = xr[64 * j]; s += (v[j].x * v[j].x + v[j].y * v[j].y) + (v[j].z * v[j].z + v[j].w * v[j].w); }
    const float r = 1.f / sqrtf(wave_sum(s) * (1.f / D) + NORM_EPS);
    const f32x4* wr = (const f32x4*)w + lane;
    unsigned long long* o8 = (unsigned long long*)orow + lane;
#pragma unroll
    for (int j = 0; j < 4; ++j) { const f32x4 ww = wr[64 * j]; v[j] = v[j] * r * ww; o8[64 * j] = (unsigned long long)pk2(v[j].x, v[j].y) | ((unsigned long long)pk2(v[j].z, v[j].w) << 32); }
}

struct Args { const float* in[22]; float* out; unsigned char* ws; int ph_lo, ph_hi; };
constexpr int NPHASE = 22;

__global__ void __launch_bounds__(NTHREADS, 2) fwd_kernel(Args args) {
    extern __shared__ __attribute__((aligned(16))) unsigned char lds_raw[];
    Frame F;
    F.lds = (LAS unsigned char*)lds_raw;
    F.tid = threadIdx.x; F.lane = F.tid & 63; F.wave = __builtin_amdgcn_readfirstlane(F.tid >> 6);
    F.G = gridDim.x; F.gw = blockIdx.x * NWAVES + F.wave; F.NGW = F.G * NWAVES;
    F.ws = args.ws; F.ctl = (gu32*)(args.ws + WS_CTL); F.out = args.out;
    volatile LAS unsigned* MISC = (volatile LAS unsigned*)(F.lds + LDSCTL_OFF);
    if (F.tid < 64) MISC[F.tid] = 0u;
    __syncthreads();
    const int lo = args.ph_lo, hi = args.ph_hi;
    const bool use_bar = (hi - lo) > 1;
    XcdBarrier bar; bar.bar = (unsigned*)(F.ctl + CW_BAR); bar.x = 0; bar.st = nullptr;
    if (use_bar) bar = xcd_barrier_post((unsigned*)(F.ctl + CW_BAR), MISC + 8);
#ifndef PHMASK
#define PHMASK 0x3fffff
#endif
#define IN(k) (((PHMASK >> (k)) & 1) && lo <= (k) && (k) < hi)
#define SEAM(k) do { if (IN(k) && IN((k) + 1)) xcd_barrier(bar); } while (0)
    unsigned char* const big = F.ws + WS_BIG;
    bf16_t* const XN = (bf16_t*)(F.ws + WS_XN);
    bf16_t* const HC0 = (bf16_t*)(big + B_HCAT0);
    bf16_t* const HC1 = (bf16_t*)(big + B_HCAT1);
    const int NT = F.G * NTHREADS, gtid = blockIdx.x * NTHREADS + F.tid;

    if (IN(0)) {
        LAS float* scr = (LAS float*)(F.lds + F.wave * 16384);
        constexpr int I0 = (D / 64) * (LD0 / 32), I1 = (MIX0 / 64) * (D / 32), I2 = (D / 64) * (2 * FF0 / 32), I3 = (FF0 / 64) * (D / 32), I4 = (D / 64) * (LD1 / 32), I5 = (MIX1 / 64) * (D / 32);
        constexpr int NIT = I0 + I1 + I2 + I3 + I4 + I5;
        for (int it = F.gw; it < NIT; it += F.NGW) {
            int r = it;
            if (r < I0) { const int nblk = LD0 / 32, kb = r / nblk, nb = r % nblk, dr = 32 * nb; transpose_item(inptr(I_WIN0), LDW0, dr < W0_LR ? dr : dr + 16, (bf16_t*)(F.ws + WS_WIN0), D, dr, 64 * kb, scr, F.lane); continue; } r -= I0;
            if (r < I1) { transpose_plain(inptr(I_WOUT0), MIX0, D, (bf16_t*)(F.ws + WS_WOUT0), r, scr, F.lane); continue; } r -= I1;
            if (r < I2) { transpose_gateup(inptr(I_WFG), inptr(I_WFU), D, FF0, (bf16_t*)(F.ws + WS_WGU0), r, scr, F.lane); continue; } r -= I2;
            if (r < I3) { transpose_plain(inptr(I_WFD), FF0, D, (bf16_t*)(F.ws + WS_WD0), r, scr, F.lane); continue; } r -= I3;
            if (r < I4) { transpose_plain(inptr(I_WIN1), D, LD1, (bf16_t*)(F.ws + WS_WIN1), r, scr, F.lane); continue; } r -= I4;
            transpose_plain(inptr(I_WOUT1), MIX1, D, (bf16_t*)(F.ws + WS_WOUT1), r, scr, F.lane);
        }
        float* lr = (float*)(F.ws + WS_LR);
        const float* wlr = inptr(I_WIN0) + W0_LR;
        for (int m = F.gw; m < T; m += F.NGW) {
            f32x4 v[4]; rmsnorm_row(inptr(I_X) + (size_t)m * D, inptr(I_MN0), XN + (size_t)m * D, F.lane, v);
            float a[16];
#pragma unroll
            for (int r = 0; r < 16; ++r) a[r] = 0.f;
#pragma unroll
            for (int j = 0; j < 4; ++j)
#pragma unroll
                for (int e = 0; e < 4; ++e) { const int c = 256 * j + 4 * F.lane + e; const f32x4* wp = (const f32x4*)(wlr + (size_t)c * LDW0); const float xv = v[j][e];
#pragma unroll
                    for (int q = 0; q < 4; ++q) { const f32x4 w4 = wp[q]; a[4 * q] += xv * w4.x; a[4 * q + 1] += xv * w4.y; a[4 * q + 2] += xv * w4.z; a[4 * q + 3] += xv * w4.w; } }
            float mine = 0.f;
#pragma unroll
            for (int r = 0; r < 16; ++r) { const float s = wave_sum(a[r]); mine = (F.lane == r) ? s : mine; }
            if (F.lane < 16) lr[(size_t)m * 16 + F.lane] = mine;
        }
    }
    SEAM(0);

    if (IN(1)) {
        pg8::DenseOrder S; S.init(T, LD0, F.G, (int)blockIdx.x); pg8::PlainMap MP; pg8::EpiBf16 E{HC0, LD0};
        pg8::gemm_phase(F.lds, XN, D, (const bf16_t*)(F.ws + WS_WIN0), D, S, MP, E);
    }
    SEAM(1);

    if (IN(2)) {
        {
            const float* qn = inptr(I_QNORM); const float* kn = inptr(I_KNORM);
            const int sub = F.lane & 7; float wq[8], wk[8];
#pragma unroll
            for (int e = 0; e < 8; ++e) { wq[e] = qn[8 * sub + e] * 0.125f; wk[e] = kn[8 * sub + e]; }
            const long nrows = (long)T * 16;
            for (long r0 = (long)F.gw * 8; r0 < nrows; r0 += (long)F.NGW * 8) {
                const long r = r0 + (F.lane >> 3); const int t = (int)(r >> 4), wh = (int)(r & 15), isk = wh >> 3, h = wh & 7;
                bf16_t* p = HC0 + (size_t)t * LD0 + (isk ? C0_KB : C0_QB) + h * 64 + 8 * sub;
                const u32x4 raw = *(const u32x4*)p; float x[8];
                x[0] = __uint_as_float(raw.x << 16); x[1] = __uint_as_float(raw.x & 0xffff0000u); x[2] = __uint_as_float(raw.y << 16); x[3] = __uint_as_float(raw.y & 0xffff0000u);
                x[4] = __uint_as_float(raw.z << 16); x[5] = __uint_as_float(raw.z & 0xffff0000u); x[6] = __uint_as_float(raw.w << 16); x[7] = __uint_as_float(raw.w & 0xffff0000u);
                float ss = 0.f;
#pragma unroll
                for (int e = 0; e < 8; ++e) ss += x[e] * x[e];
                ss += __shfl_xor(ss, 1); ss += __shfl_xor(ss, 2); ss += __shfl_xor(ss, 4);
                const float rs = 1.f / sqrtf(ss * (1.f / 64.f) + NORM_EPS);
#pragma unroll
                for (int e = 0; e < 8; ++e) x[e] = x[e] * rs * (isk ? wk[e] : wq[e]);
                u32x4 o; o.x = pk2(x[0], x[1]); o.y = pk2(x[2], x[3]); o.z = pk2(x[4], x[5]); o.w = pk2(x[6], x[7]);
                *(u32x4*)p = o;
            }
        }
        {
            const float* lr = (const float*)(F.ws + WS_LR); const float* wgu = inptr(I_WGATEUP); const float* bg = inptr(I_BGATE);
            bf16_t* att = (bf16_t*)(big + B_ATT0); bf16_t* kendT = (bf16_t*)(big + B_KENDT); float* decay = (float*)(F.ws + WS_DECAY);
            LAS float* qd_s = (LAS float*)F.lds;
            LAS float* ki_s = qd_s + 64 * 128;
            LAS float* grp = ki_s + 64 * 129;
            const int dk = F.tid & 127, sg = F.tid >> 7;
            for (int unit = blockIdx.x; unit < 2048; unit += F.G) {
                const int h = unit & 3, bn = unit >> 2, t0 = bn * 64;
                const int col = h * 128 + dk;
                float w16[16];
#pragma unroll
                for (int r = 0; r < 16; ++r) w16[r] = wgu[r * 512 + col];
                const float bias = bg[col];
                float cum[16]; float run = 0.f;
#pragma unroll
                for (int i = 0; i < 16; ++i) { const int t = t0 + 16 * sg + i; const f32x4* lp = (const f32x4*)(lr + (size_t)t * 16); float z = bias;
#pragma unroll
                    for (int q = 0; q < 4; ++q) { const f32x4 l4 = lp[q]; z += l4.x * w16[4 * q] + l4.y * w16[4 * q + 1] + l4.z * w16[4 * q + 2] + l4.w * w16[4 * q + 3]; }
                    run += logsigmoid_f(z) * (1.f / 16.f); cum[i] = run; }
                __syncthreads();
                grp[sg * 128 + dk] = run;
                __syncthreads();
                float off = 0.f, total = 0.f;
#pragma unroll
                for (int g = 0; g < 4; ++g) { const float gs = grp[g * 128 + dk]; total += gs; off += (g < sg) ? gs : 0.f; }
                unsigned kep[8];
#pragma unroll
                for (int i = 0; i < 16; ++i) { const int s = 16 * sg + i, t = t0 + s; const float c = off + cum[i];
                    bf16_t* qp = HC0 + (size_t)t * LD0 + C0_QA + col; const float q = bf2f(*qp), k = bf2f(HC0[(size_t)t * LD0 + C0_KA + col]);
                    const unsigned qdb = f2bf(q * __expf(c) * 0.08838834764831845f); *qp = (bf16_t)qdb; qd_s[s * 128 + dk] = __uint_as_float(qdb << 16);
                    ki_s[s * 129 + dk] = bfround(k * __expf(-c));
                    const unsigned keb = f2bf(k * __expf(total - c)); if (i & 1) kep[i >> 1] |= keb << 16; else kep[i >> 1] = keb; }
                { u32x4* kp = (u32x4*)(kendT + ((size_t)unit * 128 + dk) * 64 + 16 * sg); kp[0] = (u32x4){kep[0], kep[1], kep[2], kep[3]}; kp[1] = (u32x4){kep[4], kep[5], kep[6], kep[7]}; }
                if (sg == 0) decay[unit * 128 + dk] = __expf(total);
                __syncthreads();
#pragma unroll 1
                for (int i = 0; i < 8; ++i) { const int p = F.tid + 512 * i, s = p >> 6, s2 = p & 63; float a = 0.f;
                    if (s2 <= s) { for (int d = 0; d < 128; ++d) a += qd_s[s * 128 + d] * ki_s[s2 * 129 + d]; }
                    att[(size_t)unit * 4096 + p] = (bf16_t)f2bf(a); }
            }
            __syncthreads();
        }
    }
    SEAM(2);

    if (IN(3)) {
        const bf16_t* att = (const bf16_t*)(big + B_ATT0); const bf16_t* kendT = (const bf16_t*)(big + B_KENDT); const float* decay = (const float*)(F.ws + WS_DECAY);
        LAS float* att_s = (LAS float*)F.lds;
        LAS float* qd_s = att_s + 64 * 65;
        LAS float* ke_s = qd_s + 64 * 129;
        LAS float* v_s = ke_s + 128 * 65;
        LAS float* S_s = v_s + 64 * 16;
        LAS float* dc_s = S_s + 128 * 16;
        for (int item = blockIdx.x; item < 256; item += F.G) {
            const int sl = item & 15, h = (item >> 4) & 3, b = item >> 6;
            for (int i = F.tid; i < 128 * 16; i += NTHREADS) S_s[i] = 0.f;
            __syncthreads();
            for (int n = 0; n < 128; ++n) {
                const int unit = (b * 128 + n) * 4 + h, t0 = b * SEQ + n * 64;
                { const u32x4 raw = *(const u32x4*)(att + (size_t)unit * 4096 + F.tid * 8); const int s = F.tid >> 3, c0 = (F.tid & 7) * 8; LAS float* d = att_s + s * 65 + c0;
                  d[0] = __uint_as_float(raw.x << 16); d[1] = __uint_as_float(raw.x & 0xffff0000u); d[2] = __uint_as_float(raw.y << 16); d[3] = __uint_as_float(raw.y & 0xffff0000u);
                  d[4] = __uint_as_float(raw.z << 16); d[5] = __uint_as_float(raw.z & 0xffff0000u); d[6] = __uint_as_float(raw.w << 16); d[7] = __uint_as_float(raw.w & 0xffff0000u); }
#pragma unroll
                for (int rep = 0; rep < 2; ++rep) { const int ch = F.tid + 512 * rep;
                    { const int s = ch >> 4, c0 = (ch & 15) * 8; const u32x4 raw = *(const u32x4*)(HC0 + (size_t)(t0 + s) * LD0 + C0_QA + h * 128 + c0); LAS float* d = qd_s + s * 129 + c0;
                      d[0] = __uint_as_float(raw.x << 16); d[1] = __uint_as_float(raw.x & 0xffff0000u); d[2] = __uint_as_float(raw.y << 16); d[3] = __uint_as_float(raw.y & 0xffff0000u);
                      d[4] = __uint_as_float(raw.z << 16); d[5] = __uint_as_float(raw.z & 0xffff0000u); d[6] = __uint_as_float(raw.w << 16); d[7] = __uint_as_float(raw.w & 0xffff0000u); }
                    { const int dk = ch >> 3, c0 = (ch & 7) * 8; const u32x4 raw = *(const u32x4*)(kendT + ((size_t)unit * 128 + dk) * 64 + c0); LAS float* d = ke_s + dk * 65 + c0;
                      d[0] = __uint_as_float(raw.x << 16); d[1] = __uint_as_float(raw.x & 0xffff0000u); d[2] = __uint_as_float(raw.y << 16); d[3] = __uint_as_float(raw.y & 0xffff0000u);
                      d[4] = __uint_as_float(raw.z << 16); d[5] = __uint_as_float(raw.z & 0xffff0000u); d[6] = __uint_as_float(raw.w << 16); d[7] = __uint_as_float(raw.w & 0xffff0000u); } }
                if (F.tid < 128) { const int s = F.tid >> 1, c0 = (F.tid & 1) * 8; const u32x4 raw = *(const u32x4*)(HC0 + (size_t)(t0 + s) * LD0 + C0_VA + h * 256 + sl * 16 + c0); LAS float* d = v_s + s * 16 + c0;
                    d[0] = __uint_as_float(raw.x << 16); d[1] = __uint_as_float(raw.x & 0xffff0000u); d[2] = __uint_as_float(raw.y << 16); d[3] = __uint_as_float(raw.y & 0xffff0000u);
                    d[4] = __uint_as_float(raw.z << 16); d[5] = __uint_as_float(raw.z & 0xffff0000u); d[6] = __uint_as_float(raw.w << 16); d[7] = __uint_as_float(raw.w & 0xffff0000u); }
                else if (F.tid < 256) dc_s[F.tid - 128] = decay[unit * 128 + F.tid - 128];
                __syncthreads();
                { const int s = F.tid >> 3, dv = (F.tid & 7) * 2; float o0 = 0.f, o1 = 0.f;
                  for (int j = 0; j < 64; ++j) { const float a = att_s[s * 65 + j]; o0 += a * v_s[j * 16 + dv]; o1 += a * v_s[j * 16 + dv + 1]; }
                  for (int d = 0; d < 128; ++d) { const float q = qd_s[s * 129 + d]; o0 += q * S_s[d * 16 + dv]; o1 += q * S_s[d * 16 + dv + 1]; }
                  *(unsigned*)(HC0 + (size_t)(t0 + s) * LD0 + C0_VA + h * 256 + sl * 16 + dv) = pk2(o0, o1); }
                __syncthreads();
                { const int dk = F.tid >> 2, dv = (F.tid & 3) * 4; const float dc = dc_s[dk]; float a0 = S_s[dk * 16 + dv] * dc, a1 = S_s[dk * 16 + dv + 1] * dc, a2 = S_s[dk * 16 + dv + 2] * dc, a3 = S_s[dk * 16 + dv + 3] * dc;
                  for (int s = 0; s < 64; ++s) { const float k = ke_s[dk * 65 + s]; a0 += k * v_s[s * 16 + dv]; a1 += k * v_s[s * 16 + dv + 1]; a2 += k * v_s[s * 16 + dv + 2]; a3 += k * v_s[s * 16 + dv + 3]; }
                  S_s[dk * 16 + dv] = a0; S_s[dk * 16 + dv + 1] = a1; S_s[dk * 16 + dv + 2] = a2; S_s[dk * 16 + dv + 3] = a3; }
                __syncthreads();
            }
        }
    }
    SEAM(3);

    if (IN(4)) {
        float* lse = (float*)(F.ws + WS_LSE);
        const long nitem = 3L * NBATCH * 8 * SEQ;
        for (long idx = gtid; idx < nitem; idx += NT) {
            const int t = (int)(idx % SEQ); long r = idx / SEQ; const int h = (int)(r % 8); r /= 8; const int b = (int)(r % NBATCH); const int p = (int)(r / NBATCH);
            const int d = p == 0 ? 1 : (p == 1 ? 4 : 16);
            const float slope = exp2f(-(float)(h + 1));
            bf16_t* op = (p < 2) ? (bf16_t*)(F.ws + WS_XN) + (size_t)p * T * 512 : (bf16_t*)(big + B_OP2);
            float q[64], o[64];
            { const u32x4* qp = (const u32x4*)(HC0 + (size_t)(b * SEQ + t) * LD0 + C0_QB + h * 64);
#pragma unroll
              for (int c = 0; c < 8; ++c) { const u32x4 raw = qp[c]; q[8 * c] = __uint_as_float(raw.x << 16); q[8 * c + 1] = __uint_as_float(raw.x & 0xffff0000u); q[8 * c + 2] = __uint_as_float(raw.y << 16); q[8 * c + 3] = __uint_as_float(raw.y & 0xffff0000u);
                  q[8 * c + 4] = __uint_as_float(raw.z << 16); q[8 * c + 5] = __uint_as_float(raw.z & 0xffff0000u); q[8 * c + 6] = __uint_as_float(raw.w << 16); q[8 * c + 7] = __uint_as_float(raw.w & 0xffff0000u); } }
#pragma unroll
            for (int c = 0; c < 64; ++c) o[c] = 0.f;
            float m = -1e30f, l = 0.f;
            for (int j = 0; j <= 128; ++j) { const int tk = t - j * d; if (tk < 0) break;
                const u32x4* kp = (const u32x4*)(HC0 + (size_t)(b * SEQ + tk) * LD0 + C0_KB + h * 64); float s = 0.f;
#pragma unroll
                for (int c = 0; c < 8; ++c) { const u32x4 raw = kp[c]; s += q[8 * c] * __uint_as_float(raw.x << 16) + q[8 * c + 1] * __uint_as_float(raw.x & 0xffff0000u) + q[8 * c + 2] * __uint_as_float(raw.y << 16) + q[8 * c + 3] * __uint_as_float(raw.y & 0xffff0000u)
                      + q[8 * c + 4] * __uint_as_float(raw.z << 16) + q[8 * c + 5] * __uint_as_float(raw.z & 0xffff0000u) + q[8 * c + 6] * __uint_as_float(raw.w << 16) + q[8 * c + 7] * __uint_as_float(raw.w & 0xffff0000u); }
                s -= slope * (float)(j * d);
                const float mn = fmaxf(m, s), sc = __expf(m - mn), pe = __expf(s - mn); m = mn; l = l * sc + pe;
                const u32x4* vp = (const u32x4*)(HC0 + (size_t)(b * SEQ + tk) * LD0 + C0_VB + h * 64);
#pragma unroll
                for (int c = 0; c < 8; ++c) { const u32x4 raw = vp[c]; o[8 * c] = o[8 * c] * sc + pe * __uint_as_float(raw.x << 16); o[8 * c + 1] = o[8 * c + 1] * sc + pe * __uint_as_float(raw.x & 0xffff0000u);
                    o[8 * c + 2] = o[8 * c + 2] * sc + pe * __uint_as_float(raw.y << 16); o[8 * c + 3] = o[8 * c + 3] * sc + pe * __uint_as_float(raw.y & 0xffff0000u);
                    o[8 * c + 4] = o[8 * c + 4] * sc + pe * __uint_as_float(raw.z << 16); o[8 * c + 5] = o[8 * c + 5] * sc + pe * __uint_as_float(raw.z & 0xffff0000u);
                    o[8 * c + 6] = o[8 * c + 6] * sc + pe * __uint_as_float(raw.w << 16); o[8 * c + 7] = o[8 * c + 7] * sc + pe * __uint_as_float(raw.w & 0xffff0000u); } }
            const float il = 1.f / l;
            u32x4* dst = (u32x4*)(op + (size_t)(b * SEQ + t) * 512 + h * 64);
#pragma unroll
            for (int c = 0; c < 8; ++c) dst[c] = (u32x4){pk2(o[8 * c] * il, o[8 * c + 1] * il), pk2(o[8 * c + 2] * il, o[8 * c + 3] * il), pk2(o[8 * c + 4] * il, o[8 * c + 5] * il), pk2(o[8 * c + 6] * il, o[8 * c + 7] * il)};
            lse[((size_t)p * T + b * SEQ + t) * 8 + h] = m + __logf(l);
        }
    }
    SEAM(4);

    if (IN(5)) {
        const float* gn = inptr(I_GLANORM); const float* lse = (const float*)(F.ws + WS_LSE);
        float gw16[16];
#pragma unroll
        for (int e = 0; e < 16; ++e) gw16[e] = gn[(16 * F.lane + e) & 255];
        for (int t = F.gw; t < T; t += F.NGW) {
            bf16_t* row = HC0 + (size_t)t * LD0;
            { const u32x4* op = (const u32x4*)(row + C0_VA + 16 * F.lane); u32x4* rp = (u32x4*)(row + C0_RA + 16 * F.lane); float o[16], g[16];
#pragma unroll
              for (int c = 0; c < 2; ++c) { const u32x4 a = op[c], r4 = rp[c];
                  o[8 * c] = __uint_as_float(a.x << 16); o[8 * c + 1] = __uint_as_float(a.x & 0xffff0000u); o[8 * c + 2] = __uint_as_float(a.y << 16); o[8 * c + 3] = __uint_as_float(a.y & 0xffff0000u);
                  o[8 * c + 4] = __uint_as_float(a.z << 16); o[8 * c + 5] = __uint_as_float(a.z & 0xffff0000u); o[8 * c + 6] = __uint_as_float(a.w << 16); o[8 * c + 7] = __uint_as_float(a.w & 0xffff0000u);
                  g[8 * c] = __uint_as_float(r4.x << 16); g[8 * c + 1] = __uint_as_float(r4.x & 0xffff0000u); g[8 * c + 2] = __uint_as_float(r4.y << 16); g[8 * c + 3] = __uint_as_float(r4.y & 0xffff0000u);
                  g[8 * c + 4] = __uint_as_float(r4.z << 16); g[8 * c + 5] = __uint_as_float(r4.z & 0xffff0000u); g[8 * c + 6] = __uint_as_float(r4.w << 16); g[8 * c + 7] = __uint_as_float(r4.w & 0xffff0000u); }
              float ss = 0.f;
#pragma unroll
              for (int e = 0; e < 16; ++e) ss += o[e] * o[e];
              ss += __shfl_xor(ss, 1); ss += __shfl_xor(ss, 2); ss += __shfl_xor(ss, 4); ss += __shfl_xor(ss, 8);
              const float rs = 1.f / sqrtf(ss * (1.f / 256.f) + NORM_EPS);
#pragma unroll
              for (int e = 0; e < 16; ++e) o[e] = o[e] * rs * gw16[e] * silu_f(g[e]);
#pragma unroll
              for (int c = 0; c < 2; ++c) rp[c] = (u32x4){pk2(o[8 * c], o[8 * c + 1]), pk2(o[8 * c + 2], o[8 * c + 3]), pk2(o[8 * c + 4], o[8 * c + 5]), pk2(o[8 * c + 6], o[8 * c + 7])}; }
            { const int hh = F.lane >> 3; const float l0 = lse[((size_t)0 * T + t) * 8 + hh], l1 = lse[((size_t)1 * T + t) * 8 + hh], l2 = lse[((size_t)2 * T + t) * 8 + hh];
              const float mx = fmaxf(l0, fmaxf(l1, l2)); float w0 = __expf(l0 - mx), w1 = __expf(l1 - mx), w2 = __expf(l2 - mx); const float iw = 1.f / (w0 + w1 + w2); w0 *= iw; w1 *= iw; w2 *= iw;
              const u32x4 a = *(const u32x4*)((const bf16_t*)(F.ws + WS_XN) + (size_t)t * 512 + 8 * F.lane), bq = *(const u32x4*)((const bf16_t*)(F.ws + WS_XN) + (size_t)(T + t) * 512 + 8 * F.lane), c = *(const u32x4*)((const bf16_t*)(big + B_OP2) + (size_t)t * 512 + 8 * F.lane);
              float r[8];
              r[0] = w0 * __uint_as_float(a.x << 16) + w1 * __uint_as_float(bq.x << 16) + w2 * __uint_as_float(c.x << 16); r[1] = w0 * __uint_as_float(a.x & 0xffff0000u) + w1 * __uint_as_float(bq.x & 0xffff0000u) + w2 * __uint_as_float(c.x & 0xffff0000u);
              r[2] = w0 * __uint_as_float(a.y << 16) + w1 * __uint_as_float(bq.y << 16) + w2 * __uint_as_float(c.y << 16); r[3] = w0 * __uint_as_float(a.y & 0xffff0000u) + w1 * __uint_as_float(bq.y & 0xffff0000u) + w2 * __uint_as_float(c.y & 0xffff0000u);
              r[4] = w0 * __uint_as_float(a.z << 16) + w1 * __uint_as_float(bq.z << 16) + w2 * __uint_as_float(c.z << 16); r[5] = w0 * __uint_as_float(a.z & 0xffff0000u) + w1 * __uint_as_float(bq.z & 0xffff0000u) + w2 * __uint_as_float(c.z & 0xffff0000u);
              r[6] = w0 * __uint_as_float(a.w << 16) + w1 * __uint_as_float(bq.w << 16) + w2 * __uint_as_float(c.w << 16); r[7] = w0 * __uint_as_float(a.w & 0xffff0000u) + w1 * __uint_as_float(bq.w & 0xffff0000u) + w2 * __uint_as_float(c.w & 0xffff0000u);
              *(u32x4*)(row + C0_QB + 8 * F.lane) = (u32x4){pk2(r[0], r[1]), pk2(r[2], r[3]), pk2(r[4], r[5]), pk2(r[6], r[7])}; }
        }
    }
    SEAM(5);

    if (IN(6)) {
        pg8::DenseOrder S; S.init(T, D, F.G, (int)blockIdx.x); pg8::PlainMap MP; pg8::EpiResF32 E{inptr(I_X), F.out, D};
        pg8::gemm_phase(F.lds, HC0 + C0_RA, LD0, (const bf16_t*)(F.ws + WS_WOUT0), MIX0, S, MP, E);
    }
    SEAM(6);

    if (IN(7)) { for (int m = F.gw; m < T; m += F.NGW) { f32x4 v[4]; rmsnorm_row(F.out + (size_t)m * D, inptr(I_FN0), XN + (size_t)m * D, F.lane, v); } }
    SEAM(7);

    if (IN(8)) {
        pg8::DenseOrder S; S.init(T, 2 * FF0, F.G, (int)blockIdx.x); pg8::PlainMap MP; pg8::EpiSwiGLU E{(bf16_t*)(big + B_H0), FF0};
        pg8::gemm_phase(F.lds, XN, D, (const bf16_t*)(F.ws + WS_WGU0), D, S, MP, E);
    }
    SEAM(8);

    if (IN(9)) {
        pg8::DenseOrder S; S.init(T, D, F.G, (int)blockIdx.x); pg8::PlainMap MP; pg8::EpiResF32 E{F.out, F.out, D};
        pg8::gemm_phase(F.lds, (const bf16_t*)(big + B_H0), FF0, (const bf16_t*)(F.ws + WS_WD0), FF0, S, MP, E);
    }
    SEAM(9);

    if (IN(10)) { for (int m = F.gw; m < T; m += F.NGW) { f32x4 v[4]; rmsnorm_row(F.out + (size_t)m * D, inptr(I_MN1), XN + (size_t)m * D, F.lane, v); } }
    SEAM(10);

    if (IN(11)) {
        pg8::DenseOrder S; S.init(T, LD1, F.G, (int)blockIdx.x); pg8::PlainMap MP; pg8::EpiBf16 E{HC1, LD1};
        pg8::gemm_phase(F.lds, XN, D, (const bf16_t*)(F.ws + WS_WIN1), D, S, MP, E);
    }
    SEAM(11);

    if (IN(12)) {
        bf16_t* att = (bf16_t*)(big + B_ATT1); bf16_t* kdT = (bf16_t*)(F.ws + WS_XN);
        LAS bf16_t* qd_s = (LAS bf16_t*)F.lds;
        LAS bf16_t* ki_s = qd_s + 128 * 258;
        const int dk = F.tid & 255, sg = F.tid >> 8;
        for (int unit = blockIdx.x; unit < 1024; unit += F.G) {
            const int h = unit & 3, bn = unit >> 2, t0 = bn * 128;
            const float lg = log1pf(-exp2f(-5.f - (float)h));
            __syncthreads();
#pragma unroll 1
            for (int i8 = 0; i8 < 8; ++i8) {
                unsigned kp[4];
#pragma unroll
                for (int i = 0; i < 8; ++i) { const int s = 64 * sg + 8 * i8 + i, t = t0 + s;
                    bf16_t* qp = HC1 + (size_t)t * LD1 + C1_Q + h * 256 + dk; const float q = bf2f(*qp), k = bf2f(HC1[(size_t)t * LD1 + C1_K + h * 256 + dk]);
                    const unsigned qdb = f2bf(q * __expf(lg * (float)(s + 1))); *qp = (bf16_t)qdb; qd_s[s * 258 + dk] = (bf16_t)qdb;
                    ki_s[s * 258 + dk] = (bf16_t)f2bf(k * __expf(-lg * (float)(s + 1)));
                    const unsigned kdb = f2bf(k * __expf(lg * (float)(127 - s)) * 0.0625f); if (i & 1) kp[i >> 1] |= kdb << 16; else kp[i >> 1] = kdb; }
                *(u32x4*)(kdT + ((size_t)unit * 256 + dk) * 128 + 64 * sg + 8 * i8) = (u32x4){kp[0], kp[1], kp[2], kp[3]};
            }
            __syncthreads();
#pragma unroll 1
            for (int i = 0; i < 32; ++i) { const int p = F.tid + 512 * i, s = p >> 7, s2 = p & 127; float a = 0.f;
                if (s2 <= s) { for (int d = 0; d < 256; ++d) a += bf2f(qd_s[s * 258 + d]) * bf2f(ki_s[s2 * 258 + d]); }
                att[(size_t)unit * 16384 + p] = (bf16_t)f2bf(a * 0.0625f); }
        }
        __syncthreads();
    }
    SEAM(12);

    if (IN(13)) {
        const bf16_t* att = (const bf16_t*)(big + B_ATT1); const bf16_t* kdT = (const bf16_t*)(F.ws + WS_XN);
        LAS float* v_s = (LAS float*)F.lds;
        LAS float* S_s = v_s + 128 * 32;
        for (int item = blockIdx.x; item < 256; item += F.G) {
            const int sl = item & 15, h = (item >> 4) & 3, b = item >> 6;
            const float cdec = __expf(128.f * log1pf(-exp2f(-5.f - (float)h)));
            for (int i = F.tid; i < 256 * 33; i += NTHREADS) S_s[i] = 0.f;
            __syncthreads();
            for (int n = 0; n < 64; ++n) {
                const int unit = (b * 64 + n) * 4 + h, t0 = b * SEQ + n * 128;
                { const int s = F.tid >> 2, c0 = (F.tid & 3) * 8; const u32x4 raw = *(const u32x4*)(HC1 + (size_t)(t0 + s) * LD1 + C1_V + h * 512 + sl * 32 + c0); LAS float* d = v_s + s * 32 + c0;
                  d[0] = __uint_as_float(raw.x << 16); d[1] = __uint_as_float(raw.x & 0xffff0000u); d[2] = __uint_as_float(raw.y << 16); d[3] = __uint_as_float(raw.y & 0xffff0000u);
                  d[4] = __uint_as_float(raw.z << 16); d[5] = __uint_as_float(raw.z & 0xffff0000u); d[6] = __uint_as_float(raw.w << 16); d[7] = __uint_as_float(raw.w & 0xffff0000u); }
                __syncthreads();
                { const int s = F.tid >> 2, dv0 = (F.tid & 3) * 8; float o[8];
#pragma unroll
                  for (int e = 0; e < 8; ++e) o[e] = 0.f;
                  const bf16_t* ap = att + (size_t)unit * 16384 + s * 128;
                  for (int j = 0; j <= s; ++j) { const float a = bf2f(ap[j]);
#pragma unroll
                      for (int e = 0; e < 8; ++e) o[e] += a * v_s[j * 32 + dv0 + e]; }
                  const bf16_t* qp = HC1 + (size_t)(t0 + s) * LD1 + C1_Q + h * 256;
                  for (int d = 0; d < 256; ++d) { const float q = bf2f(qp[d]);
#pragma unroll
                      for (int e = 0; e < 8; ++e) o[e] += q * S_s[d * 33 + dv0 + e]; }
                  *(u32x4*)(HC1 + (size_t)(t0 + s) * LD1 + C1_V + h * 512 + sl * 32 + dv0) = (u32x4){pk2(o[0], o[1]), pk2(o[2], o[3]), pk2(o[4], o[5]), pk2(o[6], o[7])}; }
                __syncthreads();
                { const int dk = F.tid >> 1, dv0 = (F.tid & 1) * 16; float a[16];
#pragma unroll
                  for (int e = 0; e < 16; ++e) a[e] = S_s[dk * 33 + dv0 + e] * cdec;
                  const bf16_t* kp = kdT + ((size_t)unit * 256 + dk) * 128;
                  for (int s = 0; s < 128; ++s) { const float k = bf2f(kp[s]);
#pragma unroll
                      for (int e = 0; e < 16; ++e) a[e] += k * v_s[s * 32 + dv0 + e]; }
#pragma unroll
                  for (int e = 0; e < 16; ++e) S_s[dk * 33 + dv0 + e] = a[e]; }
                __syncthreads();
            }
        }
    }
    SEAM(13);

    if (IN(14)) {
        const float* gnw = inptr(I_RETGN);
        for (int t = F.gw; t < T; t += F.NGW) {
            bf16_t* row = HC1 + (size_t)t * LD1; const u32x4* op = (const u32x4*)(row + C1_V + 32 * F.lane); u32x4* gp = (u32x4*)(row + C1_G + 32 * F.lane);
            float o[32]; float s = 0.f;
#pragma unroll
            for (int c = 0; c < 4; ++c) { const u32x4 a = op[c];
                o[8 * c] = __uint_as_float(a.x << 16); o[8 * c + 1] = __uint_as_float(a.x & 0xffff0000u); o[8 * c + 2] = __uint_as_float(a.y << 16); o[8 * c + 3] = __uint_as_float(a.y & 0xffff0000u);
                o[8 * c + 4] = __uint_as_float(a.z << 16); o[8 * c + 5] = __uint_as_float(a.z & 0xffff0000u); o[8 * c + 6] = __uint_as_float(a.w << 16); o[8 * c + 7] = __uint_as_float(a.w & 0xffff0000u); }
#pragma unroll
            for (int e = 0; e < 32; ++e) s += o[e];
            s += __shfl_xor(s, 1); s += __shfl_xor(s, 2); s += __shfl_xor(s, 4); s += __shfl_xor(s, 8);
            const float mu = s * (1.f / 512.f); float q = 0.f;
#pragma unroll
            for (int e = 0; e < 32; ++e) { o[e] -= mu; q += o[e] * o[e]; }
            q += __shfl_xor(q, 1); q += __shfl_xor(q, 2); q += __shfl_xor(q, 4); q += __shfl_xor(q, 8);
            const float rs = 1.f / sqrtf(q * (1.f / 512.f) + GN_EPS);
#pragma unroll
            for (int c = 0; c < 4; ++c) { const u32x4 g4 = gp[c]; const f32x4 w0 = *(const f32x4*)(gnw + 32 * F.lane + 8 * c), w1 = *(const f32x4*)(gnw + 32 * F.lane + 8 * c + 4);
                const float g0 = __uint_as_float(g4.x << 16), g1 = __uint_as_float(g4.x & 0xffff0000u), g2 = __uint_as_float(g4.y << 16), g3 = __uint_as_float(g4.y & 0xffff0000u);
                const float g4_ = __uint_as_float(g4.z << 16), g5 = __uint_as_float(g4.z & 0xffff0000u), g6 = __uint_as_float(g4.w << 16), g7 = __uint_as_float(g4.w & 0xffff0000u);
                gp[c] = (u32x4){pk2(o[8 * c] * rs * w0.x * silu_f(g0), o[8 * c + 1] * rs * w0.y * silu_f(g1)), pk2(o[8 * c + 2] * rs * w0.z * silu_f(g2), o[8 * c + 3] * rs * w0.w * silu_f(g3)),
                                pk2(o[8 * c + 4] * rs * w1.x * silu_f(g4_), o[8 * c + 5] * rs * w1.y * silu_f(g5)), pk2(o[8 * c + 6] * rs * w1.z * silu_f(g6), o[8 * c + 7] * rs * w1.w * silu_f(g7))}; }
        }
    }
    SEAM(14);

    if (IN(15)) {
        pg8::DenseOrder S; S.init(T, D, F.G, (int)blockIdx.x); pg8::PlainMap MP; pg8::EpiResF32 E{F.out, F.out, D};
        pg8::gemm_phase(F.lds, HC1 + C1_G, LD1, (const bf16_t*)(F.ws + WS_WOUT1), MIX1, S, MP, E);
    }
    SEAM(15);

    if (IN(16)) {
        LAS float* scr = (LAS float*)(F.lds + F.wave * 16384);
        constexpr int IGU = (D / 64) * (2 * FFE / 32), IDN = (FFE / 64) * (D / 32);
        for (int it = F.gw; it < NEXP * (IGU + IDN); it += F.NGW) {
            const int e = it / (IGU + IDN), r = it % (IGU + IDN);
            if (r < IGU) transpose_gateup(inptr(I_WEG) + (size_t)e * D * FFE, inptr(I_WEU) + (size_t)e * D * FFE, D, FFE, (bf16_t*)(big + B_WEGU) + (size_t)e * 2 * FFE * D, r, scr, F.lane);
            else transpose_plain(inptr(I_WED) + (size_t)e * FFE * D, FFE, D, (bf16_t*)(big + B_WED) + (size_t)e * D * FFE, r - IGU, scr, F.lane);
        }
        int* rowtok = (int*)(F.ws + WS_ROUTE + R_ROWTOK); float* rowgate = (float*)(F.ws + WS_ROUTE + R_ROWGATE);
        for (int i = gtid; i < 2 * MOE_ROWS; i += NT) { rowtok[i] = -1; rowgate[i] = 0.f; }
        f32x4* tokinfo = (f32x4*)(F.ws + WS_ROUTE + R_TOKINFO);
        const float* wr_ = inptr(I_WROUTER);
        for (int m = F.gw; m < T; m += F.NGW) {
            f32x4 v[4]; rmsnorm_row(F.out + (size_t)m * D, inptr(I_FN1), XN + (size_t)m * D, F.lane, v);
            float a[8];
#pragma unroll
            for (int r = 0; r < 8; ++r) a[r] = 0.f;
#pragma unroll
            for (int j = 0; j < 4; ++j)
#pragma unroll
                for (int e = 0; e < 4; ++e) { const int c = 256 * j + 4 * F.lane + e; const f32x4* wp = (const f32x4*)(wr_ + (size_t)c * 8); const float xv = v[j][e]; const f32x4 w0 = wp[0], w1 = wp[1];
                    a[0] += xv * w0.x; a[1] += xv * w0.y; a[2] += xv * w0.z; a[3] += xv * w0.w; a[4] += xv * w1.x; a[5] += xv * w1.y; a[6] += xv * w1.z; a[7] += xv * w1.w; }
#pragma unroll
            for (int r = 0; r < 8; ++r) a[r] = wave_sum(a[r]);
            int e0 = 0; float l0 = a[0];
#pragma unroll
            for (int r = 1; r < 8; ++r) if (a[r] > l0) { l0 = a[r]; e0 = r; }
            int e1 = -1; float l1 = -3.4e38f;
#pragma unroll
            for (int r = 0; r < 8; ++r) if (r != e0 && a[r] > l1) { l1 = a[r]; e1 = r; }
            const float g0 = 1.f / (1.f + __expf(l1 - l0)), g1 = 1.f - g0;
            if (F.lane == 0) tokinfo[m] = (f32x4){__int_as_float(e0), __int_as_float(e1), g0, g1};
        }
    }
    SEAM(16);

    if (IN(17)) {
        if (blockIdx.x == 0) {
            const f32x4* tokinfo = (const f32x4*)(F.ws + WS_ROUTE + R_TOKINFO);
            int* rowtok = (int*)(F.ws + WS_ROUTE + R_ROWTOK); float* rowgate = (float*)(F.ws + WS_ROUTE + R_ROWGATE);
            int* blkexp = (int*)(F.ws + WS_ROUTE + R_BLKEXP); int* nblk = (int*)(F.ws + WS_ROUTE + R_NBLK);
            LAS int* cnt = (LAS int*)F.lds;
            LAS int* tot = cnt + 512 * 17;
            for (int k = 0; k < 16; ++k) cnt[F.tid * 17 + k] = 0;
            for (int i = 0; i < 64; ++i) { const f32x4 ti = tokinfo[F.tid * 64 + i]; cnt[F.tid * 17 + __float_as_int(ti.x)] += 1; cnt[F.tid * 17 + 8 + __float_as_int(ti.y)] += 1; }
            __syncthreads();
            if (F.tid < 16) { int run = 0; for (int i = 0; i < 512; ++i) { const int c = cnt[i * 17 + F.tid]; cnt[i * 17 + F.tid] = run; run += c; } tot[F.tid] = run; }
            __syncthreads();
            if (F.tid < 2) { int ps = 0, nb = 0; for (int e = 0; e < 8; ++e) { tot[16 + F.tid * 8 + e] = ps; const int c = tot[F.tid * 8 + e], bl = (c + 255) >> 8; for (int j = 0; j < bl; ++j) blkexp[F.tid * MOE_BLKS + nb + j] = e; nb += bl; ps += bl * 256; } nblk[F.tid] = nb; }
            __syncthreads();
            for (int i = 0; i < 64; ++i) { const int tok = F.tid * 64 + i; const f32x4 ti = tokinfo[tok]; const int e0 = __float_as_int(ti.x), e1 = __float_as_int(ti.y);
                const int r0 = tot[16 + e0] + cnt[F.tid * 17 + e0]; cnt[F.tid * 17 + e0] += 1; rowtok[r0] = tok; rowgate[r0] = ti.z;
                const int r1 = tot[24 + e1] + cnt[F.tid * 17 + 8 + e1]; cnt[F.tid * 17 + 8 + e1] += 1; rowtok[MOE_ROWS + r1] = tok; rowgate[MOE_ROWS + r1] = ti.w; }
        }
    }
    SEAM(17);

#pragma unroll
    for (int slot = 0; slot < 2; ++slot) {
        if (IN(18 + 2 * slot)) {
            const int* rowtok = (const int*)(F.ws + WS_ROUTE + R_ROWTOK) + slot * MOE_ROWS; const int* blkexp = (const int*)(F.ws + WS_ROUTE + R_BLKEXP) + slot * MOE_BLKS;
            const int nb = ((const int*)(F.ws + WS_ROUTE + R_NBLK))[slot];
            MoeOrder S; S.init(nb, 2 * FFE / 256, F.G, (int)blockIdx.x); pg8::MoeMap MP{rowtok, blkexp, 2 * FFE}; pg8::EpiSwiGLU E{(bf16_t*)(big + B_HMOE), FFE};
            pg8::gemm_phase(F.lds, XN, D, (const bf16_t*)(big + B_WEGU), D, S, MP, E);
        }
        SEAM(18 + 2 * slot);
        if (IN(19 + 2 * slot)) {
            const int* rowtok = (const int*)(F.ws + WS_ROUTE + R_ROWTOK) + slot * MOE_ROWS; const float* rowgate = (const float*)(F.ws + WS_ROUTE + R_ROWGATE) + slot * MOE_ROWS;
            const int* blkexp = (const int*)(F.ws + WS_ROUTE + R_BLKEXP) + slot * MOE_BLKS; const int nb = ((const int*)(F.ws + WS_ROUTE + R_NBLK))[slot];
            MoeOrder S; S.init(nb, D / 256, F.G, (int)blockIdx.x); pg8::MoeMap MP{nullptr, blkexp, D}; pg8::EpiMoeDown E{F.out, rowtok, rowgate};
            pg8::gemm_phase(F.lds, (const bf16_t*)(big + B_HMOE), FFE, (const bf16_t*)(big + B_WED), FFE, S, MP, E);
        }
        if (slot == 0) SEAM(19);
    }
#undef IN
#undef SEAM
}

#ifndef N_LAUNCH_MODE
#define N_LAUNCH_MODE 0
#endif
extern "C" void kernel_launch(void* const* d_in, const int* in_sizes, int n_in, void* d_out, int out_size, void* d_ws, size_t ws_size, hipStream_t stream) {
    static int grid = 0;
    if (grid == 0) {
        if (n_in != 22 || out_size != T * D || ws_size < WS_END) { fprintf(stderr, "kernel_launch: unexpected shapes (n_in %d out %d ws %zu need %zu)\n", n_in, out_size, ws_size, (size_t)WS_END); grid = -1; return; }
        int dev = 0, cus = 0, per_cu = 0;
        if (hipGetDevice(&dev) != hipSuccess || hipDeviceGetAttribute(&cus, hipDeviceAttributeMultiprocessorCount, dev) != hipSuccess) { grid = -1; return; }
        if (hipFuncSetAttribute((const void*)fwd_kernel, hipFuncAttributeMaxDynamicSharedMemorySize, LDS_BYTES) != hipSuccess) { fprintf(stderr, "kernel_launch: hipFuncSetAttribute failed\n"); grid = -1; return; }
        if (hipOccupancyMaxActiveBlocksPerMultiprocessor(&per_cu, (const void*)fwd_kernel, NTHREADS, LDS_BYTES) != hipSuccess || per_cu < 1) { fprintf(stderr, "kernel_launch: occupancy query says %d\n", per_cu); (void)hipGetLastError(); grid = -1; return; }
        grid = cus;
    }
    if (grid < 0) return;
    (void)hipMemsetAsync((char*)d_ws + WS_CTL, 0, CTL_ZERO_BYTES, stream);
    Args a{};
    for (int i = 0; i < 22; ++i) a.in[i] = (const float*)d_in[i];
    a.out = (float*)d_out; a.ws = (unsigned char*)d_ws;
#if N_LAUNCH_MODE == 1
    a.ph_lo = 0; a.ph_hi = NPHASE;
    hipLaunchKernelGGL(fwd_kernel, dim3(grid), dim3(NTHREADS), LDS_BYTES, stream, a);
#else
    for (int p = 0; p < NPHASE; ++p) { a.ph_lo = p; a.ph_hi = p + 1; hipLaunchKernelGGL(fwd_kernel, dim3(grid), dim3(NTHREADS), LDS_BYTES, stream, a); }
#endif
}
```

```cpp
#include <hip/hip_runtime.h>
#include <cstdio>
#include <cstdint>

#define LAS __attribute__((address_space(3)))
#define GAS __attribute__((address_space(1)))
typedef unsigned short bf16_t;
typedef short bf16x8 __attribute__((ext_vector_type(8)));
typedef float f32x4 __attribute__((ext_vector_type(4)));
typedef float f32x2 __attribute__((ext_vector_type(2)));
typedef unsigned u32x4 __attribute__((ext_vector_type(4)));
typedef unsigned u32x2 __attribute__((ext_vector_type(2)));
typedef GAS unsigned gu32;
#define RLX_AGENT __ATOMIC_RELAXED, __HIP_MEMORY_SCOPE_AGENT
#define LDS_WAIT() asm volatile("s_waitcnt lgkmcnt(0)" ::: "memory")
#define VM_WAIT() asm volatile("s_waitcnt vmcnt(0)" ::: "memory")

constexpr int NBATCH = 4, SEQ = 8192, T = NBATCH * SEQ, D = 1024;
constexpr float NORM_EPS = 1e-6f, GN_EPS = 1e-5f;
constexpr int LDW0 = 4624, LD0 = 4608;
constexpr int C0_QA = 0, C0_KA = 512, C0_VA = 1024, C0_RA = 2048, C0_QB = 3072, C0_KB = 3584, C0_VB = 4096;
constexpr int W0_LR = 3072;
constexpr int MIX0 = 1536, FF0 = 2816;
constexpr int LD1 = 6144, C1_Q = 0, C1_K = 1024, C1_V = 2048, C1_G = 4096, MIX1 = 2048;
constexpr int NEXP = 8, FFE = 3584;
constexpr int MOE_ROWS = 34816, MOE_BLKS = 136;

constexpr size_t MiB = 1u << 20;
constexpr size_t WS_CTL = 0, CTL_ZERO_BYTES = 1 * MiB;
constexpr size_t WS_WIN0 = 1 * MiB, WS_WOUT0 = 10 * MiB, WS_WGU0 = 13 * MiB, WS_WD0 = 24 * MiB, WS_WIN1 = 30 * MiB, WS_WOUT1 = 42 * MiB;
constexpr size_t WS_LR = 46 * MiB, WS_DECAY = 48 * MiB, WS_LSE = 49 * MiB, WS_ROUTE = 52 * MiB;
constexpr size_t WS_XN = 56 * MiB;
constexpr size_t WS_BIG = 120 * MiB;
constexpr size_t B_HCAT0 = 0, B_ATT0 = 288 * MiB, B_KENDT = 304 * MiB, B_OP2 = 336 * MiB;
constexpr size_t B_H0 = 0;
constexpr size_t B_HCAT1 = 0, B_ATT1 = 384 * MiB;
constexpr size_t B_WEGU = 0, B_WED = 112 * MiB, B_HMOE = 168 * MiB;
constexpr size_t WS_END = WS_BIG + 416 * MiB;
constexpr size_t R_TOKINFO = 0, R_ROWTOK = 512 * 1024, R_ROWGATE = R_ROWTOK + 2 * MOE_ROWS * 4, R_BLKEXP = R_ROWGATE + 2 * MOE_ROWS * 4, R_NBLK = R_BLKEXP + 2 * MOE_BLKS * 4;
constexpr int CW_TMO = 0, CW_CODE = 1, CW_BAR = 4096;

constexpr int LDS_BYTES = 147456;
constexpr int RING_BYTES = 131072;
constexpr int LDSCTL_OFF = 139264;
constexpr int NWAVES = 8, NTHREADS = 512;

__device__ __forceinline__ float bf2f(bf16_t b) { return __uint_as_float(((unsigned)b) << 16); }
__device__ __forceinline__ unsigned f2bf(float f) { unsigned u = __float_as_uint(f); return (u + 0x7fffu + ((u >> 16) & 1u)) >> 16; }
__device__ __forceinline__ unsigned pk2(float lo, float hi) { return f2bf(lo) | (f2bf(hi) << 16); }
__device__ __forceinline__ float bfround(float f) { return __uint_as_float(f2bf(f) << 16); }
__device__ __forceinline__ unsigned cvt_pk_bf16(float lo, float hi) { unsigned r; asm volatile("v_cvt_pk_bf16_f32 %0, %1, %2" : "=v"(r) : "v"(lo), "v"(hi)); return r; }
__device__ __forceinline__ float wave_sum(float v) {
#pragma unroll
    for (int o = 1; o < 64; o <<= 1) v += __shfl_xor(v, o);
    return v;
}
__device__ __forceinline__ float silu_f(float v) { return v / (1.f + __expf(-v)); }
__device__ __forceinline__ float logsigmoid_f(float z) { return fminf(z, 0.f) - log1pf(__expf(-fabsf(z))); }

#define XB_TMO      128
#define XB_XCNT(j)  (256  + 64 * (j))
#define XB_XSUB(j)  (1280 + 64 * (j))
#define XB_XGEN(j)  (2304 + 64 * (j))
#define XB_TOP      3328
#define XB_TOPGEN   3392
#define XCD_BAR_WORDS 3456
#define XB_SPIN_CAP (1u << 22)
__device__ __forceinline__ unsigned xb_ld(unsigned* p)              { return __hip_atomic_load(p, __ATOMIC_RELAXED, __HIP_MEMORY_SCOPE_AGENT); }
__device__ __forceinline__ unsigned xb_add(unsigned* p, unsigned v) { return __hip_atomic_fetch_add(p, v, __ATOMIC_RELAXED, __HIP_MEMORY_SCOPE_AGENT); }
__device__ __forceinline__ unsigned xb_xcc_id() { return (unsigned)__builtin_amdgcn_s_getreg((3 << 11) | 20) & 0xFu; }
#define XB_SPIN(cond, bar) do { unsigned _sp = 0; while (cond) { __builtin_amdgcn_s_sleep(1); \
    if ((++_sp & 255u) == 0u) { if (xb_ld(&(bar)[XB_TMO])) break; if (_sp > XB_SPIN_CAP) { atomicAdd(&(bar)[XB_TMO], 1u); break; } } } } while (0)
struct XcdBarrier { unsigned* bar; unsigned x; volatile LAS unsigned* st; };
__device__ __forceinline__ XcdBarrier xcd_barrier_post(unsigned* bar, volatile LAS unsigned* st) {
    XcdBarrier b; b.bar = bar; b.x = xb_xcc_id(); b.st = st;
    if (threadIdx.x == 0) (void)xb_add(&bar[XB_XCNT(b.x)], 1u);
    return b;
}
__device__ __forceinline__ void xcd_barrier_complete(unsigned* bar, unsigned x, unsigned& nloc, unsigned& nx) {
    const unsigned G = gridDim.x * gridDim.y * gridDim.z;
    unsigned sum, cnt, mine, sp = 0u;
    for (;;) {
        sum = 0u; cnt = 0u; mine = 0u;
#pragma unroll
        for (unsigned j = 0; j < 16; ++j) { const unsigned c = xb_ld(&bar[XB_XCNT(j)]); sum += c; cnt += (c > 0u) ? 1u : 0u; mine = (j == x) ? c : mine; }
        if (sum == G) break;
        __builtin_amdgcn_s_sleep(1);
        if ((++sp & 255u) == 0u) { if (xb_ld(&bar[XB_TMO])) break; if (sp > XB_SPIN_CAP) { atomicAdd(&bar[XB_TMO], 1u); break; } }
    }
    nloc = mine > 0u ? mine : 1u; nx = cnt > 0u ? cnt : 1u;
}
__device__ __forceinline__ void xcd_barrier(const XcdBarrier& b) {
    asm volatile("s_waitcnt vmcnt(0)" ::: "memory");
    __syncthreads();
    if (threadIdx.x == 0) {
        unsigned* bar = b.bar;
        __builtin_amdgcn_s_waitcnt(0);
        unsigned nloc = b.st[0], nx = b.st[1];
        if (nloc == 0u) { xcd_barrier_complete(bar, b.x, nloc, nx); b.st[0] = nloc; b.st[1] = nx; }
        const unsigned old = xb_add(&bar[XB_XSUB(b.x)], 1u);
        const unsigned gen = old / nloc;
        if (old + 1u == (gen + 1u) * nloc) {
            __builtin_amdgcn_fence(__ATOMIC_RELEASE, "agent");
            asm volatile("s_waitcnt vmcnt(0)" ::: "memory");
            const unsigned og = xb_add(&bar[XB_TOP], 1u);
            const unsigned tg = og / nx;
            if (og + 1u == (tg + 1u) * nx) xb_add(&bar[XB_TOPGEN], 1u);
            else XB_SPIN(xb_ld(&bar[XB_TOPGEN]) == tg, bar);
            __builtin_amdgcn_fence(__ATOMIC_ACQUIRE, "agent");
            xb_add(&bar[XB_XGEN(b.x)], 1u);
            asm volatile("s_waitcnt vmcnt(0)" ::: "memory");
        } else {
            XB_SPIN(xb_ld(&bar[XB_XGEN(b.x)]) == gen, bar);
            __builtin_amdgcn_fence(__ATOMIC_ACQUIRE, "agent");
            asm volatile("s_waitcnt vmcnt(0)" ::: "memory");
        }
    }
    __syncthreads();
}

namespace pg8 {
constexpr int BM = 256, BK = 64, HALF = 128, HTB = HALF * BK * 2, STAGE_BYTES = 8 * HTB;
__device__ __forceinline__ int lds_byte(int r, int c) { const int st = (r >> 4) * 2 + (c >> 5), rr = r & 15, cc = c & 31, ob = rr * 64 + cc * 2; return st * 1024 + (ob ^ (((ob >> 9) & 1) << 5)); }
__device__ __forceinline__ void stage_rc(int b, int& R, int& C) { const int st = b / 1024, sb = b % 1024, swz = sb ^ (((sb >> 9) & 1) << 5); R = (st >> 1) * 16 + swz / 64; C = (st & 1) * 32 + (swz % 64) / 2; }
__device__ __forceinline__ int perm32(int rho) { const int n = rho >> 4, i = rho & 15; return 8 * (i >> 2) + 4 * n + (i & 3); }
struct Unit { int pm, pn; };

struct DenseOrder {
    int nM, nN, nwg, G, c;
    __device__ void init(int M, int N, int G_, int c_) { nM = M / BM; nN = N / BM; nwg = nM * nN; G = G_; c = c_; }
    __device__ bool next(int i, Unit& u) const {
        const long L = (long)i * G + c; if (L >= nwg) return false;
        int wgid = (int)L; { const int q = nwg / 8, r = nwg % 8, xcd = wgid % 8, off = wgid / 8; wgid = (xcd < r ? xcd * (q + 1) : r * (q + 1) + (xcd - r) * q) + off; }
        const int nig = 8 * nN, gid = wgid / nig, fm = gid * 8, gsz = (nM - fm) < 8 ? (nM - fm) : 8;
        u.pm = fm + ((wgid % nig) % gsz); u.pn = (wgid % nig) / gsz; return true;
    }
};
struct PlainMap {
    __device__ __forceinline__ unsigned arow(int pm, int r) const { return (unsigned)(pm * BM + r); }
    __device__ __forceinline__ size_t brow0(const Unit& u) const { return (size_t)u.pn * BM; }
};
struct MoeMap {
    const int* rowtok; const int* blkexp; int nexp_rows;
    __device__ __forceinline__ unsigned arow(int pm, int r) const { if (!rowtok) return (unsigned)(pm * BM + r); const int t = rowtok[pm * BM + r]; return (unsigned)(t < 0 ? 0 : t); }
    __device__ __forceinline__ size_t brow0(const Unit& u) const { return (size_t)blkexp[u.pm] * nexp_rows + (size_t)u.pn * BM; }
};

template <class Epi, class Sched, class Map>
__device__ __forceinline__ void gemm_phase(LAS unsigned char* lds, const bf16_t* A, int lda, const bf16_t* Bt, int K, const Sched& S, const Map& MP, const Epi& E) {
    const int tid = threadIdx.x, wid = __builtin_amdgcn_readfirstlane(tid >> 6), lane = tid & 63, wr = wid >> 2, wc = wid & 3, fr = lane & 15, fq = lane >> 4;
    const int nt = K / BK;
    int Rst[2], Cst[2]; unsigned voffB[2];
#pragma unroll
    for (int i = 0; i < 2; ++i) { int R, C; stage_rc(tid * 16 + i * 8192, R, C); Rst[i] = R; Cst[i] = C; const int Rb = Epi::PERM ? ((R & ~31) + perm32(R & 31)) : R; voffB[i] = (unsigned)(Rb * K + C) * 2u; }
    const size_t kstep = (size_t)(BK * 2);
    const size_t hstepB = (size_t)HALF * K * 2;
    const unsigned ldsw = (unsigned)wid * 1024u;
    const int aoff = lds_byte(wr * 64 + fr, fq * 8), boff = lds_byte(wc * 32 + fr, fq * 8);
#define PG8_SA(b, h) (((b) * 2 + (h)) * HTB)
#define PG8_SB(b, h) ((4 + (b) * 2 + (h)) * HTB)
#define PG8_STAGE(bufoff, gbase, voff) do { _Pragma("unroll") for (int _i = 0; _i < 2; ++_i) \
        __builtin_amdgcn_global_load_lds((const unsigned*)((const char*)(gbase) + (voff)[_i]), (LAS unsigned*)(lds + (bufoff) + ldsw + _i * 8192), 16, 0, 0); } while (0)
#define PG8_LDA(dst, b, h) do { _Pragma("unroll") for (int m = 0; m < 4; ++m) _Pragma("unroll") for (int k = 0; k < 2; ++k) dst[m][k] = *(const LAS bf16x8*)(lds + PG8_SA(b, h) + aoff + m * 2048 + k * 1024); } while (0)
#define PG8_LDB(dst, b, h) do { _Pragma("unroll") for (int n = 0; n < 2; ++n) _Pragma("unroll") for (int k = 0; k < 2; ++k) dst[n][k] = *(const LAS bf16x8*)(lds + PG8_SB(b, h) + boff + n * 2048 + k * 1024); } while (0)
#define PG8_MMA(ai, bj, At, Bt_) do { __builtin_amdgcn_s_setprio(1); _Pragma("unroll") for (int m = 0; m < 4; ++m) _Pragma("unroll") for (int n = 0; n < 2; ++n) _Pragma("unroll") for (int k = 0; k < 2; ++k) \
        acc[ai][bj][m][n] = __builtin_amdgcn_mfma_f32_16x16x32_bf16(Bt_[n][k], At[m][k], acc[ai][bj][m][n], 0, 0, 0); __builtin_amdgcn_s_setprio(0); } while (0)
#define PG8_WAIT_V(n) asm volatile("s_waitcnt vmcnt(" #n ")" ::: "memory")
#define PG8_WAIT_L(n) asm volatile("s_waitcnt lgkmcnt(" #n ")" ::: "memory")
#define PG8_BAR __builtin_amdgcn_s_barrier()
#define PG8_SCHED __builtin_amdgcn_sched_barrier(0)
#define PG8_VOFFA(dst, u_) do { _Pragma("unroll") for (int _h = 0; _h < 2; ++_h) _Pragma("unroll") for (int _i = 0; _i < 2; ++_i) \
        dst[_h][_i] = (MP.arow((u_).pm, _h * HALF + Rst[_i]) * (unsigned)lda + (unsigned)Cst[_i]) * 2u; } while (0)
    Unit cur, nxt; int ui = 0;
    if (!S.next(0, cur)) return;
    f32x4 acc[2][2][4][2];
#pragma unroll
    for (int a = 0; a < 2; ++a)
#pragma unroll
        for (int b = 0; b < 2; ++b)
#pragma unroll
            for (int m = 0; m < 4; ++m)
#pragma unroll
                for (int n = 0; n < 2; ++n) acc[a][b][m][n] = (f32x4){0.f, 0.f, 0.f, 0.f};
    bf16x8 At[4][2], B0[2][2], B1[2][2];
    unsigned vc[2][2], vn[2][2], v2[2][2];
    PG8_VOFFA(vc, cur);
    const char* cA = (const char*)A; const char* cB = (const char*)Bt + MP.brow0(cur) * (size_t)K * 2;
    PG8_STAGE(PG8_SB(0, 0), cB, voffB); PG8_STAGE(PG8_SB(0, 1), cB + hstepB, voffB); PG8_STAGE(PG8_SA(0, 0), cA, vc[0]); PG8_STAGE(PG8_SA(0, 1), cA, vc[1]);
    if (wr == 1) PG8_BAR;
    PG8_WAIT_V(2); PG8_BAR;
    PG8_STAGE(PG8_SB(1, 0), cB + kstep, voffB); PG8_STAGE(PG8_SA(1, 0), cA + kstep, vc[0]); PG8_STAGE(PG8_SB(1, 1), cB + hstepB + kstep, voffB);
    PG8_WAIT_V(6); PG8_BAR;
    for (;;) {
        const bool has_next = S.next(ui + 1, nxt);
        const char* nB = cB;
        if (has_next) { PG8_VOFFA(vn, nxt); nB = (const char*)Bt + MP.brow0(nxt) * (size_t)K * 2; }
        else {
#pragma unroll
            for (int h = 0; h < 2; ++h)
#pragma unroll
                for (int i = 0; i < 2; ++i) vn[h][i] = vc[h][i];
        }
        for (int t = 0; t < nt; t += 2) {
            const bool last = (t == nt - 2);
            const char* a1 = cA + (size_t)(t + 1) * kstep;
            const char* a2 = last ? cA : cA + (size_t)(t + 2) * kstep; const char* b2 = last ? nB : cB + (size_t)(t + 2) * kstep;
            const char* a3 = a2 + kstep; const char* b3 = b2 + kstep;
#pragma unroll
            for (int h = 0; h < 2; ++h)
#pragma unroll
                for (int i = 0; i < 2; ++i) v2[h][i] = last ? vn[h][i] : vc[h][i];
            PG8_LDB(B0, 0, 0); PG8_LDB(B1, 0, 1); PG8_SCHED; PG8_LDA(At, 0, 0); PG8_STAGE(PG8_SA(1, 1), a1, vc[1]);
            PG8_WAIT_V(8); PG8_WAIT_L(0); PG8_BAR; PG8_MMA(0, 0, At, B0); PG8_MMA(0, 1, At, B1); PG8_BAR; PG8_SCHED;
            PG8_LDA(At, 0, 1); PG8_STAGE(PG8_SB(0, 0), b2, voffB); PG8_STAGE(PG8_SB(0, 1), b2 + hstepB, voffB); PG8_STAGE(PG8_SA(0, 0), a2, v2[0]);
            PG8_WAIT_V(8); PG8_WAIT_L(0); PG8_BAR; PG8_MMA(1, 0, At, B0); PG8_MMA(1, 1, At, B1); PG8_BAR; PG8_SCHED;
            PG8_LDB(B0, 1, 0); PG8_LDB(B1, 1, 1); PG8_SCHED; PG8_LDA(At, 1, 0); PG8_STAGE(PG8_SA(0, 1), a2, v2[1]);
            PG8_WAIT_V(8); PG8_WAIT_L(0); PG8_BAR; PG8_MMA(0, 0, At, B0); PG8_MMA(0, 1, At, B1); PG8_BAR; PG8_SCHED;
            PG8_LDA(At, 1, 1); PG8_STAGE(PG8_SB(1, 0), b3, voffB); PG8_STAGE(PG8_SB(1, 1), b3 + hstepB, voffB); PG8_STAGE(PG8_SA(1, 0), a3, v2[0]);
            PG8_WAIT_V(8); PG8_WAIT_L(0); PG8_BAR; PG8_MMA(1, 0, At, B0); PG8_MMA(1, 1, At, B1); PG8_BAR; PG8_SCHED;
        }
        if (wr == 0) PG8_BAR;
        E(acc, cur, wr, wc, fr, fq);
        if (!has_next) break;
#pragma unroll
        for (int a = 0; a < 2; ++a)
#pragma unroll
            for (int b = 0; b < 2; ++b)
#pragma unroll
                for (int m = 0; m < 4; ++m)
#pragma unroll
                    for (int n = 0; n < 2; ++n) acc[a][b][m][n] = (f32x4){0.f, 0.f, 0.f, 0.f};
        cur = nxt; cB = nB; ++ui;
#pragma unroll
        for (int h = 0; h < 2; ++h)
#pragma unroll
            for (int i = 0; i < 2; ++i) vc[h][i] = vn[h][i];
        if (wr == 1) PG8_BAR;
    }
    PG8_WAIT_V(0);
    PG8_BAR;
#undef PG8_SA
#undef PG8_SB
#undef PG8_STAGE
#undef PG8_LDA
#undef PG8_LDB
#undef PG8_MMA
#undef PG8_WAIT_V
#undef PG8_WAIT_L
#undef PG8_BAR
#undef PG8_SCHED
#undef PG8_VOFFA
}

struct EpiBf16 {
    static constexpr bool PERM = true;
    bf16_t* O; int ldc;
    __device__ __forceinline__ void operator()(const f32x4 (&acc)[2][2][4][2], const Unit& u, int wr, int wc, int fr, int fq) const {
        const int row0 = u.pm * BM + wr * 64 + fr, col0 = u.pn * BM + wc * 32 + 8 * fq;
#pragma unroll
        for (int ai = 0; ai < 2; ++ai)
#pragma unroll
            for (int m = 0; m < 4; ++m) { bf16_t* rowp = O + (size_t)(row0 + ai * HALF + m * 16) * ldc + col0;
#pragma unroll
                for (int bj = 0; bj < 2; ++bj) { const f32x4 v0 = acc[ai][bj][m][0], v1 = acc[ai][bj][m][1];
                    u32x4 w; w.x = cvt_pk_bf16(v0[0], v0[1]); w.y = cvt_pk_bf16(v0[2], v0[3]); w.z = cvt_pk_bf16(v1[0], v1[1]); w.w = cvt_pk_bf16(v1[2], v1[3]);
                    *(u32x4*)(rowp + bj * HALF) = w; } }
    }
};
struct EpiSwiGLU {
    static constexpr bool PERM = true;
    bf16_t* H; int ldh;
    __device__ __forceinline__ void operator()(const f32x4 (&acc)[2][2][4][2], const Unit& u, int wr, int wc, int fr, int fq) const {
        const int row0 = u.pm * BM + wr * 64 + fr, col0 = u.pn * HALF + wc * 32 + 8 * fq;
#pragma unroll
        for (int ai = 0; ai < 2; ++ai)
#pragma unroll
            for (int m = 0; m < 4; ++m) { bf16_t* rowp = H + (size_t)(row0 + ai * HALF + m * 16) * ldh + col0;
                f32x4 h0, h1;
#pragma unroll
                for (int j = 0; j < 4; ++j) { const float g0 = acc[ai][0][m][0][j], g1 = acc[ai][0][m][1][j];
                    h0[j] = g0 * __builtin_amdgcn_rcpf(1.f + __expf(-g0)) * acc[ai][1][m][0][j]; h1[j] = g1 * __builtin_amdgcn_rcpf(1.f + __expf(-g1)) * acc[ai][1][m][1][j]; }
                u32x4 w; w.x = cvt_pk_bf16(h0[0], h0[1]); w.y = cvt_pk_bf16(h0[2], h0[3]); w.z = cvt_pk_bf16(h1[0], h1[1]); w.w = cvt_pk_bf16(h1[2], h1[3]);
                *(u32x4*)rowp = w; }
    }
};
struct EpiResF32 {
    static constexpr bool PERM = false;
    const float* base; float* out; int ldc;
    __device__ __forceinline__ void operator()(const f32x4 (&acc)[2][2][4][2], const Unit& u, int wr, int wc, int fr, int fq) const {
        const int row0 = u.pm * BM + wr * 64 + fr, col0 = u.pn * BM + wc * 32 + 4 * fq;
#pragma unroll
        for (int ai = 0; ai < 2; ++ai)
#pragma unroll
            for (int m = 0; m < 4; ++m) { const size_t off = (size_t)(row0 + ai * HALF + m * 16) * ldc + col0;
#pragma unroll
                for (int bj = 0; bj < 2; ++bj)
#pragma unroll
                    for (int n = 0; n < 2; ++n) { const f32x4 bs = *(const f32x4*)(base + off + bj * HALF + n * 16); *(f32x4*)(out + off + bj * HALF + n * 16) = bs + acc[ai][bj][m][n]; } }
    }
};
struct EpiMoeDown {
    static constexpr bool PERM = false;
    float* out; const int* rowtok; const float* rowgate;
    __device__ __forceinline__ void operator()(const f32x4 (&acc)[2][2][4][2], const Unit& u, int wr, int wc, int fr, int fq) const {
        const int row0 = u.pm * BM + wr * 64 + fr, col0 = u.pn * BM + wc * 32 + 4 * fq;
#pragma unroll
        for (int ai = 0; ai < 2; ++ai)
#pragma unroll
            for (int m = 0; m < 4; ++m) { const int r = row0 + ai * HALF + m * 16; const int tok = rowtok[r]; const float g = rowgate[r];
                if (tok >= 0) { float* op = out + (size_t)tok * D + col0;
#pragma unroll
                    for (int bj = 0; bj < 2; ++bj)
#pragma unroll
                        for (int n = 0; n < 2; ++n) { const f32x4 bs = *(const f32x4*)(op + bj * HALF + n * 16); *(f32x4*)(op + bj * HALF + n * 16) = bs + g * acc[ai][bj][m][n]; } } }
    }
};
}

struct MoeOrder {
    int nwg, nN, G, c;
    __device__ void init(int nblk, int nN_, int G_, int c_) { nN = nN_; nwg = nblk * nN_; G = G_; c = c_; }
    __device__ bool next(int i, pg8::Unit& u) const { const long L = (long)i * G + c; if (L >= nwg) return false; u.pm = (int)(L / nN); u.pn = (int)(L % nN); return true; }
};

struct Frame {
    LAS unsigned char* lds;
    gu32* ctl;
    int tid, lane, wave, G, gw, NGW;
    unsigned char* ws;
    float* out;
};
__device__ __forceinline__ const float* inptr(int i) {
    unsigned off = (unsigned)i * 8u; asm volatile("" : "+s"(off));
    return *(const float* const*)((const char*)__builtin_amdgcn_kernarg_segment_ptr() + off);
}
enum { I_X = 0, I_MN0, I_WIN0, I_WGATEUP, I_BGATE, I_GLANORM, I_QNORM, I_KNORM, I_WOUT0, I_FN0, I_WFG, I_WFU, I_WFD, I_MN1, I_WIN1, I_RETGN, I_WOUT1, I_FN1, I_WROUTER, I_WEG, I_WEU, I_WED };

__device__ __forceinline__ void transpose_item(const float* W, int ldw, int src_col0, bf16_t* WT, int ldt, int dst_row0, int k0, LAS float* scr, int lane) {
#pragma unroll 8
    for (int i = 0; i < 32; ++i) { const int kk = 2 * i + (lane >> 5); scr[kk * 33 + (lane & 31)] = W[(size_t)(k0 + kk) * ldw + src_col0 + (lane & 31)]; }
    LDS_WAIT(); asm volatile("" ::: "memory");
    const int c = lane & 7;
#pragma unroll
    for (int j = 0; j < 4; ++j) { const int n = (lane >> 3) + 8 * j; const LAS float* s = scr + (8 * c) * 33 + n;
        u32x4 o; o.x = pk2(s[0 * 33], s[1 * 33]); o.y = pk2(s[2 * 33], s[3 * 33]); o.z = pk2(s[4 * 33], s[5 * 33]); o.w = pk2(s[6 * 33], s[7 * 33]);
        *(u32x4*)(WT + (size_t)(dst_row0 + n) * ldt + k0 + 8 * c) = o; }
    LDS_WAIT(); asm volatile("" ::: "memory");
}
__device__ __forceinline__ void transpose_plain(const float* W, int K, int N, bf16_t* WT, int it, LAS float* scr, int lane) {
    const int nblk = N / 32, kb = it / nblk, nb = it % nblk; transpose_item(W, N, 32 * nb, WT, K, 32 * nb, 64 * kb, scr, lane);
}
__device__ __forceinline__ void transpose_gateup(const float* Wg, const float* Wu, int K, int F, bf16_t* WT, int it, LAS float* scr, int lane) {
    const int nblk = 2 * F / 32, kb = it / nblk, nb = it % nblk, dr = 32 * nb, tile = dr >> 8, within = dr & 255;
    const float* W = within < 128 ? Wg : Wu; const int sc = tile * 128 + (within & 127);
    transpose_item(W, F, sc, WT, K, dr, 64 * kb, scr, lane);
}

__device__ __forceinline__ void rmsnorm_row(const float* xrow, const float* w, bf16_t* orow, int lane, f32x4 (&v)[4]) {
    const f32x4* xr = (const f32x4*)xrow + lane; float s = 0.f;
#pragma unroll
    for (int j = 0; j < 4; ++j) { v[j] = xr[64 * j]; s += (v[j].x * v[j].x + v[j].y * v[j].y) + (v[j].z * v[j].z + v[j].w * v[j].w); }
    const float r = 1.f / sqrtf(wave_sum(s) * (1.f / D) + NORM_EPS);
    const f32x4* wr = (const f32x4*)w + lane;
    unsigned long long* o8 = (unsigned long long*)orow + lane;
#pragma unroll
    for (int j = 0; j < 4; ++j) { const f32x4 ww = wr[64 * j]; v[j] = v[j] * r * ww; o8[64 * j] = (unsigned long long)pk2(v[j].x, v[j].y) | ((unsigned long long)pk2(v[j].z, v[j].w) << 32); }
}

struct Args { const float* in[22]; float* out; unsigned char* ws; int ph_lo, ph_hi; };
constexpr int NPHASE = 22;

__global__ void __launch_bounds__(NTHREADS, 2) fwd_kernel(Args args) {
    extern __shared__ __attribute__((aligned(16))) unsigned char lds_raw[];
    Frame F;
    F.lds = (LAS unsigned char*)lds_raw;
    F.tid = threadIdx.x; F.lane = F.tid & 63; F.wave = __builtin_amdgcn_readfirstlane(F.tid >> 6);
    F.G = gridDim.x; F.gw = blockIdx.x * NWAVES + F.wave; F.NGW = F.G * NWAVES;
    F.ws = args.ws; F.ctl = (gu32*)(args.ws + WS_CTL); F.out = args.out;
    volatile LAS unsigned* MISC = (volatile LAS unsigned*)(F.lds + LDSCTL_OFF);
    if (F.tid < 64) MISC[F.tid] = 0u;
    __syncthreads();
    const int lo = args.ph_lo, hi = args.ph_hi;
    const bool use_bar = (hi - lo) > 1;
    XcdBarrier bar; bar.bar = (unsigned*)(F.ctl + CW_BAR); bar.x = 0; bar.st = nullptr;
    if (use_bar) bar = xcd_barrier_post((unsigned*)(F.ctl + CW_BAR), MISC + 8);
#ifndef PHMASK
#define PHMASK 0x3fffff
#endif
#define IN(k) (((PHMASK >> (k)) & 1) && lo <= (k) && (k) < hi)
#define SEAM(k) do { if (IN(k) && IN((k) + 1)) xcd_barrier(bar); } while (0)
    unsigned char* const big = F.ws + WS_BIG;
    bf16_t* const XN = (bf16_t*)(F.ws + WS_XN);
    bf16_t* const HC0 = (bf16_t*)(big + B_HCAT0);
    bf16_t* const HC1 = (bf16_t*)(big + B_HCAT1);
    const int NT = F.G * NTHREADS, gtid = blockIdx.x * NTHREADS + F.tid;

    if (IN(0)) {
        LAS float* scr = (LAS float*)(F.lds + F.wave * 16384);
        constexpr int I0 = (D / 64) * (LD0 / 32), I1 = (MIX0 / 64) * (D / 32), I2 = (D / 64) * (2 * FF0 / 32), I3 = (FF0 / 64) * (D / 32), I4 = (D / 64) * (LD1 / 32), I5 = (MIX1 / 64) * (D / 32);
        constexpr int NIT = I0 + I1 + I2 + I3 + I4 + I5;
        for (int it = F.gw; it < NIT; it += F.NGW) {
            int r = it;
            if (r < I0) { const int nblk = LD0 / 32, kb = r / nblk, nb = r % nblk, dr = 32 * nb; transpose_item(inptr(I_WIN0), LDW0, dr < W0_LR ? dr : dr + 16, (bf16_t*)(F.ws + WS_WIN0), D, dr, 64 * kb, scr, F.lane); continue; } r -= I0;
            if (r < I1) { transpose_plain(inptr(I_WOUT0), MIX0, D, (bf16_t*)(F.ws + WS_WOUT0), r, scr, F.lane); continue; } r -= I1;
            if (r < I2) { transpose_gateup(inptr(I_WFG), inptr(I_WFU), D, FF0, (bf16_t*)(F.ws + WS_WGU0), r, scr, F.lane); continue; } r -= I2;
            if (r < I3) { transpose_plain(inptr(I_WFD), FF0, D, (bf16_t*)(F.ws + WS_WD0), r, scr, F.lane); continue; } r -= I3;
            if (r < I4) { transpose_plain(inptr(I_WIN1), D, LD1, (bf16_t*)(F.ws + WS_WIN1), r, scr, F.lane); continue; } r -= I4;
            transpose_plain(inptr(I_WOUT1), MIX1, D, (bf16_t*)(F.ws + WS_WOUT1), r, scr, F.lane);
        }
        float* lr = (float*)(F.ws + WS_LR);
        const float* wlr = inptr(I_WIN0) + W0_LR;
        for (int m = F.gw; m < T; m += F.NGW) {
            f32x4 v[4]; rmsnorm_row(inptr(I_X) + (size_t)m * D, inptr(I_MN0), XN + (size_t)m * D, F.lane, v);
            float a[16];
#pragma unroll
            for (int r = 0; r < 16; ++r) a[r] = 0.f;
#pragma unroll
            for (int j = 0; j < 4; ++j)
#pragma unroll
                for (int e = 0; e < 4; ++e) { const int c = 256 * j + 4 * F.lane + e; const f32x4* wp = (const f32x4*)(wlr + (size_t)c * LDW0); const float xv = v[j][e];
#pragma unroll
                    for (int q = 0; q < 4; ++q) { const f32x4 w4 = wp[q]; a[4 * q] += xv * w4.x; a[4 * q + 1] += xv * w4.y; a[4 * q + 2] += xv * w4.z; a[4 * q + 3] += xv * w4.w; } }
            float mine = 0.f;
#pragma unroll
            for (int r = 0; r < 16; ++r) { const float s = wave_sum(a[r]); mine = (F.lane == r) ? s : mine; }
            if (F.lane < 16) lr[(size_t)m * 16 + F.lane] = mine;
        }
    }
    SEAM(0);

    if (IN(1)) {
        pg8::DenseOrder S; S.init(T, LD0, F.G, (int)blockIdx.x); pg8::PlainMap MP; pg8::EpiBf16 E{HC0, LD0};
        pg8::gemm_phase(F.lds, XN, D, (const bf16_t*)(F.ws + WS_WIN0), D, S, MP, E);
    }
    SEAM(1);

    if (IN(2)) {
        {
            const float* qn = inptr(I_QNORM); const float* kn = inptr(I_KNORM);
            const int sub = F.lane & 7; float wq[8], wk[8];
#pragma unroll
            for (int e = 0; e < 8; ++e) { wq[e] = qn[8 * sub + e] * 0.125f; wk[e] = kn[8 * sub + e]; }
            const long nrows = (long)T * 16;
            for (long r0 = (long)F.gw * 8; r0 < nrows; r0 += (long)F.NGW * 8) {
                const long r = r0 + (F.lane >> 3); const int t = (int)(r >> 4), wh = (int)(r & 15), isk = wh >> 3, h = wh & 7;
                bf16_t* p = HC0 + (size_t)t * LD0 + (isk ? C0_KB : C0_QB) + h * 64 + 8 * sub;
                const u32x4 raw = *(const u32x4*)p; float x[8];
                x[0] = __uint_as_float(raw.x << 16); x[1] = __uint_as_float(raw.x & 0xffff0000u); x[2] = __uint_as_float(raw.y << 16); x[3] = __uint_as_float(raw.y & 0xffff0000u);
                x[4] = __uint_as_float(raw.z << 16); x[5] = __uint_as_float(raw.z & 0xffff0000u); x[6] = __uint_as_float(raw.w << 16); x[7] = __uint_as_float(raw.w & 0xffff0000u);
                float ss = 0.f;
#pragma unroll
                for (int e = 0; e < 8; ++e) ss += x[e] * x[e];
                ss += __shfl_xor(ss, 1); ss += __shfl_xor(ss, 2); ss += __shfl_xor(ss, 4);
                const float rs = 1.f / sqrtf(ss * (1.f / 64.f) + NORM_EPS);
#pragma unroll
                for (int e = 0; e < 8; ++e) x[e] = x[e] * rs * (isk ? wk[e] : wq[e]);
                u32x4 o; o.x = pk2(x[0], x[1]); o.y = pk2(x[2], x[3]); o.z = pk2(x[4], x[5]); o.w = pk2(x[6], x[7]);
                *(u32x4*)p = o;
            }
        }
        {
            const float* lr = (const float*)(F.ws + WS_LR); const float* wgu = inptr(I_WGATEUP); const float* bg = inptr(I_BGATE);
            bf16_t* att = (bf16_t*)(big + B_ATT0); bf16_t* kendT = (bf16_t*)(big + B_KENDT); float* decay = (float*)(F.ws + WS_DECAY);
            LAS float* qd_s = (LAS float*)F.lds;
            LAS float* ki_s = qd_s + 64 * 128;
            LAS float* grp = ki_s + 64 * 129;
            const int dk = F.tid & 127, sg = F.tid >> 7;
            for (int unit = blockIdx.x; unit < 2048; unit += F.G) {
                const int h = unit & 3, bn = unit >> 2, t0 = bn * 64;
                const int col = h * 128 + dk;
                float w16[16];
#pragma unroll
                for (int r = 0; r < 16; ++r) w16[r] = wgu[r * 512 + col];
                const float bias = bg[col];
                float cum[16]; float run = 0.f;
#pragma unroll
                for (int i = 0; i < 16; ++i) { const int t = t0 + 16 * sg + i; const f32x4* lp = (const f32x4*)(lr + (size_t)t * 16); float z = bias;
#pragma unroll
                    for (int q = 0; q < 4; ++q) { const f32x4 l4 = lp[q]; z += l4.x * w16[4 * q] + l4.y * w16[4 * q + 1] + l4.z * w16[4 * q + 2] + l4.w * w16[4 * q + 3]; }
                    run += logsigmoid_f(z) * (1.f / 16.f); cum[i] = run; }
                __syncthreads();
                grp[sg * 128 + dk] = run;
                __syncthreads();
                float off = 0.f, total = 0.f;
#pragma unroll
                for (int g = 0; g < 4; ++g) { const float gs = grp[g * 128 + dk]; total += gs; off += (g < sg) ? gs : 0.f; }
                unsigned kep[8];
#pragma unroll
                for (int i = 0; i < 16; ++i) { const int s = 16 * sg + i, t = t0 + s; const float c = off + cum[i];
                    bf16_t* qp = HC0 + (size_t)t * LD0 + C0_QA + col; const float q = bf2f(*qp), k = bf2f(HC0[(size_t)t * LD0 + C0_KA + col]);
                    const unsigned qdb = f2bf(q * __expf(c) * 0.08838834764831845f); *qp = (bf16_t)qdb; qd_s[s * 128 + dk] = __uint_as_float(qdb << 16);
                    ki_s[s * 129 + dk] = bfround(k * __expf(-c));
                    const unsigned keb = f2bf(k * __expf(total - c)); if (i & 1) kep[i >> 1] |= keb << 16; else kep[i >> 1] = keb; }
                { u32x4* kp = (u32x4*)(kendT + ((size_t)unit * 128 + dk) * 64 + 16 * sg); kp[0] = (u32x4){kep[0], kep[1], kep[2], kep[3]}; kp[1] = (u32x4){kep[4], kep[5], kep[6], kep[7]}; }
                if (sg == 0) decay[unit * 128 + dk] = __expf(total);
                __syncthreads();
#pragma unroll 1
                for (int i = 0; i < 8; ++i) { const int p = F.tid + 512 * i, s = p >> 6, s2 = p & 63; float a = 0.f;
                    if (s2 <= s) { for (int d = 0; d < 128; ++d) a += qd_s[s * 128 + d] * ki_s[s2 * 129 + d]; }
                    att[(size_t)unit * 4096 + p] = (bf16_t)f2bf(a); }
            }
            __syncthreads();
        }
    }
    SEAM(2);

    if (IN(3)) {
        const bf16_t* att = (const bf16_t*)(big + B_ATT0); const bf16_t* kendT = (const bf16_t*)(big + B_KENDT); const float* decay = (const float*)(F.ws + WS_DECAY);
        LAS float* att_s = (LAS float*)F.lds;
        LAS float* qd_s = att_s + 64 * 65;
        LAS float* ke_s = qd_s + 64 * 129;
        LAS float* v_s = ke_s + 128 * 65;
        LAS float* S_s = v_s + 64 * 16;
        LAS float* dc_s = S_s + 128 * 16;
        for (int item = blockIdx.x; item < 256; item += F.G) {
            const int sl = item & 15, h = (item >> 4) & 3, b = item >> 6;
            for (int i = F.tid; i < 128 * 16; i += NTHREADS) S_s[i] = 0.f;
            __syncthreads();
            for (int n = 0; n < 128; ++n) {
                const int unit = (b * 128 + n) * 4 + h, t0 = b * SEQ + n * 64;
                { const u32x4 raw = *(const u32x4*)(att + (size_t)unit * 4096 + F.tid * 8); const int s = F.tid >> 3, c0 = (F.tid & 7) * 8; LAS float* d = att_s + s * 65 + c0;
                  d[0] = __uint_as_float(raw.x << 16); d[1] = __uint_as_float(raw.x & 0xffff0000u); d[2] = __uint_as_float(raw.y << 16); d[3] = __uint_as_float(raw.y & 0xffff0000u);
                  d[4] = __uint_as_float(raw.z << 16); d[5] = __uint_as_float(raw.z & 0xffff0000u); d[6] = __uint_as_float(raw.w << 16); d[7] = __uint_as_float(raw.w & 0xffff0000u); }
#pragma unroll
                for (int rep = 0; rep < 2; ++rep) { const int ch = F.tid + 512 * rep;
                    { const int s = ch >> 4, c0 = (ch & 15) * 8; const u32x4 raw = *(const u32x4*)(HC0 + (size_t)(t0 + s) * LD0 + C0_QA + h * 128 + c0); LAS float* d = qd_s + s * 129 + c0;
                      d[0] = __uint_as_float(raw.x << 16); d[1] = __uint_as_float(raw.x & 0xffff0000u); d[2] = __uint_as_float(raw.y << 16); d[3] = __uint_as_float(raw.y & 0xffff0000u);
                      d[4] = __uint_as_float(raw.z << 16); d[5] = __uint_as_float(raw.z & 0xffff0000u); d[6] = __uint_as_float(raw.w << 16); d[7] = __uint_as_float(raw.w & 0xffff0000u); }
                    { const int dk = ch >> 3, c0 = (ch & 7) * 8; const u32x4 raw = *(const u32x4*)(kendT + ((size_t)unit * 128 + dk) * 64 + c0); LAS float* d = ke_s + dk * 65 + c0;
                      d[0] = __uint_as_float(raw.x << 16); d[1] = __uint_as_float(raw.x & 0xffff0000u); d[2] = __uint_as_float(raw.y << 16); d[3] = __uint_as_float(raw.y & 0xffff0000u);
                      d[4] = __uint_as_float(raw.z << 16); d[5] = __uint_as_float(raw.z & 0xffff0000u); d[6] = __uint_as_float(raw.w << 16); d[7] = __uint_as_float(raw.w & 0xffff0000u); } }
                if (F.tid < 128) { const int s = F.tid >> 1, c0 = (F.tid & 1) * 8; const u32x4 raw = *(const u32x4*)(HC0 + (size_t)(t0 + s) * LD0 + C0_VA + h * 256 + sl * 16 + c0); LAS float* d = v_s + s * 16 + c0;
                    d[0] = __uint_as_float(raw.x << 16); d[1] = __uint_as_float(raw.x & 0xffff0000u); d[2] = __uint_as_float(raw.y << 16); d[3] = __uint_as_float(raw.y & 0xffff0000u);
                    d[4] = __uint_as_float(raw.z << 16); d[5] = __uint_as_float(raw.z & 0xffff0000u); d[6] = __uint_as_float(raw.w << 16); d[7] = __uint_as_float(raw.w & 0xffff0000u); }
                else if (F.tid < 256) dc_s[F.tid - 128] = decay[unit * 128 + F.tid - 128];
                __syncthreads();
                { const int s = F.tid >> 3, dv = (F.tid & 7) * 2; float o0 = 0.f, o1 = 0.f;
                  for (int j = 0; j < 64; ++j) { const float a = att_s[s * 65 + j]; o0 += a * v_s[j * 16 + dv]; o1 += a * v_s[j * 16 + dv + 1]; }
                  for (int d = 0; d < 128; ++d) { const float q = qd_s[s * 129 + d]; o0 += q * S_s[d * 16 + dv]; o1 += q * S_s[d * 16 + dv + 1]; }
                  *(unsigned*)(HC0 + (size_t)(t0 + s) * LD0 + C0_VA + h * 256 + sl * 16 + dv) = pk2(o0, o1); }
                __syncthreads();
                { const int dk = F.tid >> 2, dv = (F.tid & 3) * 4; const float dc = dc_s[dk]; float a0 = S_s[dk * 16 + dv] * dc, a1 = S_s[dk * 16 + dv + 1] * dc, a2 = S_s[dk * 16 + dv + 2] * dc, a3 = S_s[dk * 16 + dv + 3] * dc;
                  for (int s = 0; s < 64; ++s) { const float k = ke_s[dk * 65 + s]; a0 += k * v_s[s * 16 + dv]; a1 += k * v_s[s * 16 + dv + 1]; a2 += k * v_s[s * 16 + dv + 2]; a3 += k * v_s[s * 16 + dv + 3]; }
                  S_s[dk * 16 + dv] = a0; S_s[dk * 16 + dv + 1] = a1; S_s[dk * 16 + dv + 2] = a2; S_s[dk * 16 + dv + 3] = a3; }
                __syncthreads();
            }
        }
    }
    SEAM(3);

    if (IN(4)) {
        float* lse = (float*)(F.ws + WS_LSE);
        const long nitem = 3L * NBATCH * 8 * SEQ;
        for (long idx = gtid; idx < nitem; idx += NT) {
            const int t = (int)(idx % SEQ); long r = idx / SEQ; const int h = (int)(r % 8); r /= 8; const int b = (int)(r % NBATCH); const int p = (int)(r / NBATCH);
            const int d = p == 0 ? 1 : (p == 1 ? 4 : 16);
            const float slope = exp2f(-(float)(h + 1));
            bf16_t* op = (p < 2) ? (bf16_t*)(F.ws + WS_XN) + (size_t)p * T * 512 : (bf16_t*)(big + B_OP2);
            float q[64], o[64];
            { const u32x4* qp = (const u32x4*)(HC0 + (size_t)(b * SEQ + t) * LD0 + C0_QB + h * 64);
#pragma unroll
              for (int c = 0; c < 8; ++c) { const u32x4 raw = qp[c]; q[8 * c] = __uint_as_float(raw.x << 16); q[8 * c + 1] = __uint_as_float(raw.x & 0xffff0000u); q[8 * c + 2] = __uint_as_float(raw.y << 16); q[8 * c + 3] = __uint_as_float(raw.y & 0xffff0000u);
                  q[8 * c + 4] = __uint_as_float(raw.z << 16); q[8 * c + 5] = __uint_as_float(raw.z & 0xffff0000u); q[8 * c + 6] = __uint_as_float(raw.w << 16); q[8 * c + 7] = __uint_as_float(raw.w & 0xffff0000u); } }
#pragma unroll
            for (int c = 0; c < 64; ++c) o[c] = 0.f;
            float m = -1e30f, l = 0.f;
            for (int j = 0; j <= 128; ++j) { const int tk = t - j * d; if (tk < 0) break;
                const u32x4* kp = (const u32x4*)(HC0 + (size_t)(b * SEQ + tk) * LD0 + C0_KB + h * 64); float s = 0.f;
#pragma unroll
                for (int c = 0; c < 8; ++c) { const u32x4 raw = kp[c]; s += q[8 * c] * __uint_as_float(raw.x << 16) + q[8 * c + 1] * __uint_as_float(raw.x & 0xffff0000u) + q[8 * c + 2] * __uint_as_float(raw.y << 16) + q[8 * c + 3] * __uint_as_float(raw.y & 0xffff0000u)
                      + q[8 * c + 4] * __uint_as_float(raw.z << 16) + q[8 * c + 5] * __uint_as_float(raw.z & 0xffff0000u) + q[8 * c + 6] * __uint_as_float(raw.w << 16) + q[8 * c + 7] * __uint_as_float(raw.w & 0xffff0000u); }
                s -= slope * (float)(j * d);
                const float mn = fmaxf(m, s), sc = __expf(m - mn), pe = __expf(s - mn); m = mn; l = l * sc + pe;
                const u32x4* vp = (const u32x4*)(HC0 + (size_t)(b * SEQ + tk) * LD0 + C0_VB + h * 64);
#pragma unroll
                for (int c = 0; c < 8; ++c) { const u32x4 raw = vp[c]; o[8 * c] = o[8 * c] * sc + pe * __uint_as_float(raw.x << 16); o[8 * c + 1] = o[8 * c + 1] * sc + pe * __uint_as_float(raw.x & 0xffff0000u);
                    o[8 * c + 2] = o[8 * c + 2] * sc + pe * __uint_as_float(raw.y << 16); o[8 * c + 3] = o[8 * c + 3] * sc + pe * __uint_as_float(raw.y & 0xffff0000u);
                    o[8 * c + 4] = o[8 * c + 4] * sc + pe * __uint_as_float(raw.z << 16); o[8 * c + 5] = o[8 * c + 5] * sc + pe * __uint_as_float(raw.z & 0xffff0000u);
                    o[8 * c + 6] = o[8 * c + 6] * sc + pe * __uint_as_float(raw.w << 16); o[8 * c + 7] = o[8 * c + 7] * sc + pe * __uint_as_float(raw.w & 0xffff0000u); } }
            const float il = 1.f / l;
            u32x4* dst = (u32x4*)(op + (size_t)(b * SEQ + t) * 512 + h * 64);
#pragma unroll
            for (int c = 0; c < 8; ++c) dst[c] = (u32x4){pk2(o[8 * c] * il, o[8 * c + 1] * il), pk2(o[8 * c + 2] * il, o[8 * c + 3] * il), pk2(o[8 * c + 4] * il, o[8 * c + 5] * il), pk2(o[8 * c + 6] * il, o[8 * c + 7] * il)};
            lse[((size_t)p * T + b * SEQ + t) * 8 + h] = m + __logf(l);
        }
    }
    SEAM(4);

    if (IN(5)) {
        const float* gn = inptr(I_GLANORM); const float* lse = (const float*)(F.ws + WS_LSE);
        float gw16[16];
#pragma unroll
        for (int e = 0; e < 16; ++e) gw16[e] = gn[(16 * F.lane + e) & 255];
        for (int t = F.gw; t < T; t += F.NGW) {
            bf16_t* row = HC0 + (size_t)t * LD0;
            { const u32x4* op = (const u32x4*)(row + C0_VA + 16 * F.lane); u32x4* rp = (u32x4*)(row + C0_RA + 16 * F.lane); float o[16], g[16];
#pragma unroll
              for (int c = 0; c < 2; ++c) { const u32x4 a = op[c], r4 = rp[c];
                  o[8 * c] = __uint_as_float(a.x << 16); o[8 * c + 1] = __uint_as_float(a.x & 0xffff0000u); o[8 * c + 2] = __uint_as_float(a.y << 16); o[8 * c + 3] = __uint_as_float(a.y & 0xffff0000u);
                  o[8 * c + 4] = __uint_as_float(a.z << 16); o[8 * c + 5] = __uint_as_float(a.z & 0xffff0000u); o[8 * c + 6] = __uint_as_float(a.w << 16); o[8 * c + 7] = __uint_as_float(a.w & 0xffff0000u);
                  g[8 * c] = __uint_as_float(r4.x << 16); g[8 * c + 1] = __uint_as_float(r4.x & 0xffff0000u); g[8 * c + 2] = __uint_as_float(r4.y << 16); g[8 * c + 3] = __uint_as_float(r4.y & 0xffff0000u);
                  g[8 * c + 4] = __uint_as_float(r4.z << 16); g[8 * c + 5] = __uint_as_float(r4.z & 0xffff0000u); g[8 * c + 6] = __uint_as_float(r4.w << 16); g[8 * c + 7] = __uint_as_float(r4.w & 0xffff0000u); }
              float ss = 0.f;
#pragma unroll
              for (int e = 0; e < 16; ++e) ss += o[e] * o[e];
              ss += __shfl_xor(ss, 1); ss += __shfl_xor(ss, 2); ss += __shfl_xor(ss, 4); ss += __shfl_xor(ss, 8);
              const float rs = 1.f / sqrtf(ss * (1.f / 256.f) + NORM_EPS);
#pragma unroll
              for (int e = 0; e < 16; ++e) o[e] = o[e] * rs * gw16[e] * silu_f(g[e]);
#pragma unroll
              for (int c = 0; c < 2; ++c) rp[c] = (u32x4){pk2(o[8 * c], o[8 * c + 1]), pk2(o[8 * c + 2], o[8 * c + 3]), pk2(o[8 * c + 4], o[8 * c + 5]), pk2(o[8 * c + 6], o[8 * c + 7])}; }
            { const int hh = F.lane >> 3; const float l0 = lse[((size_t)0 * T + t) * 8 + hh], l1 = lse[((size_t)1 * T + t) * 8 + hh], l2 = lse[((size_t)2 * T + t) * 8 + hh];
              const float mx = fmaxf(l0, fmaxf(l1, l2)); float w0 = __expf(l0 - mx), w1 = __expf(l1 - mx), w2 = __expf(l2 - mx); const float iw = 1.f / (w0 + w1 + w2); w0 *= iw; w1 *= iw; w2 *= iw;
              const u32x4 a = *(const u32x4*)((const bf16_t*)(F.ws + WS_XN) + (size_t)t * 512 + 8 * F.lane), bq = *(const u32x4*)((const bf16_t*)(F.ws + WS_XN) + (size_t)(T + t) * 512 + 8 * F.lane), c = *(const u32x4*)((const bf16_t*)(big + B_OP2) + (size_t)t * 512 + 8 * F.lane);
              float r[8];
              r[0] = w0 * __uint_as_float(a.x << 16) + w1 * __uint_as_float(bq.x << 16) + w2 * __uint_as_float(c.x << 16); r[1] = w0 * __uint_as_float(a.x & 0xffff0000u) + w1 * __uint_as_float(bq.x & 0xffff0000u) + w2 * __uint_as_float(c.x & 0xffff0000u);
              r[2] = w0 * __uint_as_float(a.y << 16) + w1 * __uint_as_float(bq.y << 16) + w2 * __uint_as_float(c.y << 16); r[3] = w0 * __uint_as_float(a.y & 0xffff0000u) + w1 * __uint_as_float(bq.y & 0xffff0000u) + w2 * __uint_as_float(c.y & 0xffff0000u);
              r[4] = w0 * __uint_as_float(a.z << 16) + w1 * __uint_as_float(bq.z << 16) + w2 * __uint_as_float(c.z << 16); r[5] = w0 * __uint_as_float(a.z & 0xffff0000u) + w1 * __uint_as_float(bq.z & 0xffff0000u) + w2 * __uint_as_float(c.z & 0xffff0000u);
              r[6] = w0 * __uint_as_float(a.w << 16) + w1 * __uint_as_float(bq.w << 16) + w2 * __uint_as_float(c.w << 16); r[7] = w0 * __uint_as_float(a.w & 0xffff0000u) + w1 * __uint_as_float(bq.w & 0xffff0000u) + w2 * __uint_as_float(c.w & 0xffff0000u);
              *(u32x4*)(row + C0_QB + 8 * F.lane) = (u32x4){pk2(r[0], r[1]), pk2(r[2], r[3]), pk2(r[4], r[5]), pk2(r[6], r[7])}; }
        }
    }
    SEAM(5);

    if (IN(6)) {
        pg8::DenseOrder S; S.init(T, D, F.G, (int)blockIdx.x); pg8::PlainMap MP; pg8::EpiResF32 E{inptr(I_X), F.out, D};
        pg8::gemm_phase(F.lds, HC0 + C0_RA, LD0, (const bf16_t*)(F.ws + WS_WOUT0), MIX0, S, MP, E);
    }
    SEAM(6);

    if (IN(7)) { for (int m = F.gw; m < T; m += F.NGW) { f32x4 v[4]; rmsnorm_row(F.out + (size_t)m * D, inptr(I_FN0), XN + (size_t)m * D, F.lane, v); } }
    SEAM(7);

    if (IN(8)) {
        pg8::DenseOrder S; S.init(T, 2 * FF0, F.G, (int)blockIdx.x); pg8::PlainMap MP; pg8::EpiSwiGLU E{(bf16_t*)(big + B_H0), FF0};
        pg8::gemm_phase(F.lds, XN, D, (const bf16_t*)(F.ws + WS_WGU0), D, S, MP, E);
    }
    SEAM(8);

    if (IN(9)) {
        pg8::DenseOrder S; S.init(T, D, F.G, (int)blockIdx.x); pg8::PlainMap MP; pg8::EpiResF32 E{F.out, F.out, D};
        pg8::gemm_phase(F.lds, (const bf16_t*)(big + B_H0), FF0, (const bf16_t*)(F.ws + WS_WD0), FF0, S, MP, E);
    }
    SEAM(9);

    if (IN(10)) { for (int m = F.gw; m < T; m += F.NGW) { f32x4 v[4]; rmsnorm_row(F.out + (size_t)m * D, inptr(I_MN1), XN + (size_t)m * D, F.lane, v); } }
    SEAM(10);

    if (IN(11)) {
        pg8::DenseOrder S; S.init(T, LD1, F.G, (int)blockIdx.x); pg8::PlainMap MP; pg8::EpiBf16 E{HC1, LD1};
        pg8::gemm_phase(F.lds, XN, D, (const bf16_t*)(F.ws + WS_WIN1), D, S, MP, E);
    }
    SEAM(11);

    if (IN(12)) {
        bf16_t* att = (bf16_t*)(big + B_ATT1); bf16_t* kdT = (bf16_t*)(F.ws + WS_XN);
        LAS bf16_t* qd_s = (LAS bf16_t*)F.lds;
        LAS bf16_t* ki_s = qd_s + 128 * 258;
        const int dk = F.tid & 255, sg = F.tid >> 8;
        for (int unit = blockIdx.x; unit < 1024; unit += F.G) {
            const int h = unit & 3, bn = unit >> 2, t0 = bn * 128;
            const float lg = log1pf(-exp2f(-5.f - (float)h));
            __syncthreads();
#pragma unroll 1
            for (int i8 = 0; i8 < 8; ++i8) {
                unsigned kp[4];
#pragma unroll
                for (int i = 0; i < 8; ++i) { const int s = 64 * sg + 8 * i8 + i, t = t0 + s;
                    bf16_t* qp = HC1 + (size_t)t * LD1 + C1_Q + h * 256 + dk; const float q = bf2f(*qp), k = bf2f(HC1[(size_t)t * LD1 + C1_K + h * 256 + dk]);
                    const unsigned qdb = f2bf(q * __expf(lg * (float)(s + 1))); *qp = (bf16_t)qdb; qd_s[s * 258 + dk] = (bf16_t)qdb;
                    ki_s[s * 258 + dk] = (bf16_t)f2bf(k * __expf(-lg * (float)(s + 1)));
                    const unsigned kdb = f2bf(k * __expf(lg * (float)(127 - s)) * 0.0625f); if (i & 1) kp[i >> 1] |= kdb << 16; else kp[i >> 1] = kdb; }
                *(u32x4*)(kdT + ((size_t)unit * 256 + dk) * 128 + 64 * sg + 8 * i8) = (u32x4){kp[0], kp[1], kp[2], kp[3]};
            }
            __syncthreads();
#pragma unroll 1
            for (int i = 0; i < 32; ++i) { const int p = F.tid + 512 * i, s = p >> 7, s2 = p & 127; float a = 0.f;
                if (s2 <= s) { for (int d = 0; d < 256; ++d) a += bf2f(qd_s[s * 258 + d]) * bf2f(ki_s[s2 * 258 + d]); }
                att[(size_t)unit * 16384 + p] = (bf16_t)f2bf(a * 0.0625f); }
        }
        __syncthreads();
    }
    SEAM(12);

    if (IN(13)) {
        const bf16_t* att = (const bf16_t*)(big + B_ATT1); const bf16_t* kdT = (const bf16_t*)(F.ws + WS_XN);
        LAS float* v_s = (LAS float*)F.lds;
        LAS float* S_s = v_s + 128 * 32;
        for (int item = blockIdx.x; item < 256; item += F.G) {
            const int sl = item & 15, h = (item >> 4) & 3, b = item >> 6;
            const float cdec = __expf(128.f * log1pf(-exp2f(-5.f - (float)h)));
            for (int i = F.tid; i < 256 * 33; i += NTHREADS) S_s[i] = 0.f;
            __syncthreads();
            for (int n = 0; n < 64; ++n) {
                const int unit = (b * 64 + n) * 4 + h, t0 = b * SEQ + n * 128;
                { const int s = F.tid >> 2, c0 = (F.tid & 3) * 8; const u32x4 raw = *(const u32x4*)(HC1 + (size_t)(t0 + s) * LD1 + C1_V + h * 512 + sl * 32 + c0); LAS float* d = v_s + s * 32 + c0;
                  d[0] = __uint_as_float(raw.x << 16); d[1] = __uint_as_float(raw.x & 0xffff0000u); d[2] = __uint_as_float(raw.y << 16); d[3] = __uint_as_float(raw.y & 0xffff0000u);
                  d[4] = __uint_as_float(raw.z << 16); d[5] = __uint_as_float(raw.z & 0xffff0000u); d[6] = __uint_as_float(raw.w << 16); d[7] = __uint_as_float(raw.w & 0xffff0000u); }
                __syncthreads();
                { const int s = F.tid >> 2, dv0 = (F.tid & 3) * 8; float o[8];
#pragma unroll
                  for (int e = 0; e < 8; ++e) o[e] = 0.f;
                  const bf16_t* ap = att + (size_t)unit * 16384 + s * 128;
                  for (int j = 0; j <= s; ++j) { const float a = bf2f(ap[j]);
#pragma unroll
                      for (int e = 0; e < 8; ++e) o[e] += a * v_s[j * 32 + dv0 + e]; }
                  const bf16_t* qp = HC1 + (size_t)(t0 + s) * LD1 + C1_Q + h * 256;
                  for (int d = 0; d < 256; ++d) { const float q = bf2f(qp[d]);
#pragma unroll
                      for (int e = 0; e < 8; ++e) o[e] += q * S_s[d * 33 + dv0 + e]; }
                  *(u32x4*)(HC1 + (size_t)(t0 + s) * LD1 + C1_V + h * 512 + sl * 32 + dv0) = (u32x4){pk2(o[0], o[1]), pk2(o[2], o[3]), pk2(o[4], o[5]), pk2(o[6], o[7])}; }
                __syncthreads();
                { const int dk = F.tid >> 1, dv0 = (F.tid & 1) * 16; float a[16];
#pragma unroll
                  for (int e = 0; e < 16; ++e) a[e] = S_s[dk * 33 + dv0 + e] * cdec;
                  const bf16_t* kp = kdT + ((size_t)unit * 256 + dk) * 128;
                  for (int s = 0; s < 128; ++s) { const float k = bf2f(kp[s]);
#pragma unroll
                      for (int e = 0; e < 16; ++e) a[e] += k * v_s[s * 32 + dv0 + e]; }
#pragma unroll
                  for (int e = 0; e < 16; ++e) S_s[dk * 33 + dv0 + e] = a[e]; }
                __syncthreads();
            }
        }
    }
    SEAM(13);

    if (IN(14)) {
        const float* gnw = inptr(I_RETGN);
        for (int t = F.gw; t < T; t += F.NGW) {
            bf16_t* row = HC1 + (size_t)t * LD1; const u32x4* op = (const u32x4*)(row + C1_V + 32 * F.lane); u32x4* gp = (u32x4*)(row + C1_G + 32 * F.lane);
            float o[32]; float s = 0.f;
#pragma unroll
            for (int c = 0; c < 4; ++c) { const u32x4 a = op[c];
                o[8 * c] = __uint_as_float(a.x << 16); o[8 * c + 1] = __uint_as_float(a.x & 0xffff0000u); o[8 * c + 2] = __uint_as_float(a.y << 16); o[8 * c + 3] = __uint_as_float(a.y & 0xffff0000u);
                o[8 * c + 4] = __uint_as_float(a.z << 16); o[8 * c + 5] = __uint_as_float(a.z & 0xffff0000u); o[8 * c + 6] = __uint_as_float(a.w << 16); o[8 * c + 7] = __uint_as_float(a.w & 0xffff0000u); }
#pragma unroll
            for (int e = 0; e < 32; ++e) s += o[e];
            s += __shfl_xor(s, 1); s += __shfl_xor(s, 2); s += __shfl_xor(s, 4); s += __shfl_xor(s, 8);
            const float mu = s * (1.f / 512.f); float q = 0.f;
#pragma unroll
            for (int e = 0; e < 32; ++e) { o[e] -= mu; q += o[e] * o[e]; }
            q += __shfl_xor(q, 1); q += __shfl_xor(q, 2); q += __shfl_xor(q, 4); q += __shfl_xor(q, 8);
            const float rs = 1.f / sqrtf(q * (1.f / 512.f) + GN_EPS);
#pragma unroll
            for (int c = 0; c < 4; ++c) { const u32x4 g4 = gp[c]; const f32x4 w0 = *(const f32x4*)(gnw + 32 * F.lane + 8 * c), w1 = *(const f32x4*)(gnw + 32 * F.lane + 8 * c + 4);
                const float g0 = __uint_as_float(g4.x << 16), g1 = __uint_as_float(g4.x & 0xffff0000u), g2 = __uint_as_float(g4.y << 16), g3 = __uint_as_float(g4.y & 0xffff0000u);
                const float g4_ = __uint_as_float(g4.z << 16), g5 = __uint_as_float(g4.z & 0xffff0000u), g6 = __uint_as_float(g4.w << 16), g7 = __uint_as_float(g4.w & 0xffff0000u);
                gp[c] = (u32x4){pk2(o[8 * c] * rs * w0.x * silu_f(g0), o[8 * c + 1] * rs * w0.y * silu_f(g1)), pk2(o[8 * c + 2] * rs * w0.z * silu_f(g2), o[8 * c + 3] * rs * w0.w * silu_f(g3)),
                                pk2(o[8 * c + 4] * rs * w1.x * silu_f(g4_), o[8 * c + 5] * rs * w1.y * silu_f(g5)), pk2(o[8 * c + 6] * rs * w1.z * silu_f(g6), o[8 * c + 7] * rs * w1.w * silu_f(g7))}; }
        }
    }
    SEAM(14);

    if (IN(15)) {
        pg8::DenseOrder S; S.init(T, D, F.G, (int)blockIdx.x); pg8::PlainMap MP; pg8::EpiResF32 E{F.out, F.out, D};
        pg8::gemm_phase(F.lds, HC1 + C1_G, LD1, (const bf16_t*)(F.ws + WS_WOUT1), MIX1, S, MP, E);
    }
    SEAM(15);

    if (IN(16)) {
        LAS float* scr = (LAS float*)(F.lds + F.wave * 16384);
        constexpr int IGU = (D / 64) * (2 * FFE / 32), IDN = (FFE / 64) * (D / 32);
        for (int it = F.gw; it < NEXP * (IGU + IDN); it += F.NGW) {
            const int e = it / (IGU + IDN), r = it % (IGU + IDN);
            if (r < IGU) transpose_gateup(inptr(I_WEG) + (size_t)e * D * FFE, inptr(I_WEU) + (size_t)e * D * FFE, D, FFE, (bf16_t*)(big + B_WEGU) + (size_t)e * 2 * FFE * D, r, scr, F.lane);
            else transpose_plain(inptr(I_WED) + (size_t)e * FFE * D, FFE, D, (bf16_t*)(big + B_WED) + (size_t)e * D * FFE, r - IGU, scr, F.lane);
        }
        int* rowtok = (int*)(F.ws + WS_ROUTE + R_ROWTOK); float* rowgate = (float*)(F.ws + WS_ROUTE + R_ROWGATE);
        for (int i = gtid; i < 2 * MOE_ROWS; i += NT) { rowtok[i] = -1; rowgate[i] = 0.f; }
        f32x4* tokinfo = (f32x4*)(F.ws + WS_ROUTE + R_TOKINFO);
        const float* wr_ = inptr(I_WROUTER);
        for (int m = F.gw; m < T; m += F.NGW) {
            f32x4 v[4]; rmsnorm_row(F.out + (size_t)m * D, inptr(I_FN1), XN + (size_t)m * D, F.lane, v);
            float a[8];
#pragma unroll
            for (int r = 0; r < 8; ++r) a[r] = 0.f;
#pragma unroll
            for (int j = 0; j < 4; ++j)
#pragma unroll
                for (int e = 0; e < 4; ++e) { const int c = 256 * j + 4 * F.lane + e; const f32x4* wp = (const f32x4*)(wr_ + (size_t)c * 8); const float xv = v[j][e]; const f32x4 w0 = wp[0], w1 = wp[1];
                    a[0] += xv * w0.x; a[1] += xv * w0.y; a[2] += xv * w0.z; a[3] += xv * w0.w; a[4] += xv * w1.x; a[5] += xv * w1.y; a[6] += xv * w1.z; a[7] += xv * w1.w; }
#pragma unroll
            for (int r = 0; r < 8; ++r) a[r] = wave_sum(a[r]);
            int e0 = 0; float l0 = a[0];
#pragma unroll
            for (int r = 1; r < 8; ++r) if (a[r] > l0) { l0 = a[r]; e0 = r; }
            int e1 = -1; float l1 = -3.4e38f;
#pragma unroll
            for (int r = 0; r < 8; ++r) if (r != e0 && a[r] > l1) { l1 = a[r]; e1 = r; }
            const float g0 = 1.f / (1.f + __expf(l1 - l0)), g1 = 1.f - g0;
            if (F.lane == 0) tokinfo[m] = (f32x4){__int_as_float(e0), __int_as_float(e1), g0, g1};
        }
    }
    SEAM(16);

    if (IN(17)) {
        if (blockIdx.x == 0) {
            const f32x4* tokinfo = (const f32x4*)(F.ws + WS_ROUTE + R_TOKINFO);
            int* rowtok = (int*)(F.ws + WS_ROUTE + R_ROWTOK); float* rowgate = (float*)(F.ws + WS_ROUTE + R_ROWGATE);
            int* blkexp = (int*)(F.ws + WS_ROUTE + R_BLKEXP); int* nblk = (int*)(F.ws + WS_ROUTE + R_NBLK);
            LAS int* cnt = (LAS int*)F.lds;
            LAS int* tot = cnt + 512 * 17;
            for (int k = 0; k < 16; ++k) cnt[F.tid * 17 + k] = 0;
            for (int i = 0; i < 64; ++i) { const f32x4 ti = tokinfo[F.tid * 64 + i]; cnt[F.tid * 17 + __float_as_int(ti.x)] += 1; cnt[F.tid * 17 + 8 + __float_as_int(ti.y)] += 1; }
            __syncthreads();
            if (F.tid < 16) { int run = 0; for (int i = 0; i < 512; ++i) { const int c = cnt[i * 17 + F.tid]; cnt[i * 17 + F.tid] = run; run += c; } tot[F.tid] = run; }
            __syncthreads();
            if (F.tid < 2) { int ps = 0, nb = 0; for (int e = 0; e < 8; ++e) { tot[16 + F.tid * 8 + e] = ps; const int c = tot[F.tid * 8 + e], bl = (c + 255) >> 8; for (int j = 0; j < bl; ++j) blkexp[F.tid * MOE_BLKS + nb + j] = e; nb += bl; ps += bl * 256; } nblk[F.tid] = nb; }
            __syncthreads();
            for (int i = 0; i < 64; ++i) { const int tok = F.tid * 64 + i; const f32x4 ti = tokinfo[tok]; const int e0 = __float_as_int(ti.x), e1 = __float_as_int(ti.y);
                const int r0 = tot[16 + e0] + cnt[F.tid * 17 + e0]; cnt[F.tid * 17 + e0] += 1; rowtok[r0] = tok; rowgate[r0] = ti.z;
                const int r1 = tot[24 + e1] + cnt[F.tid * 17 + 8 + e1]; cnt[F.tid * 17 + 8 + e1] += 1; rowtok[MOE_ROWS + r1] = tok; rowgate[MOE_ROWS + r1] = ti.w; }
        }
    }
    SEAM(17);

#pragma unroll
    for (int slot = 0; slot < 2; ++slot) {
        if (IN(18 + 2 * slot)) {
            const int* rowtok = (const int*)(F.ws + WS_ROUTE + R_ROWTOK) + slot * MOE_ROWS; const int* blkexp = (const int*)(F.ws + WS_ROUTE + R_BLKEXP) + slot * MOE_BLKS;
            const int nb = ((const int*)(F.ws + WS_ROUTE + R_NBLK))[slot];
            MoeOrder S; S.init(nb, 2 * FFE / 256, F.G, (int)blockIdx.x); pg8::MoeMap MP{rowtok, blkexp, 2 * FFE}; pg8::EpiSwiGLU E{(bf16_t*)(big + B_HMOE), FFE};
            pg8::gemm_phase(F.lds, XN, D, (const bf16_t*)(big + B_WEGU), D, S, MP, E);
        }
        SEAM(18 + 2 * slot);
        if (IN(19 + 2 * slot)) {
            const int* rowtok = (const int*)(F.ws + WS_ROUTE + R_ROWTOK) + slot * MOE_ROWS; const float* rowgate = (const float*)(F.ws + WS_ROUTE + R_ROWGATE) + slot * MOE_ROWS;
            const int* blkexp = (const int*)(F.ws + WS_ROUTE + R_BLKEXP) + slot * MOE_BLKS; const int nb = ((const int*)(F.ws + WS_ROUTE + R_NBLK))[slot];
            MoeOrder S; S.init(nb, D / 256, F.G, (int)blockIdx.x); pg8::MoeMap MP{nullptr, blkexp, D}; pg8::EpiMoeDown E{F.out, rowtok, rowgate};
            pg8::gemm_phase(F.lds, (const bf16_t*)(big + B_HMOE), FFE, (const bf16_t*)(big + B_WED), FFE, S, MP, E);
        }
        if (slot == 0) SEAM(19);
    }
#undef IN
#undef SEAM
}

#ifndef N_LAUNCH_MODE
#define N_LAUNCH_MODE 1
#endif
extern "C" void kernel_launch(void* const* d_in, const int* in_sizes, int n_in, void* d_out, int out_size, void* d_ws, size_t ws_size, hipStream_t stream) {
    static int grid = 0;
    if (grid == 0) {
        if (n_in != 22 || out_size != T * D || ws_size < WS_END) { fprintf(stderr, "kernel_launch: unexpected shapes (n_in %d out %d ws %zu need %zu)\n", n_in, out_size, ws_size, (size_t)WS_END); grid = -1; return; }
        int dev = 0, cus = 0, per_cu = 0;
        if (hipGetDevice(&dev) != hipSuccess || hipDeviceGetAttribute(&cus, hipDeviceAttributeMultiprocessorCount, dev) != hipSuccess) { grid = -1; return; }
        if (hipFuncSetAttribute((const void*)fwd_kernel, hipFuncAttributeMaxDynamicSharedMemorySize, LDS_BYTES) != hipSuccess) { fprintf(stderr, "kernel_launch: hipFuncSetAttribute failed\n"); grid = -1; return; }
        if (hipOccupancyMaxActiveBlocksPerMultiprocessor(&per_cu, (const void*)fwd_kernel, NTHREADS, LDS_BYTES) != hipSuccess || per_cu < 1) { fprintf(stderr, "kernel_launch: occupancy query says %d\n", per_cu); (void)hipGetLastError(); grid = -1; return; }
        grid = cus;
    }
    if (grid < 0) return;
    (void)hipMemsetAsync((char*)d_ws + WS_CTL, 0, CTL_ZERO_BYTES, stream);
    Args a{};
    for (int i = 0; i < 22; ++i) a.in[i] = (const float*)d_in[i];
    a.out = (float*)d_out; a.ws = (unsigned char*)d_ws;
#if N_LAUNCH_MODE == 1
    a.ph_lo = 0; a.ph_hi = NPHASE;
    hipLaunchKernelGGL(fwd_kernel, dim3(grid), dim3(NTHREADS), LDS_BYTES, stream, a);
#else
    for (int p = 0; p < NPHASE; ++p) { a.ph_lo = p; a.ph_hi = p + 1; hipLaunchKernelGGL(fwd_kernel, dim3(grid), dim3(NTHREADS), LDS_BYTES, stream, a); }
#endif
}
```

```cpp
#include <hip/hip_runtime.h>
#include <cstdio>
#include <cstdint>

#define LAS __attribute__((address_space(3)))
#define GAS __attribute__((address_space(1)))
typedef unsigned short bf16_t;
typedef short bf16x8 __attribute__((ext_vector_type(8)));
typedef float f32x4 __attribute__((ext_vector_type(4)));
typedef float f32x2 __attribute__((ext_vector_type(2)));
typedef unsigned u32x4 __attribute__((ext_vector_type(4)));
typedef unsigned u32x2 __attribute__((ext_vector_type(2)));
typedef GAS unsigned gu32;
#define RLX_AGENT __ATOMIC_RELAXED, __HIP_MEMORY_SCOPE_AGENT
#define LDS_WAIT() asm volatile("s_waitcnt lgkmcnt(0)" ::: "memory")
#define VM_WAIT() asm volatile("s_waitcnt vmcnt(0)" ::: "memory")

constexpr int NBATCH = 4, SEQ = 8192, T = NBATCH * SEQ, D = 1024;
constexpr float NORM_EPS = 1e-6f, GN_EPS = 1e-5f;
constexpr int LDW0 = 4624, LD0 = 4608;
constexpr int C0_QA = 0, C0_KA = 512, C0_VA = 1024, C0_RA = 2048, C0_QB = 3072, C0_KB = 3584, C0_VB = 4096;
constexpr int W0_LR = 3072;
constexpr int MIX0 = 1536, FF0 = 2816;
constexpr int LD1 = 6144, C1_Q = 0, C1_K = 1024, C1_V = 2048, C1_G = 4096, MIX1 = 2048;
constexpr int NEXP = 8, FFE = 3584;
constexpr int MOE_ROWS = 34816, MOE_BLKS = 136;

constexpr size_t MiB = 1u << 20;
constexpr size_t WS_CTL = 0, CTL_ZERO_BYTES = 1 * MiB;
constexpr size_t WS_WIN0 = 1 * MiB, WS_WOUT0 = 10 * MiB, WS_WGU0 = 13 * MiB, WS_WD0 = 24 * MiB, WS_WIN1 = 30 * MiB, WS_WOUT1 = 42 * MiB;
constexpr size_t WS_LR = 46 * MiB, WS_DECAY = 48 * MiB, WS_LSE = 49 * MiB, WS_ROUTE = 52 * MiB;
constexpr size_t WS_XN = 56 * MiB;
constexpr size_t WS_BIG = 120 * MiB;
constexpr size_t B_HCAT0 = 0, B_ATT0 = 288 * MiB, B_KENDT = 304 * MiB, B_OP2 = 336 * MiB;
constexpr size_t B_H0 = 0;
constexpr size_t B_HCAT1 = 0, B_ATT1 = 384 * MiB;
constexpr size_t B_WEGU = 0, B_WED = 112 * MiB, B_HMOE = 168 * MiB;
constexpr size_t WS_END = WS_BIG + 416 * MiB;
constexpr size_t R_TOKINFO = 0, R_ROWTOK = 512 * 1024, R_ROWGATE = R_ROWTOK + 2 * MOE_ROWS * 4, R_BLKEXP = R_ROWGATE + 2 * MOE_ROWS * 4, R_NBLK = R_BLKEXP + 2 * MOE_BLKS * 4;
constexpr int CW_TMO = 0, CW_CODE = 1, CW_BAR = 4096;

constexpr int LDS_BYTES = 147456;
constexpr int RING_BYTES = 131072;
constexpr int LDSCTL_OFF = 139264;
constexpr int NWAVES = 8, NTHREADS = 512;

__device__ __forceinline__ float bf2f(bf16_t b) { return __uint_as_float(((unsigned)b) << 16); }
__device__ __forceinline__ unsigned f2bf(float f) { unsigned u = __float_as_uint(f); return (u + 0x7fffu + ((u >> 16) & 1u)) >> 16; }
__device__ __forceinline__ unsigned pk2(float lo, float hi) { return f2bf(lo) | (f2bf(hi) << 16); }
__device__ __forceinline__ float bfround(float f) { return __uint_as_float(f2bf(f) << 16); }
__device__ __forceinline__ unsigned cvt_pk_bf16(float lo, float hi) { unsigned r; asm volatile("v_cvt_pk_bf16_f32 %0, %1, %2" : "=v"(r) : "v"(lo), "v"(hi)); return r; }
__device__ __forceinline__ float wave_sum(float v) {
#pragma unroll
    for (int o = 1; o < 64; o <<= 1) v += __shfl_xor(v, o);
    return v;
}
__device__ __forceinline__ float silu_f(float v) { return v / (1.f + __expf(-v)); }
__device__ __forceinline__ float logsigmoid_f(float z) { return fminf(z, 0.f) - log1pf(__expf(-fabsf(z))); }

#define XB_TMO      128
#define XB_XCNT(j)  (256  + 64 * (j))
#define XB_XSUB(j)  (1280 + 64 * (j))
#define XB_XGEN(j)  (2304 + 64 * (j))
#define XB_TOP      3328
#define XB_TOPGEN   3392
#define XCD_BAR_WORDS 3456
#define XB_SPIN_CAP (1u << 22)
__device__ __forceinline__ unsigned xb_ld(unsigned* p)              { return __hip_atomic_load(p, __ATOMIC_RELAXED, __HIP_MEMORY_SCOPE_AGENT); }
__device__ __forceinline__ unsigned xb_add(unsigned* p, unsigned v) { return __hip_atomic_fetch_add(p, v, __ATOMIC_RELAXED, __HIP_MEMORY_SCOPE_AGENT); }
__device__ __forceinline__ unsigned xb_xcc_id() { return (unsigned)__builtin_amdgcn_s_getreg((3 << 11) | 20) & 0xFu; }
#define XB_SPIN(cond, bar) do { unsigned _sp = 0; while (cond) { __builtin_amdgcn_s_sleep(1); \
    if ((++_sp & 255u) == 0u) { if (xb_ld(&(bar)[XB_TMO])) break; if (_sp > XB_SPIN_CAP) { atomicAdd(&(bar)[XB_TMO], 1u); break; } } } } while (0)
struct XcdBarrier { unsigned* bar; unsigned x; volatile LAS unsigned* st; };
__device__ __forceinline__ XcdBarrier xcd_barrier_post(unsigned* bar, volatile LAS unsigned* st) {
    XcdBarrier b; b.bar = bar; b.x = xb_xcc_id(); b.st = st;
    if (threadIdx.x == 0) (void)xb_add(&bar[XB_XCNT(b.x)], 1u);
    return b;
}
__device__ __forceinline__ void xcd_barrier_complete(unsigned* bar, unsigned x, unsigned& nloc, unsigned& nx) {
    const unsigned G = gridDim.x * gridDim.y * gridDim.z;
    unsigned sum, cnt, mine, sp = 0u;
    for (;;) {
        sum = 0u; cnt = 0u; mine = 0u;
#pragma unroll
        for (unsigned j = 0; j < 16; ++j) { const unsigned c = xb_ld(&bar[XB_XCNT(j)]); sum += c; cnt += (c > 0u) ? 1u : 0u; mine = (j == x) ? c : mine; }
        if (sum == G) break;
        __builtin_amdgcn_s_sleep(1);
        if ((++sp & 255u) == 0u) { if (xb_ld(&bar[XB_TMO])) break; if (sp > XB_SPIN_CAP) { atomicAdd(&bar[XB_TMO], 1u); break; } }
    }
    nloc = mine > 0u ? mine : 1u; nx = cnt > 0u ? cnt : 1u;
}
__device__ __forceinline__ void xcd_barrier(const XcdBarrier& b) {
    asm volatile("s_waitcnt vmcnt(0)" ::: "memory");
    __syncthreads();
    if (threadIdx.x == 0) {
        unsigned* bar = b.bar;
        __builtin_amdgcn_s_waitcnt(0);
        unsigned nloc = b.st[0], nx = b.st[1];
        if (nloc == 0u) { xcd_barrier_complete(bar, b.x, nloc, nx); b.st[0] = nloc; b.st[1] = nx; }
        const unsigned old = xb_add(&bar[XB_XSUB(b.x)], 1u);
        const unsigned gen = old / nloc;
        if (old + 1u == (gen + 1u) * nloc) {
            __builtin_amdgcn_fence(__ATOMIC_RELEASE, "agent");
            asm volatile("s_waitcnt vmcnt(0)" ::: "memory");
            const unsigned og = xb_add(&bar[XB_TOP], 1u);
            const unsigned tg = og / nx;
            if (og + 1u == (tg + 1u) * nx) xb_add(&bar[XB_TOPGEN], 1u);
            else XB_SPIN(xb_ld(&bar[XB_TOPGEN]) == tg, bar);
            __builtin_amdgcn_fence(__ATOMIC_ACQUIRE, "agent");
            xb_add(&bar[XB_XGEN(b.x)], 1u);
            asm volatile("s_waitcnt vmcnt(0)" ::: "memory");
        } else {
            XB_SPIN(xb_ld(&bar[XB_XGEN(b.x)]) == gen, bar);
            __builtin_amdgcn_fence(__ATOMIC_ACQUIRE, "agent");
            asm volatile("s_waitcnt vmcnt(0)" ::: "memory");
        }
    }
    __syncthreads();
}

namespace pg8 {
constexpr int BM = 256, BK = 64, HALF = 128, HTB = HALF * BK * 2, STAGE_BYTES = 8 * HTB;
__device__ __forceinline__ int lds_byte(int r, int c) { const int st = (r >> 4) * 2 + (c >> 5), rr = r & 15, cc = c & 31, ob = rr * 64 + cc * 2; return st * 1024 + (ob ^ (((ob >> 9) & 1) << 5)); }
__device__ __forceinline__ void stage_rc(int b, int& R, int& C) { const int st = b / 1024, sb = b % 1024, swz = sb ^ (((sb >> 9) & 1) << 5); R = (st >> 1) * 16 + swz / 64; C = (st & 1) * 32 + (swz % 64) / 2; }
__device__ __forceinline__ int perm32(int rho) { const int n = rho >> 4, i = rho & 15; return 8 * (i >> 2) + 4 * n + (i & 3); }
struct Unit { int pm, pn; };

struct DenseOrder {
    int nM, nN, nwg, G, c;
    __device__ void init(int M, int N, int G_, int c_) { nM = M / BM; nN = N / BM; nwg = nM * nN; G = G_; c = c_; }
    __device__ bool next(int i, Unit& u) const {
        const long L = (long)i * G + c; if (L >= nwg) return false;
        int wgid = (int)L; { const int q = nwg / 8, r = nwg % 8, xcd = wgid % 8, off = wgid / 8; wgid = (xcd < r ? xcd * (q + 1) : r * (q + 1) + (xcd - r) * q) + off; }
        const int nig = 8 * nN, gid = wgid / nig, fm = gid * 8, gsz = (nM - fm) < 8 ? (nM - fm) : 8;
        u.pm = fm + ((wgid % nig) % gsz); u.pn = (wgid % nig) / gsz; return true;
    }
};
struct PlainMap {
    __device__ __forceinline__ unsigned arow(int pm, int r) const { return (unsigned)(pm * BM + r); }
    __device__ __forceinline__ size_t brow0(const Unit& u) const { return (size_t)u.pn * BM; }
};
struct MoeMap {
    const int* rowtok; const int* blkexp; int nexp_rows;
    __device__ __forceinline__ unsigned arow(int pm, int r) const { if (!rowtok) return (unsigned)(pm * BM + r); const int t = rowtok[pm * BM + r]; return (unsigned)(t < 0 ? 0 : t); }
    __device__ __forceinline__ size_t brow0(const Unit& u) const { return (size_t)blkexp[u.pm] * nexp_rows + (size_t)u.pn * BM; }
};

template <class Epi, class Sched, class Map>
__device__ __forceinline__ void gemm_phase(LAS unsigned char* lds, const bf16_t* A, int lda, const bf16_t* Bt, int K, const Sched& S, const Map& MP, const Epi& E) {
    int tid_ = threadIdx.x; asm volatile("" : "+v"(tid_));
    const int tid = tid_, wid = __builtin_amdgcn_readfirstlane(tid >> 6), lane = tid & 63, wr = wid >> 2, wc = wid & 3, fr = lane & 15, fq = lane >> 4;
    const int nt = K / BK;
    unsigned voffB[2];
#pragma unroll
    for (int i = 0; i < 2; ++i) { int R, C; stage_rc(tid * 16 + i * 8192, R, C); const int Rb = Epi::PERM ? ((R & ~31) + perm32(R & 31)) : R; voffB[i] = (unsigned)(Rb * K + C) * 2u; }
    const size_t kstep = (size_t)(BK * 2);
    const size_t hstepB = (size_t)HALF * K * 2;
    const unsigned ldsw = (unsigned)wid * 1024u;
    const int aoff = lds_byte(wr * 64 + fr, fq * 8), boff = lds_byte(wc * 32 + fr, fq * 8);
#define PG8_SA(b, h) (((b) * 2 + (h)) * HTB)
#define PG8_SB(b, h) ((4 + (b) * 2 + (h)) * HTB)
#define PG8_STAGE(bufoff, gbase, voff) do { _Pragma("unroll") for (int _i = 0; _i < 2; ++_i) \
        __builtin_amdgcn_global_load_lds((const unsigned*)((const char*)(gbase) + (voff)[_i]), (LAS unsigned*)(lds + (bufoff) + ldsw + _i * 8192), 16, 0, 0); } while (0)
#define PG8_LDA(dst, b, h) do { _Pragma("unroll") for (int m = 0; m < 4; ++m) _Pragma("unroll") for (int k = 0; k < 2; ++k) dst[m][k] = *(const LAS bf16x8*)(lds + PG8_SA(b, h) + aoff + m * 2048 + k * 1024); } while (0)
#define PG8_LDB(dst, b, h) do { _Pragma("unroll") for (int n = 0; n < 2; ++n) _Pragma("unroll") for (int k = 0; k < 2; ++k) dst[n][k] = *(const LAS bf16x8*)(lds + PG8_SB(b, h) + boff + n * 2048 + k * 1024); } while (0)
#define PG8_MMA(ai, bj, At, Bt_) do { __builtin_amdgcn_s_setprio(1); _Pragma("unroll") for (int m = 0; m < 4; ++m) _Pragma("unroll") for (int n = 0; n < 2; ++n) _Pragma("unroll") for (int k = 0; k < 2; ++k) \
        acc[ai][bj][m][n] = __builtin_amdgcn_mfma_f32_16x16x32_bf16(Bt_[n][k], At[m][k], acc[ai][bj][m][n], 0, 0, 0); __builtin_amdgcn_s_setprio(0); } while (0)
#define PG8_WAIT_V(n) asm volatile("s_waitcnt vmcnt(" #n ")" ::: "memory")
#define PG8_WAIT_L(n) asm volatile("s_waitcnt lgkmcnt(" #n ")" ::: "memory")
#define PG8_BAR __builtin_amdgcn_s_barrier()
#define PG8_SCHED __builtin_amdgcn_sched_barrier(0)
#define PG8_VOFFA(dst, u_) do { _Pragma("unroll") for (int _i = 0; _i < 2; ++_i) { int _R, _C; stage_rc(tid * 16 + _i * 8192, _R, _C); _Pragma("unroll") for (int _h = 0; _h < 2; ++_h) \
        dst[_h][_i] = (MP.arow((u_).pm, _h * HALF + _R) * (unsigned)lda + (unsigned)_C) * 2u; } } while (0)
#define PG8_STAGE2(bufoff, gbase, va, vb, sel) do { _Pragma("unroll") for (int _i = 0; _i < 2; ++_i) \
        __builtin_amdgcn_global_load_lds((const unsigned*)((const char*)(gbase) + ((sel) ? (vb)[_i] : (va)[_i])), (LAS unsigned*)(lds + (bufoff) + ldsw + _i * 8192), 16, 0, 0); } while (0)
    Unit cur, nxt; int ui = 0;
    if (!S.next(0, cur)) return;
    f32x4 acc[2][2][4][2];
#pragma unroll
    for (int a = 0; a < 2; ++a)
#pragma unroll
        for (int b = 0; b < 2; ++b)
#pragma unroll
            for (int m = 0; m < 4; ++m)
#pragma unroll
                for (int n = 0; n < 2; ++n) acc[a][b][m][n] = (f32x4){0.f, 0.f, 0.f, 0.f};
    bf16x8 At[4][2], B0[2][2], B1[2][2];
    unsigned vc[2][2], vn[2][2];
    PG8_VOFFA(vc, cur);
    const char* cA = (const char*)A; const char* cB = (const char*)Bt + MP.brow0(cur) * (size_t)K * 2;
    PG8_STAGE(PG8_SB(0, 0), cB, voffB); PG8_STAGE(PG8_SB(0, 1), cB + hstepB, voffB); PG8_STAGE(PG8_SA(0, 0), cA, vc[0]); PG8_STAGE(PG8_SA(0, 1), cA, vc[1]);
    if (wr == 1) PG8_BAR;
    PG8_WAIT_V(2); PG8_BAR;
    PG8_STAGE(PG8_SB(1, 0), cB + kstep, voffB); PG8_STAGE(PG8_SA(1, 0), cA + kstep, vc[0]); PG8_STAGE(PG8_SB(1, 1), cB + hstepB + kstep, voffB);
    PG8_WAIT_V(6); PG8_BAR;
    for (;;) {
        const bool has_next = S.next(ui + 1, nxt);
        const char* nB = cB;
        if (has_next) { PG8_VOFFA(vn, nxt); nB = (const char*)Bt + MP.brow0(nxt) * (size_t)K * 2; }
        else {
#pragma unroll
            for (int h = 0; h < 2; ++h)
#pragma unroll
                for (int i = 0; i < 2; ++i) vn[h][i] = vc[h][i];
        }
        for (int t = 0; t < nt; t += 2) {
            const bool last = (t == nt - 2);
            const char* a1 = cA + (size_t)(t + 1) * kstep;
            const char* a2 = last ? cA : cA + (size_t)(t + 2) * kstep; const char* b2 = last ? nB : cB + (size_t)(t + 2) * kstep;
            const char* a3 = a2 + kstep; const char* b3 = b2 + kstep;
            PG8_LDB(B0, 0, 0); PG8_LDB(B1, 0, 1); PG8_SCHED; PG8_LDA(At, 0, 0); PG8_STAGE(PG8_SA(1, 1), a1, vc[1]);
            PG8_WAIT_V(8); PG8_WAIT_L(0); PG8_BAR; PG8_MMA(0, 0, At, B0); PG8_MMA(0, 1, At, B1); PG8_BAR; PG8_SCHED;
            PG8_LDA(At, 0, 1); PG8_STAGE(PG8_SB(0, 0), b2, voffB); PG8_STAGE(PG8_SB(0, 1), b2 + hstepB, voffB); PG8_STAGE2(PG8_SA(0, 0), a2, vc[0], vn[0], last);
            PG8_WAIT_V(8); PG8_WAIT_L(0); PG8_BAR; PG8_MMA(1, 0, At, B0); PG8_MMA(1, 1, At, B1); PG8_BAR; PG8_SCHED;
            PG8_LDB(B0, 1, 0); PG8_LDB(B1, 1, 1); PG8_SCHED; PG8_LDA(At, 1, 0); PG8_STAGE2(PG8_SA(0, 1), a2, vc[1], vn[1], last);
            PG8_WAIT_V(8); PG8_WAIT_L(0); PG8_BAR; PG8_MMA(0, 0, At, B0); PG8_MMA(0, 1, At, B1); PG8_BAR; PG8_SCHED;
            PG8_LDA(At, 1, 1); PG8_STAGE(PG8_SB(1, 0), b3, voffB); PG8_STAGE(PG8_SB(1, 1), b3 + hstepB, voffB); PG8_STAGE2(PG8_SA(1, 0), a3, vc[0], vn[0], last);
            PG8_WAIT_V(8); PG8_WAIT_L(0); PG8_BAR; PG8_MMA(1, 0, At, B0); PG8_MMA(1, 1, At, B1); PG8_BAR; PG8_SCHED;
        }
        if (wr == 0) PG8_BAR;
        E(acc, cur, wr, wc, fr, fq);
        if (!has_next) break;
#pragma unroll
        for (int a = 0; a < 2; ++a)
#pragma unroll
            for (int b = 0; b < 2; ++b)
#pragma unroll
                for (int m = 0; m < 4; ++m)
#pragma unroll
                    for (int n = 0; n < 2; ++n) acc[a][b][m][n] = (f32x4){0.f, 0.f, 0.f, 0.f};
        cur = nxt; cB = nB; ++ui;
#pragma unroll
        for (int h = 0; h < 2; ++h)
#pragma unroll
            for (int i = 0; i < 2; ++i) vc[h][i] = vn[h][i];
        if (wr == 1) PG8_BAR;
    }
    PG8_WAIT_V(0);
    PG8_BAR;
#undef PG8_SA
#undef PG8_SB
#undef PG8_STAGE
#undef PG8_LDA
#undef PG8_LDB
#undef PG8_MMA
#undef PG8_WAIT_V
#undef PG8_WAIT_L
#undef PG8_BAR
#undef PG8_SCHED
#undef PG8_VOFFA
#undef PG8_STAGE2
}

struct EpiBf16 {
    static constexpr bool PERM = true;
    bf16_t* O; int ldc;
    __device__ __forceinline__ void operator()(const f32x4 (&acc)[2][2][4][2], const Unit& u, int wr, int wc, int fr, int fq) const {
        const int row0 = u.pm * BM + wr * 64 + fr, col0 = u.pn * BM + wc * 32 + 8 * fq;
#pragma unroll
        for (int ai = 0; ai < 2; ++ai)
#pragma unroll
            for (int m = 0; m < 4; ++m) { bf16_t* rowp = O + (size_t)(row0 + ai * HALF + m * 16) * ldc + col0;
#pragma unroll
                for (int bj = 0; bj < 2; ++bj) { const f32x4 v0 = acc[ai][bj][m][0], v1 = acc[ai][bj][m][1];
                    u32x4 w; w.x = cvt_pk_bf16(v0[0], v0[1]); w.y = cvt_pk_bf16(v0[2], v0[3]); w.z = cvt_pk_bf16(v1[0], v1[1]); w.w = cvt_pk_bf16(v1[2], v1[3]);
                    *(u32x4*)(rowp + bj * HALF) = w; } }
    }
};
struct EpiSwiGLU {
    static constexpr bool PERM = true;
    bf16_t* H; int ldh;
    __device__ __forceinline__ void operator()(const f32x4 (&acc)[2][2][4][2], const Unit& u, int wr, int wc, int fr, int fq) const {
        const int row0 = u.pm * BM + wr * 64 + fr, col0 = u.pn * HALF + wc * 32 + 8 * fq;
#pragma unroll
        for (int ai = 0; ai < 2; ++ai)
#pragma unroll
            for (int m = 0; m < 4; ++m) { bf16_t* rowp = H + (size_t)(row0 + ai * HALF + m * 16) * ldh + col0;
                f32x4 h0, h1;
#pragma unroll
                for (int j = 0; j < 4; ++j) { const float g0 = acc[ai][0][m][0][j], g1 = acc[ai][0][m][1][j];
                    h0[j] = g0 * __builtin_amdgcn_rcpf(1.f + __expf(-g0)) * acc[ai][1][m][0][j]; h1[j] = g1 * __builtin_amdgcn_rcpf(1.f + __expf(-g1)) * acc[ai][1][m][1][j]; }
                u32x4 w; w.x = cvt_pk_bf16(h0[0], h0[1]); w.y = cvt_pk_bf16(h0[2], h0[3]); w.z = cvt_pk_bf16(h1[0], h1[1]); w.w = cvt_pk_bf16(h1[2], h1[3]);
                *(u32x4*)rowp = w; }
    }
};
struct EpiResF32 {
    static constexpr bool PERM = false;
    const float* base; float* out; int ldc;
    __device__ __forceinline__ void operator()(const f32x4 (&acc)[2][2][4][2], const Unit& u, int wr, int wc, int fr, int fq) const {
        const int row0 = u.pm * BM + wr * 64 + fr, col0 = u.pn * BM + wc * 32 + 4 * fq;
#pragma unroll
        for (int ai = 0; ai < 2; ++ai)
#pragma unroll
            for (int m = 0; m < 4; ++m) { const size_t off = (size_t)(row0 + ai * HALF + m * 16) * ldc + col0;
#pragma unroll
                for (int bj = 0; bj < 2; ++bj)
#pragma unroll
                    for (int n = 0; n < 2; ++n) { const f32x4 bs = *(const f32x4*)(base + off + bj * HALF + n * 16); *(f32x4*)(out + off + bj * HALF + n * 16) = bs + acc[ai][bj][m][n]; } }
    }
};
struct EpiMoeDown {
    static constexpr bool PERM = false;
    float* out; const int* rowtok; const float* rowgate;
    __device__ __forceinline__ void operator()(const f32x4 (&acc)[2][2][4][2], const Unit& u, int wr, int wc, int fr, int fq) const {
        const int row0 = u.pm * BM + wr * 64 + fr, col0 = u.pn * BM + wc * 32 + 4 * fq;
#pragma unroll
        for (int ai = 0; ai < 2; ++ai)
#pragma unroll
            for (int m = 0; m < 4; ++m) { const int r = row0 + ai * HALF + m * 16; const int tok = rowtok[r]; const float g = rowgate[r];
                if (tok >= 0) { float* op = out + (size_t)tok * D + col0;
#pragma unroll
                    for (int bj = 0; bj < 2; ++bj)
#pragma unroll
                        for (int n = 0; n < 2; ++n) { const f32x4 bs = *(const f32x4*)(op + bj * HALF + n * 16); *(f32x4*)(op + bj * HALF + n * 16) = bs + g * acc[ai][bj][m][n]; } } }
    }
};
}

struct MoeOrder {
    int nwg, nN, G, c;
    __device__ void init(int nblk, int nN_, int G_, int c_) { nN = nN_; nwg = nblk * nN_; G = G_; c = c_; }
    __device__ bool next(int i, pg8::Unit& u) const { const long L = (long)i * G + c; if (L >= nwg) return false; u.pm = (int)(L / nN); u.pn = (int)(L % nN); return true; }
};

struct Frame {
    LAS unsigned char* lds;
    gu32* ctl;
    int tid, lane, wave, G, gw, NGW;
    unsigned char* ws;
    float* out;
};
__device__ __forceinline__ const float* inptr(int i) {
    unsigned off = (unsigned)i * 8u; asm volatile("" : "+s"(off));
    return *(const float* const*)((const char*)__builtin_amdgcn_kernarg_segment_ptr() + off);
}
enum { I_X = 0, I_MN0, I_WIN0, I_WGATEUP, I_BGATE, I_GLANORM, I_QNORM, I_KNORM, I_WOUT0, I_FN0, I_WFG, I_WFU, I_WFD, I_MN1, I_WIN1, I_RETGN, I_WOUT1, I_FN1, I_WROUTER, I_WEG, I_WEU, I_WED };

__device__ __forceinline__ void transpose_item(const float* W, int ldw, int src_col0, bf16_t* WT, int ldt, int dst_row0, int k0, LAS float* scr, int lane) {
#pragma unroll 8
    for (int i = 0; i < 32; ++i) { const int kk = 2 * i + (lane >> 5); scr[kk * 33 + (lane & 31)] = W[(size_t)(k0 + kk) * ldw + src_col0 + (lane & 31)]; }
    LDS_WAIT(); asm volatile("" ::: "memory");
    const int c = lane & 7;
#pragma unroll
    for (int j = 0; j < 4; ++j) { const int n = (lane >> 3) + 8 * j; const LAS float* s = scr + (8 * c) * 33 + n;
        u32x4 o; o.x = pk2(s[0 * 33], s[1 * 33]); o.y = pk2(s[2 * 33], s[3 * 33]); o.z = pk2(s[4 * 33], s[5 * 33]); o.w = pk2(s[6 * 33], s[7 * 33]);
        *(u32x4*)(WT + (size_t)(dst_row0 + n) * ldt + k0 + 8 * c) = o; }
    LDS_WAIT(); asm volatile("" ::: "memory");
}
__device__ __forceinline__ void transpose_plain(const float* W, int K, int N, bf16_t* WT, int it, LAS float* scr, int lane) {
    const int nblk = N / 32, kb = it / nblk, nb = it % nblk; transpose_item(W, N, 32 * nb, WT, K, 32 * nb, 64 * kb, scr, lane);
}
__device__ __forceinline__ void transpose_gateup(const float* Wg, const float* Wu, int K, int F, bf16_t* WT, int it, LAS float* scr, int lane) {
    const int nblk = 2 * F / 32, kb = it / nblk, nb = it % nblk, dr = 32 * nb, tile = dr >> 8, within = dr & 255;
    const float* W = within < 128 ? Wg : Wu; const int sc = tile * 128 + (within & 127);
    transpose_item(W, F, sc, WT, K, dr, 64 * kb, scr, lane);
}

__device__ __forceinline__ void rmsnorm_row(const float* xrow, const float* w, bf16_t* orow, int lane, f32x4 (&v)[4]) {
    const f32x4* xr = (const f32x4*)xrow + lane; float s = 0.f;
#pragma unroll
    for (int j = 0; j < 4; ++j) { v[j] = xr[64 * j]; s += (v[j].x * v[j].x + v[j].y * v[j].y) + (v[j].z * v[j].z + v[j].w * v[j].w); }
    const float r = 1.f / sqrtf(wave_sum(s) * (1.f / D) + NORM_EPS);
    const f32x4* wr = (const f32x4*)w + lane;
    unsigned long long* o8 = (unsigned long long*)orow + lane;
#pragma unroll
    for (int j = 0; j < 4; ++j) { const f32x4 ww = wr[64 * j]; v[j] = v[j] * r * ww; o8[64 * j] = (unsigned long long)pk2(v[j].x, v[j].y) | ((unsigned long long)pk2(v[j].z, v[j].w) << 32); }
}


__device__ __forceinline__ void unpack8(const u32x4 raw, float (&x)[8]) {
    x[0] = __uint_as_float(raw.x << 16); x[1] = __uint_as_float(raw.x & 0xffff0000u); x[2] = __uint_as_float(raw.y << 16); x[3] = __uint_as_float(raw.y & 0xffff0000u);
    x[4] = __uint_as_float(raw.z << 16); x[5] = __uint_as_float(raw.z & 0xffff0000u); x[6] = __uint_as_float(raw.w << 16); x[7] = __uint_as_float(raw.w & 0xffff0000u);
}
typedef short s16x4 __attribute__((ext_vector_type(4)));
__device__ __forceinline__ void dilated_phase(const Frame& F, const bf16_t* HC0, bf16_t* op01, bf16_t* op2, float* lse) {
    constexpr int SLOT = 128 * 144;
    constexpr float LOG2E = 1.4426950408889634f, LN2 = 0.6931471805599453f;
    LAS unsigned char* Ks = F.lds; LAS unsigned char* Vs = F.lds + 3 * SLOT;
    for (int i = F.tid; i < 6 * SLOT / 16; i += NTHREADS) ((LAS u32x4*)F.lds)[i] = (u32x4){0u, 0u, 0u, 0u};
    int tid_ = threadIdx.x; asm volatile("" : "+v"(tid_));
    const int lane = tid_ & 63, fr = lane & 15, fq = lane >> 4, w = __builtin_amdgcn_readfirstlane(tid_ >> 6);
    const int srow0 = tid_ >> 3, sc = tid_ & 7;
    float knw[8], qnw[16];
    { const float* kn = inptr(I_KNORM); const float* qn = inptr(I_QNORM);
#pragma unroll
      for (int e = 0; e < 8; ++e) { knw[e] = kn[8 * sc + e]; qnw[e] = qn[8 * fq + e] * (0.125f * LOG2E); qnw[8 + e] = qn[32 + 8 * fq + e] * (0.125f * LOG2E); } }
    const unsigned vlane = (unsigned)((4 * fq + ((lane & 15) >> 2)) * 144 + (lane & 3) * 8);
    __syncthreads();
    for (int item = blockIdx.x; item < 1536; item += F.G) {
        const int p = item >> 9, within = item & 511, dsh = 2 * p, d = 1 << dsh;
        const int strip = within >> (4 - dsh), grp = within & ((16 >> dsh) - 1), r = strip & (d - 1), bh = strip >> dsh, h = bh & 7, b = bh >> 3, n0 = 4 * grp;
        const float cb = exp2f(-(float)(h + 1)) * LOG2E * (float)d;
        bf16_t* op = p < 2 ? op01 + (size_t)p * T * 512 : op2;
        const bf16_t* base = HC0 + (size_t)b * SEQ * LD0 + h * 64;
        u32x4 kreg[2], vreg[2];
#define DIL_LOAD(m) do { _Pragma("unroll") for (int rep = 0; rep < 2; ++rep) { const size_t pos = (size_t)((128 * (m) + srow0 + 64 * rep) * d + r); \
            kreg[rep] = *(const u32x4*)(base + pos * LD0 + C0_KB + 8 * sc); vreg[rep] = *(const u32x4*)(base + pos * LD0 + C0_VB + 8 * sc); } } while (0)
#define DIL_STORE(slot) do { _Pragma("unroll") for (int rep = 0; rep < 2; ++rep) { float x[8]; unpack8(kreg[rep], x); float ss = 0.f; \
            _Pragma("unroll") for (int e = 0; e < 8; ++e) ss += x[e] * x[e]; \
            ss += __shfl_xor(ss, 1); ss += __shfl_xor(ss, 2); ss += __shfl_xor(ss, 4); const float rs = 1.f / sqrtf(ss * (1.f / 64.f) + NORM_EPS); \
            const unsigned ro = (unsigned)((slot) * SLOT + (srow0 + 64 * rep) * 144 + sc * 16); \
            *(LAS u32x4*)(Ks + ro) = (u32x4){cvt_pk_bf16(x[0] * rs * knw[0], x[1] * rs * knw[1]), cvt_pk_bf16(x[2] * rs * knw[2], x[3] * rs * knw[3]), cvt_pk_bf16(x[4] * rs * knw[4], x[5] * rs * knw[5]), cvt_pk_bf16(x[6] * rs * knw[6], x[7] * rs * knw[7])}; \
            *(LAS u32x4*)(Vs + ro) = vreg[rep]; } } while (0)
        if (n0 > 0) { DIL_LOAD(n0 - 1); DIL_STORE((n0 + 2) % 3); }
        DIL_LOAD(n0); DIL_STORE(n0 % 3);
        __syncthreads();
#pragma unroll 1
        for (int n = n0; n < n0 + 4; ++n) {
            const int prev = (n + 2) % 3, cur = n % 3, nxt = (n + 1) % 3;
            const bool more = (n + 1 < n0 + 4);
            if (more) DIL_LOAD(n + 1);
            const size_t tokq = (size_t)b * SEQ + (size_t)((128 * n + 16 * w + fr) * d + r);
            bf16x8 qf0, qf1;
            { const bf16_t* qp = HC0 + tokq * LD0 + C0_QB + h * 64; float x0[8], x1[8]; unpack8(*(const u32x4*)(qp + 8 * fq), x0); unpack8(*(const u32x4*)(qp + 32 + 8 * fq), x1);
              float ss = 0.f;
#pragma unroll
              for (int e = 0; e < 8; ++e) ss += x0[e] * x0[e] + x1[e] * x1[e];
              ss += __shfl_xor(ss, 16); ss += __shfl_xor(ss, 32);
              const float rs = 1.f / sqrtf(ss * (1.f / 64.f) + NORM_EPS);
              const u32x4 a0 = (u32x4){cvt_pk_bf16(x0[0] * rs * qnw[0], x0[1] * rs * qnw[1]), cvt_pk_bf16(x0[2] * rs * qnw[2], x0[3] * rs * qnw[3]), cvt_pk_bf16(x0[4] * rs * qnw[4], x0[5] * rs * qnw[5]), cvt_pk_bf16(x0[6] * rs * qnw[6], x0[7] * rs * qnw[7])};
              const u32x4 a1 = (u32x4){cvt_pk_bf16(x1[0] * rs * qnw[8], x1[1] * rs * qnw[9]), cvt_pk_bf16(x1[2] * rs * qnw[10], x1[3] * rs * qnw[11]), cvt_pk_bf16(x1[4] * rs * qnw[12], x1[5] * rs * qnw[13]), cvt_pk_bf16(x1[6] * rs * qnw[14], x1[7] * rs * qnw[15])};
              qf0 = __builtin_bit_cast(bf16x8, a0); qf1 = __builtin_bit_cast(bf16x8, a1); }
            f32x4 sacc[9];
#pragma unroll
            for (int i = 0; i < 9; ++i) { const int kt = w + i; const unsigned ko = (unsigned)((kt < 8 ? prev : cur) * SLOT + ((kt & 7) * 16 + fr) * 144 + fq * 16);
                const bf16x8 k0 = *(const LAS bf16x8*)(Ks + ko), k1 = *(const LAS bf16x8*)(Ks + ko + 64);
                f32x4 z = (f32x4){0.f, 0.f, 0.f, 0.f};
                z = __builtin_amdgcn_mfma_f32_16x16x32_bf16(k0, qf0, z, 0, 0, 0); sacc[i] = __builtin_amdgcn_mfma_f32_16x16x32_bf16(k1, qf1, z, 0, 0, 0); }
            float mx = -1e30f; const int lpart = fr - 4 * fq;
#pragma unroll
            for (int i = 0; i < 9; ++i) { const bool tile_ok = (w + i >= 8) || (n > 0);
#pragma unroll
                for (int j = 0; j < 4; ++j) { const int steps = 128 - 16 * i - j + lpart; float sv = sacc[i][j] - cb * (float)steps; bool ok = tile_ok;
                    if (i == 0) ok = ok && (steps <= 128); if (i == 8) ok = ok && (steps >= 0);
                    sv = ok ? sv : -1e30f; sacc[i][j] = sv; mx = fmaxf(mx, sv); } }
            mx = fmaxf(mx, __shfl_xor(mx, 16)); mx = fmaxf(mx, __shfl_xor(mx, 32));
            float l = 0.f;
#pragma unroll
            for (int i = 0; i < 9; ++i)
#pragma unroll
                for (int j = 0; j < 4; ++j) { const float pe = __builtin_amdgcn_exp2f(sacc[i][j] - mx); sacc[i][j] = pe; l += pe; }
            l += __shfl_xor(l, 16); l += __shfl_xor(l, 32);
            bf16x8 pf[5];
#pragma unroll
            for (int ks = 0; ks < 5; ++ks) { u32x4 t4; t4.x = cvt_pk_bf16(sacc[2 * ks][0], sacc[2 * ks][1]); t4.y = cvt_pk_bf16(sacc[2 * ks][2], sacc[2 * ks][3]);
                if (ks < 4) { t4.z = cvt_pk_bf16(sacc[2 * ks + 1][0], sacc[2 * ks + 1][1]); t4.w = cvt_pk_bf16(sacc[2 * ks + 1][2], sacc[2 * ks + 1][3]); } else { t4.z = 0u; t4.w = 0u; }
                pf[ks] = __builtin_bit_cast(bf16x8, t4); }
            f32x4 oacc[4];
#pragma unroll
            for (int dt = 0; dt < 4; ++dt) oacc[dt] = (f32x4){0.f, 0.f, 0.f, 0.f};
#pragma unroll
            for (int ks = 0; ks < 5; ++ks) { const int ta = w + 2 * ks, tb = ks < 4 ? ta + 1 : ta;
                const unsigned va = (unsigned)((ta < 8 ? prev : cur) * SLOT + (ta & 7) * 16 * 144) + vlane, vb = (unsigned)((tb < 8 ? prev : cur) * SLOT + (tb & 7) * 16 * 144) + vlane;
#pragma unroll
                for (int dt = 0; dt < 4; ++dt) { const s16x4 lo = __builtin_amdgcn_ds_read_tr16_b64_v4i16((LAS s16x4*)(Vs + va + dt * 32)), hi = __builtin_amdgcn_ds_read_tr16_b64_v4i16((LAS s16x4*)(Vs + vb + dt * 32));
                    const bf16x8 vf = (bf16x8){lo[0], lo[1], lo[2], lo[3], hi[0], hi[1], hi[2], hi[3]};
                    oacc[dt] = __builtin_amdgcn_mfma_f32_16x16x32_bf16(vf, pf[ks], oacc[dt], 0, 0, 0); } }
            const float il = 1.f / l;
            bf16_t* orow = op + tokq * 512 + h * 64 + 4 * fq;
#pragma unroll
            for (int dt = 0; dt < 4; ++dt) *(u32x2*)(orow + 16 * dt) = (u32x2){cvt_pk_bf16(oacc[dt][0] * il, oacc[dt][1] * il), cvt_pk_bf16(oacc[dt][2] * il, oacc[dt][3] * il)};
            if (fq == 0) lse[((size_t)p * T + tokq) * 8 + h] = (mx + __builtin_amdgcn_logf(l)) * LN2;
            if (more) DIL_STORE(nxt);
            __syncthreads();
        }
#undef DIL_LOAD
#undef DIL_STORE
    }
}
struct Args { const float* in[22]; float* out; unsigned char* ws; int ph_lo, ph_hi; };
constexpr int NPHASE = 22;

__global__ void __launch_bounds__(NTHREADS, 2) fwd_kernel(Args args) {
    extern __shared__ __attribute__((aligned(16))) unsigned char lds_raw[];
    Frame F;
    F.lds = (LAS unsigned char*)lds_raw;
    F.tid = threadIdx.x; F.lane = F.tid & 63; F.wave = __builtin_amdgcn_readfirstlane(F.tid >> 6);
    F.G = gridDim.x; F.gw = blockIdx.x * NWAVES + F.wave; F.NGW = F.G * NWAVES;
    F.ws = args.ws; F.ctl = (gu32*)(args.ws + WS_CTL); F.out = args.out;
    volatile LAS unsigned* MISC = (volatile LAS unsigned*)(F.lds + LDSCTL_OFF);
    if (F.tid < 64) MISC[F.tid] = 0u;
    __syncthreads();
    const int lo = args.ph_lo, hi = args.ph_hi;
    const bool use_bar = (hi - lo) > 1;
    XcdBarrier bar; bar.bar = (unsigned*)(F.ctl + CW_BAR); bar.x = 0; bar.st = nullptr;
    if (use_bar) bar = xcd_barrier_post((unsigned*)(F.ctl + CW_BAR), MISC + 8);
#ifndef PHMASK
#define PHMASK 0x3fffff
#endif
#define IN(k) (((PHMASK >> (k)) & 1) && lo <= (k) && (k) < hi)
#define SEAM(k) do { if (IN(k) && IN((k) + 1)) xcd_barrier(bar); } while (0)
    unsigned char* const big = F.ws + WS_BIG;
    bf16_t* const XN = (bf16_t*)(F.ws + WS_XN);
    bf16_t* const HC0 = (bf16_t*)(big + B_HCAT0);
    bf16_t* const HC1 = (bf16_t*)(big + B_HCAT1);
    const int NT = F.G * NTHREADS, gtid = blockIdx.x * NTHREADS + F.tid;

    if (IN(0)) {
        LAS float* scr = (LAS float*)(F.lds + F.wave * 16384);
        constexpr int I0 = (D / 64) * (LD0 / 32), I1 = (MIX0 / 64) * (D / 32), I2 = (D / 64) * (2 * FF0 / 32), I3 = (FF0 / 64) * (D / 32), I4 = (D / 64) * (LD1 / 32), I5 = (MIX1 / 64) * (D / 32);
        constexpr int NIT = I0 + I1 + I2 + I3 + I4 + I5;
        for (int it = F.gw; it < NIT; it += F.NGW) {
            int r = it;
            if (r < I0) { const int nblk = LD0 / 32, kb = r / nblk, nb = r % nblk, dr = 32 * nb; transpose_item(inptr(I_WIN0), LDW0, dr < W0_LR ? dr : dr + 16, (bf16_t*)(F.ws + WS_WIN0), D, dr, 64 * kb, scr, F.lane); continue; } r -= I0;
            if (r < I1) { transpose_plain(inptr(I_WOUT0), MIX0, D, (bf16_t*)(F.ws + WS_WOUT0), r, scr, F.lane); continue; } r -= I1;
            if (r < I2) { transpose_gateup(inptr(I_WFG), inptr(I_WFU), D, FF0, (bf16_t*)(F.ws + WS_WGU0), r, scr, F.lane); continue; } r -= I2;
            if (r < I3) { transpose_plain(inptr(I_WFD), FF0, D, (bf16_t*)(F.ws + WS_WD0), r, scr, F.lane); continue; } r -= I3;
            if (r < I4) { transpose_plain(inptr(I_WIN1), D, LD1, (bf16_t*)(F.ws + WS_WIN1), r, scr, F.lane); continue; } r -= I4;
            transpose_plain(inptr(I_WOUT1), MIX1, D, (bf16_t*)(F.ws + WS_WOUT1), r, scr, F.lane);
        }
        float* lr = (float*)(F.ws + WS_LR);
        const float* wlr = inptr(I_WIN0) + W0_LR;
        for (int m = F.gw; m < T; m += F.NGW) {
            f32x4 v[4]; rmsnorm_row(inptr(I_X) + (size_t)m * D, inptr(I_MN0), XN + (size_t)m * D, F.lane, v);
            float a[16];
#pragma unroll
            for (int r = 0; r < 16; ++r) a[r] = 0.f;
#pragma unroll
            for (int j = 0; j < 4; ++j)
#pragma unroll
                for (int e = 0; e < 4; ++e) { const int c = 256 * j + 4 * F.lane + e; const f32x4* wp = (const f32x4*)(wlr + (size_t)c * LDW0); const float xv = v[j][e];
#pragma unroll
                    for (int q = 0; q < 4; ++q) { const f32x4 w4 = wp[q]; a[4 * q] += xv * w4.x; a[4 * q + 1] += xv * w4.y; a[4 * q + 2] += xv * w4.z; a[4 * q + 3] += xv * w4.w; } }
            float mine = 0.f;
#pragma unroll
            for (int r = 0; r < 16; ++r) { const float s = wave_sum(a[r]); mine = (F.lane == r) ? s : mine; }
            if (F.lane < 16) lr[(size_t)m * 16 + F.lane] = mine;
        }
    }
    SEAM(0);

    if (IN(1)) {
        pg8::DenseOrder S; S.init(T, LD0, F.G, (int)blockIdx.x); pg8::PlainMap MP; pg8::EpiBf16 E{HC0, LD0};
        pg8::gemm_phase(F.lds, XN, D, (const bf16_t*)(F.ws + WS_WIN0), D, S, MP, E);
    }
    SEAM(1);

    if (IN(2)) {
        {
            const float* lr = (const float*)(F.ws + WS_LR); const float* wgu = inptr(I_WGATEUP); const float* bg = inptr(I_BGATE);
            bf16_t* att = (bf16_t*)(big + B_ATT0); bf16_t* kendT = (bf16_t*)(big + B_KENDT); float* decay = (float*)(F.ws + WS_DECAY);
            LAS float* qd_s = (LAS float*)F.lds;
            LAS float* ki_s = qd_s + 64 * 128;
            LAS float* grp = ki_s + 64 * 129;
            const int dk = F.tid & 127, sg = F.tid >> 7;
            for (int unit = blockIdx.x; unit < 2048; unit += F.G) {
                const int h = unit & 3, bn = unit >> 2, t0 = bn * 64;
                const int col = h * 128 + dk;
                float w16[16];
#pragma unroll
                for (int r = 0; r < 16; ++r) w16[r] = wgu[r * 512 + col];
                const float bias = bg[col];
                float cum[16]; float run = 0.f;
#pragma unroll
                for (int i = 0; i < 16; ++i) { const int t = t0 + 16 * sg + i; const f32x4* lp = (const f32x4*)(lr + (size_t)t * 16); float z = bias;
#pragma unroll
                    for (int q = 0; q < 4; ++q) { const f32x4 l4 = lp[q]; z += l4.x * w16[4 * q] + l4.y * w16[4 * q + 1] + l4.z * w16[4 * q + 2] + l4.w * w16[4 * q + 3]; }
                    run += logsigmoid_f(z) * (1.f / 16.f); cum[i] = run; }
                __syncthreads();
                grp[sg * 128 + dk] = run;
                __syncthreads();
                float off = 0.f, total = 0.f;
#pragma unroll
                for (int g = 0; g < 4; ++g) { const float gs = grp[g * 128 + dk]; total += gs; off += (g < sg) ? gs : 0.f; }
                unsigned kep[8];
#pragma unroll
                for (int i = 0; i < 16; ++i) { const int s = 16 * sg + i, t = t0 + s; const float c = off + cum[i];
                    bf16_t* qp = HC0 + (size_t)t * LD0 + C0_QA + col; const float q = bf2f(*qp), k = bf2f(HC0[(size_t)t * LD0 + C0_KA + col]);
                    const unsigned qdb = f2bf(q * __expf(c) * 0.08838834764831845f); *qp = (bf16_t)qdb; qd_s[s * 128 + dk] = __uint_as_float(qdb << 16);
                    ki_s[s * 129 + dk] = bfround(k * __expf(-c));
                    const unsigned keb = f2bf(k * __expf(total - c)); if (i & 1) kep[i >> 1] |= keb << 16; else kep[i >> 1] = keb; }
                { u32x4* kp = (u32x4*)(kendT + ((size_t)unit * 128 + dk) * 64 + 16 * sg); kp[0] = (u32x4){kep[0], kep[1], kep[2], kep[3]}; kp[1] = (u32x4){kep[4], kep[5], kep[6], kep[7]}; }
                if (sg == 0) decay[unit * 128 + dk] = __expf(total);
                __syncthreads();
#pragma unroll 1
                for (int i = 0; i < 8; ++i) { const int p = F.tid + 512 * i, s = p >> 6, s2 = p & 63; float a = 0.f;
                    if (s2 <= s) { for (int d = 0; d < 128; ++d) a += qd_s[s * 128 + d] * ki_s[s2 * 129 + d]; }
                    att[(size_t)unit * 4096 + p] = (bf16_t)f2bf(a); }
            }
            __syncthreads();
        }
    }
    SEAM(2);

    if (IN(3)) {
        const bf16_t* att = (const bf16_t*)(big + B_ATT0); const bf16_t* kendT = (const bf16_t*)(big + B_KENDT); const float* decay = (const float*)(F.ws + WS_DECAY);
        LAS float* att_s = (LAS float*)F.lds;
        LAS float* qd_s = att_s + 64 * 65;
        LAS float* ke_s = qd_s + 64 * 129;
        LAS float* v_s = ke_s + 128 * 65;
        LAS float* S_s = v_s + 64 * 16;
        LAS float* dc_s = S_s + 128 * 16;
        for (int item = blockIdx.x; item < 256; item += F.G) {
            const int sl = item & 15, h = (item >> 4) & 3, b = item >> 6;
            for (int i = F.tid; i < 128 * 16; i += NTHREADS) S_s[i] = 0.f;
            __syncthreads();
            for (int n = 0; n < 128; ++n) {
                const int unit = (b * 128 + n) * 4 + h, t0 = b * SEQ + n * 64;
                { const u32x4 raw = *(const u32x4*)(att + (size_t)unit * 4096 + F.tid * 8); const int s = F.tid >> 3, c0 = (F.tid & 7) * 8; LAS float* d = att_s + s * 65 + c0;
                  d[0] = __uint_as_float(raw.x << 16); d[1] = __uint_as_float(raw.x & 0xffff0000u); d[2] = __uint_as_float(raw.y << 16); d[3] = __uint_as_float(raw.y & 0xffff0000u);
                  d[4] = __uint_as_float(raw.z << 16); d[5] = __uint_as_float(raw.z & 0xffff0000u); d[6] = __uint_as_float(raw.w << 16); d[7] = __uint_as_float(raw.w & 0xffff0000u); }
#pragma unroll
                for (int rep = 0; rep < 2; ++rep) { const int ch = F.tid + 512 * rep;
                    { const int s = ch >> 4, c0 = (ch & 15) * 8; const u32x4 raw = *(const u32x4*)(HC0 + (size_t)(t0 + s) * LD0 + C0_QA + h * 128 + c0); LAS float* d = qd_s + s * 129 + c0;
                      d[0] = __uint_as_float(raw.x << 16); d[1] = __uint_as_float(raw.x & 0xffff0000u); d[2] = __uint_as_float(raw.y << 16); d[3] = __uint_as_float(raw.y & 0xffff0000u);
                      d[4] = __uint_as_float(raw.z << 16); d[5] = __uint_as_float(raw.z & 0xffff0000u); d[6] = __uint_as_float(raw.w << 16); d[7] = __uint_as_float(raw.w & 0xffff0000u); }
                    { const int dk = ch >> 3, c0 = (ch & 7) * 8; const u32x4 raw = *(const u32x4*)(kendT + ((size_t)unit * 128 + dk) * 64 + c0); LAS float* d = ke_s + dk * 65 + c0;
                      d[0] = __uint_as_float(raw.x << 16); d[1] = __uint_as_float(raw.x & 0xffff0000u); d[2] = __uint_as_float(raw.y << 16); d[3] = __uint_as_float(raw.y & 0xffff0000u);
                      d[4] = __uint_as_float(raw.z << 16); d[5] = __uint_as_float(raw.z & 0xffff0000u); d[6] = __uint_as_float(raw.w << 16); d[7] = __uint_as_float(raw.w & 0xffff0000u); } }
                if (F.tid < 128) { const int s = F.tid >> 1, c0 = (F.tid & 1) * 8; const u32x4 raw = *(const u32x4*)(HC0 + (size_t)(t0 + s) * LD0 + C0_VA + h * 256 + sl * 16 + c0); LAS float* d = v_s + s * 16 + c0;
                    d[0] = __uint_as_float(raw.x << 16); d[1] = __uint_as_float(raw.x & 0xffff0000u); d[2] = __uint_as_float(raw.y << 16); d[3] = __uint_as_float(raw.y & 0xffff0000u);
                    d[4] = __uint_as_float(raw.z << 16); d[5] = __uint_as_float(raw.z & 0xffff0000u); d[6] = __uint_as_float(raw.w << 16); d[7] = __uint_as_float(raw.w & 0xffff0000u); }
                else if (F.tid < 256) dc_s[F.tid - 128] = decay[unit * 128 + F.tid - 128];
                __syncthreads();
                { const int s = F.tid >> 3, dv = (F.tid & 7) * 2; float o0 = 0.f, o1 = 0.f;
                  for (int j = 0; j < 64; ++j) { const float a = att_s[s * 65 + j]; o0 += a * v_s[j * 16 + dv]; o1 += a * v_s[j * 16 + dv + 1]; }
                  for (int d = 0; d < 128; ++d) { const float q = qd_s[s * 129 + d]; o0 += q * S_s[d * 16 + dv]; o1 += q * S_s[d * 16 + dv + 1]; }
                  *(unsigned*)(HC0 + (size_t)(t0 + s) * LD0 + C0_VA + h * 256 + sl * 16 + dv) = pk2(o0, o1); }
                __syncthreads();
                { const int dk = F.tid >> 2, dv = (F.tid & 3) * 4; const float dc = dc_s[dk]; float a0 = S_s[dk * 16 + dv] * dc, a1 = S_s[dk * 16 + dv + 1] * dc, a2 = S_s[dk * 16 + dv + 2] * dc, a3 = S_s[dk * 16 + dv + 3] * dc;
                  for (int s = 0; s < 64; ++s) { const float k = ke_s[dk * 65 + s]; a0 += k * v_s[s * 16 + dv]; a1 += k * v_s[s * 16 + dv + 1]; a2 += k * v_s[s * 16 + dv + 2]; a3 += k * v_s[s * 16 + dv + 3]; }
                  S_s[dk * 16 + dv] = a0; S_s[dk * 16 + dv + 1] = a1; S_s[dk * 16 + dv + 2] = a2; S_s[dk * 16 + dv + 3] = a3; }
                __syncthreads();
            }
        }
    }
    SEAM(3);

    if (IN(4)) dilated_phase(F, HC0, (bf16_t*)(F.ws + WS_XN), (bf16_t*)(big + B_OP2), (float*)(F.ws + WS_LSE));
    SEAM(4);

    if (IN(5)) {
        const float* gn = inptr(I_GLANORM); const float* lse = (const float*)(F.ws + WS_LSE);
        float gw16[16];
#pragma unroll
        for (int e = 0; e < 16; ++e) gw16[e] = gn[(16 * F.lane + e) & 255];
        for (int t = F.gw; t < T; t += F.NGW) {
            bf16_t* row = HC0 + (size_t)t * LD0;
            { const u32x4* op = (const u32x4*)(row + C0_VA + 16 * F.lane); u32x4* rp = (u32x4*)(row + C0_RA + 16 * F.lane); float o[16], g[16];
#pragma unroll
              for (int c = 0; c < 2; ++c) { const u32x4 a = op[c], r4 = rp[c];
                  o[8 * c] = __uint_as_float(a.x << 16); o[8 * c + 1] = __uint_as_float(a.x & 0xffff0000u); o[8 * c + 2] = __uint_as_float(a.y << 16); o[8 * c + 3] = __uint_as_float(a.y & 0xffff0000u);
                  o[8 * c + 4] = __uint_as_float(a.z << 16); o[8 * c + 5] = __uint_as_float(a.z & 0xffff0000u); o[8 * c + 6] = __uint_as_float(a.w << 16); o[8 * c + 7] = __uint_as_float(a.w & 0xffff0000u);
                  g[8 * c] = __uint_as_float(r4.x << 16); g[8 * c + 1] = __uint_as_float(r4.x & 0xffff0000u); g[8 * c + 2] = __uint_as_float(r4.y << 16); g[8 * c + 3] = __uint_as_float(r4.y & 0xffff0000u);
                  g[8 * c + 4] = __uint_as_float(r4.z << 16); g[8 * c + 5] = __uint_as_float(r4.z & 0xffff0000u); g[8 * c + 6] = __uint_as_float(r4.w << 16); g[8 * c + 7] = __uint_as_float(r4.w & 0xffff0000u); }
              float ss = 0.f;
#pragma unroll
              for (int e = 0; e < 16; ++e) ss += o[e] * o[e];
              ss += __shfl_xor(ss, 1); ss += __shfl_xor(ss, 2); ss += __shfl_xor(ss, 4); ss += __shfl_xor(ss, 8);
              const float rs = 1.f / sqrtf(ss * (1.f / 256.f) + NORM_EPS);
#pragma unroll
              for (int e = 0; e < 16; ++e) o[e] = o[e] * rs * gw16[e] * silu_f(g[e]);
#pragma unroll
              for (int c = 0; c < 2; ++c) rp[c] = (u32x4){pk2(o[8 * c], o[8 * c + 1]), pk2(o[8 * c + 2], o[8 * c + 3]), pk2(o[8 * c + 4], o[8 * c + 5]), pk2(o[8 * c + 6], o[8 * c + 7])}; }
            { const int hh = F.lane >> 3; const float l0 = lse[((size_t)0 * T + t) * 8 + hh], l1 = lse[((size_t)1 * T + t) * 8 + hh], l2 = lse[((size_t)2 * T + t) * 8 + hh];
              const float mx = fmaxf(l0, fmaxf(l1, l2)); float w0 = __expf(l0 - mx), w1 = __expf(l1 - mx), w2 = __expf(l2 - mx); const float iw = 1.f / (w0 + w1 + w2); w0 *= iw; w1 *= iw; w2 *= iw;
              const u32x4 a = *(const u32x4*)((const bf16_t*)(F.ws + WS_XN) + (size_t)t * 512 + 8 * F.lane), bq = *(const u32x4*)((const bf16_t*)(F.ws + WS_XN) + (size_t)(T + t) * 512 + 8 * F.lane), c = *(const u32x4*)((const bf16_t*)(big + B_OP2) + (size_t)t * 512 + 8 * F.lane);
              float r[8];
              r[0] = w0 * __uint_as_float(a.x << 16) + w1 * __uint_as_float(bq.x << 16) + w2 * __uint_as_float(c.x << 16); r[1] = w0 * __uint_as_float(a.x & 0xffff0000u) + w1 * __uint_as_float(bq.x & 0xffff0000u) + w2 * __uint_as_float(c.x & 0xffff0000u);
              r[2] = w0 * __uint_as_float(a.y << 16) + w1 * __uint_as_float(bq.y << 16) + w2 * __uint_as_float(c.y << 16); r[3] = w0 * __uint_as_float(a.y & 0xffff0000u) + w1 * __uint_as_float(bq.y & 0xffff0000u) + w2 * __uint_as_float(c.y & 0xffff0000u);
              r[4] = w0 * __uint_as_float(a.z << 16) + w1 * __uint_as_float(bq.z << 16) + w2 * __uint_as_float(c.z << 16); r[5] = w0 * __uint_as_float(a.z & 0xffff0000u) + w1 * __uint_as_float(bq.z & 0xffff0000u) + w2 * __uint_as_float(c.z & 0xffff0000u);
              r[6] = w0 * __uint_as_float(a.w << 16) + w1 * __uint_as_float(bq.w << 16) + w2 * __uint_as_float(c.w << 16); r[7] = w0 * __uint_as_float(a.w & 0xffff0000u) + w1 * __uint_as_float(bq.w & 0xffff0000u) + w2 * __uint_as_float(c.w & 0xffff0000u);
              *(u32x4*)(row + C0_QB + 8 * F.lane) = (u32x4){pk2(r[0], r[1]), pk2(r[2], r[3]), pk2(r[4], r[5]), pk2(r[6], r[7])}; }
        }
    }
    SEAM(5);

    if (IN(6)) {
        pg8::DenseOrder S; S.init(T, D, F.G, (int)blockIdx.x); pg8::PlainMap MP; pg8::EpiResF32 E{inptr(I_X), F.out, D};
        pg8::gemm_phase(F.lds, HC0 + C0_RA, LD0, (const bf16_t*)(F.ws + WS_WOUT0), MIX0, S, MP, E);
    }
    SEAM(6);

    if (IN(7)) { for (int m = F.gw; m < T; m += F.NGW) { f32x4 v[4]; rmsnorm_row(F.out + (size_t)m * D, inptr(I_FN0), XN + (size_t)m * D, F.lane, v); } }
    SEAM(7);

    if (IN(8)) {
        pg8::DenseOrder S; S.init(T, 2 * FF0, F.G, (int)blockIdx.x); pg8::PlainMap MP; pg8::EpiSwiGLU E{(bf16_t*)(big + B_H0), FF0};
        pg8::gemm_phase(F.lds, XN, D, (const bf16_t*)(F.ws + WS_WGU0), D, S, MP, E);
    }
    SEAM(8);

    if (IN(9)) {
        pg8::DenseOrder S; S.init(T, D, F.G, (int)blockIdx.x); pg8::PlainMap MP; pg8::EpiResF32 E{F.out, F.out, D};
        pg8::gemm_phase(F.lds, (const bf16_t*)(big + B_H0), FF0, (const bf16_t*)(F.ws + WS_WD0), FF0, S, MP, E);
    }
    SEAM(9);

    if (IN(10)) { for (int m = F.gw; m < T; m += F.NGW) { f32x4 v[4]; rmsnorm_row(F.out + (size_t)m * D, inptr(I_MN1), XN + (size_t)m * D, F.lane, v); } }
    SEAM(10);

    if (IN(11)) {
        pg8::DenseOrder S; S.init(T, LD1, F.G, (int)blockIdx.x); pg8::PlainMap MP; pg8::EpiBf16 E{HC1, LD1};
        pg8::gemm_phase(F.lds, XN, D, (const bf16_t*)(F.ws + WS_WIN1), D, S, MP, E);
    }
    SEAM(11);

    if (IN(12)) {
        bf16_t* att = (bf16_t*)(big + B_ATT1); bf16_t* kdT = (bf16_t*)(F.ws + WS_XN);
        LAS bf16_t* qd_s = (LAS bf16_t*)F.lds;
        LAS bf16_t* ki_s = qd_s + 128 * 258;
        const int dk = F.tid & 255, sg = F.tid >> 8;
        for (int unit = blockIdx.x; unit < 1024; unit += F.G) {
            const int h = unit & 3, bn = unit >> 2, t0 = bn * 128;
            const float lg = log1pf(-exp2f(-5.f - (float)h));
            __syncthreads();
#pragma unroll 1
            for (int i8 = 0; i8 < 8; ++i8) {
                unsigned kp[4];
#pragma unroll
                for (int i = 0; i < 8; ++i) { const int s = 64 * sg + 8 * i8 + i, t = t0 + s;
                    bf16_t* qp = HC1 + (size_t)t * LD1 + C1_Q + h * 256 + dk; const float q = bf2f(*qp), k = bf2f(HC1[(size_t)t * LD1 + C1_K + h * 256 + dk]);
                    const unsigned qdb = f2bf(q * __expf(lg * (float)(s + 1))); *qp = (bf16_t)qdb; qd_s[s * 258 + dk] = (bf16_t)qdb;
                    ki_s[s * 258 + dk] = (bf16_t)f2bf(k * __expf(-lg * (float)(s + 1)));
                    const unsigned kdb = f2bf(k * __expf(lg * (float)(127 - s)) * 0.0625f); if (i & 1) kp[i >> 1] |= kdb << 16; else kp[i >> 1] = kdb; }
                *(u32x4*)(kdT + ((size_t)unit * 256 + dk) * 128 + 64 * sg + 8 * i8) = (u32x4){kp[0], kp[1], kp[2], kp[3]};
            }
            __syncthreads();
#pragma unroll 1
            for (int i = 0; i < 32; ++i) { const int p = F.tid + 512 * i, s = p >> 7, s2 = p & 127; float a = 0.f;
                if (s2 <= s) { for (int d = 0; d < 256; ++d) a += bf2f(qd_s[s * 258 + d]) * bf2f(ki_s[s2 * 258 + d]); }
                att[(size_t)unit * 16384 + p] = (bf16_t)f2bf(a * 0.0625f); }
        }
        __syncthreads();
    }
    SEAM(12);

    if (IN(13)) {
        const bf16_t* att = (const bf16_t*)(big + B_ATT1); const bf16_t* kdT = (const bf16_t*)(F.ws + WS_XN);
        LAS float* v_s = (LAS float*)F.lds;
        LAS float* S_s = v_s + 128 * 32;
        for (int item = blockIdx.x; item < 256; item += F.G) {
            const int sl = item & 15, h = (item >> 4) & 3, b = item >> 6;
            const float cdec = __expf(128.f * log1pf(-exp2f(-5.f - (float)h)));
            for (int i = F.tid; i < 256 * 33; i += NTHREADS) S_s[i] = 0.f;
            __syncthreads();
            for (int n = 0; n < 64; ++n) {
                const int unit = (b * 64 + n) * 4 + h, t0 = b * SEQ + n * 128;
                { const int s = F.tid >> 2, c0 = (F.tid & 3) * 8; const u32x4 raw = *(const u32x4*)(HC1 + (size_t)(t0 + s) * LD1 + C1_V + h * 512 + sl * 32 + c0); LAS float* d = v_s + s * 32 + c0;
                  d[0] = __uint_as_float(raw.x << 16); d[1] = __uint_as_float(raw.x & 0xffff0000u); d[2] = __uint_as_float(raw.y << 16); d[3] = __uint_as_float(raw.y & 0xffff0000u);
                  d[4] = __uint_as_float(raw.z << 16); d[5] = __uint_as_float(raw.z & 0xffff0000u); d[6] = __uint_as_float(raw.w << 16); d[7] = __uint_as_float(raw.w & 0xffff0000u); }
                __syncthreads();
                { const int s = F.tid >> 2, dv0 = (F.tid & 3) * 8; float o[8];
#pragma unroll
                  for (int e = 0; e < 8; ++e) o[e] = 0.f;
                  const bf16_t* ap = att + (size_t)unit * 16384 + s * 128;
                  for (int j = 0; j <= s; ++j) { const float a = bf2f(ap[j]);
#pragma unroll
                      for (int e = 0; e < 8; ++e) o[e] += a * v_s[j * 32 + dv0 + e]; }
                  const bf16_t* qp = HC1 + (size_t)(t0 + s) * LD1 + C1_Q + h * 256;
                  for (int d = 0; d < 256; ++d) { const float q = bf2f(qp[d]);
#pragma unroll
                      for (int e = 0; e < 8; ++e) o[e] += q * S_s[d * 33 + dv0 + e]; }
                  *(u32x4*)(HC1 + (size_t)(t0 + s) * LD1 + C1_V + h * 512 + sl * 32 + dv0) = (u32x4){pk2(o[0], o[1]), pk2(o[2], o[3]), pk2(o[4], o[5]), pk2(o[6], o[7])}; }
                __syncthreads();
                { const int dk = F.tid >> 1, dv0 = (F.tid & 1) * 16; float a[16];
#pragma unroll
                  for (int e = 0; e < 16; ++e) a[e] = S_s[dk * 33 + dv0 + e] * cdec;
                  const bf16_t* kp = kdT + ((size_t)unit * 256 + dk) * 128;
                  for (int s = 0; s < 128; ++s) { const float k = bf2f(kp[s]);
#pragma unroll
                      for (int e = 0; e < 16; ++e) a[e] += k * v_s[s * 32 + dv0 + e]; }
#pragma unroll
                  for (int e = 0; e < 16; ++e) S_s[dk * 33 + dv0 + e] = a[e]; }
                __syncthreads();
            }
        }
    }
    SEAM(13);

    if (IN(14)) {
        const float* gnw = inptr(I_RETGN);
        for (int t = F.gw; t < T; t += F.NGW) {
            bf16_t* row = HC1 + (size_t)t * LD1; const u32x4* op = (const u32x4*)(row + C1_V + 32 * F.lane); u32x4* gp = (u32x4*)(row + C1_G + 32 * F.lane);
            float o[32]; float s = 0.f;
#pragma unroll
            for (int c = 0; c < 4; ++c) { const u32x4 a = op[c];
                o[8 * c] = __uint_as_float(a.x << 16); o[8 * c + 1] = __uint_as_float(a.x & 0xffff0000u); o[8 * c + 2] = __uint_as_float(a.y << 16); o[8 * c + 3] = __uint_as_float(a.y & 0xffff0000u);
                o[8 * c + 4] = __uint_as_float(a.z << 16); o[8 * c + 5] = __uint_as_float(a.z & 0xffff0000u); o[8 * c + 6] = __uint_as_float(a.w << 16); o[8 * c + 7] = __uint_as_float(a.w & 0xffff0000u); }
#pragma unroll
            for (int e = 0; e < 32; ++e) s += o[e];
            s += __shfl_xor(s, 1); s += __shfl_xor(s, 2); s += __shfl_xor(s, 4); s += __shfl_xor(s, 8);
            const float mu = s * (1.f / 512.f); float q = 0.f;
#pragma unroll
            for (int e = 0; e < 32; ++e) { o[e] -= mu; q += o[e] * o[e]; }
            q += __shfl_xor(q, 1); q += __shfl_xor(q, 2); q += __shfl_xor(q, 4); q += __shfl_xor(q, 8);
            const float rs = 1.f / sqrtf(q * (1.f / 512.f) + GN_EPS);
#pragma unroll
            for (int c = 0; c < 4; ++c) { const u32x4 g4 = gp[c]; const f32x4 w0 = *(const f32x4*)(gnw + 32 * F.lane + 8 * c), w1 = *(const f32x4*)(gnw + 32 * F.lane + 8 * c + 4);
                const float g0 = __uint_as_float(g4.x << 16), g1 = __uint_as_float(g4.x & 0xffff0000u), g2 = __uint_as_float(g4.y << 16), g3 = __uint_as_float(g4.y & 0xffff0000u);
                const float g4_ = __uint_as_float(g4.z << 16), g5 = __uint_as_float(g4.z & 0xffff0000u), g6 = __uint_as_float(g4.w << 16), g7 = __uint_as_float(g4.w & 0xffff0000u);
                gp[c] = (u32x4){pk2(o[8 * c] * rs * w0.x * silu_f(g0), o[8 * c + 1] * rs * w0.y * silu_f(g1)), pk2(o[8 * c + 2] * rs * w0.z * silu_f(g2), o[8 * c + 3] * rs * w0.w * silu_f(g3)),
                                pk2(o[8 * c + 4] * rs * w1.x * silu_f(g4_), o[8 * c + 5] * rs * w1.y * silu_f(g5)), pk2(o[8 * c + 6] * rs * w1.z * silu_f(g6), o[8 * c + 7] * rs * w1.w * silu_f(g7))}; }
        }
    }
    SEAM(14);

    if (IN(15)) {
        pg8::DenseOrder S; S.init(T, D, F.G, (int)blockIdx.x); pg8::PlainMap MP; pg8::EpiResF32 E{F.out, F.out, D};
        pg8::gemm_phase(F.lds, HC1 + C1_G, LD1, (const bf16_t*)(F.ws + WS_WOUT1), MIX1, S, MP, E);
    }
    SEAM(15);

    if (IN(16)) {
        LAS float* scr = (LAS float*)(F.lds + F.wave * 16384);
        constexpr int IGU = (D / 64) * (2 * FFE / 32), IDN = (FFE / 64) * (D / 32);
        for (int it = F.gw; it < NEXP * (IGU + IDN); it += F.NGW) {
            const int e = it / (IGU + IDN), r = it % (IGU + IDN);
            if (r < IGU) transpose_gateup(inptr(I_WEG) + (size_t)e * D * FFE, inptr(I_WEU) + (size_t)e * D * FFE, D, FFE, (bf16_t*)(big + B_WEGU) + (size_t)e * 2 * FFE * D, r, scr, F.lane);
            else transpose_plain(inptr(I_WED) + (size_t)e * FFE * D, FFE, D, (bf16_t*)(big + B_WED) + (size_t)e * D * FFE, r - IGU, scr, F.lane);
        }
        int* rowtok = (int*)(F.ws + WS_ROUTE + R_ROWTOK); float* rowgate = (float*)(F.ws + WS_ROUTE + R_ROWGATE);
        for (int i = gtid; i < 2 * MOE_ROWS; i += NT) { rowtok[i] = -1; rowgate[i] = 0.f; }
        f32x4* tokinfo = (f32x4*)(F.ws + WS_ROUTE + R_TOKINFO);
        const float* wr_ = inptr(I_WROUTER);
        for (int m = F.gw; m < T; m += F.NGW) {
            f32x4 v[4]; rmsnorm_row(F.out + (size_t)m * D, inptr(I_FN1), XN + (size_t)m * D, F.lane, v);
            float a[8];
#pragma unroll
            for (int r = 0; r < 8; ++r) a[r] = 0.f;
#pragma unroll
            for (int j = 0; j < 4; ++j)
#pragma unroll
                for (int e = 0; e < 4; ++e) { const int c = 256 * j + 4 * F.lane + e; const f32x4* wp = (const f32x4*)(wr_ + (size_t)c * 8); const float xv = v[j][e]; const f32x4 w0 = wp[0], w1 = wp[1];
                    a[0] += xv * w0.x; a[1] += xv * w0.y; a[2] += xv * w0.z; a[3] += xv * w0.w; a[4] += xv * w1.x; a[5] += xv * w1.y; a[6] += xv * w1.z; a[7] += xv * w1.w; }
#pragma unroll
            for (int r = 0; r < 8; ++r) a[r] = wave_sum(a[r]);
            int e0 = 0; float l0 = a[0];
#pragma unroll
            for (int r = 1; r < 8; ++r) if (a[r] > l0) { l0 = a[r]; e0 = r; }
            int e1 = -1; float l1 = -3.4e38f;
#pragma unroll
            for (int r = 0; r < 8; ++r) if (r != e0 && a[r] > l1) { l1 = a[r]; e1 = r; }
            const float g0 = 1.f / (1.f + __expf(l1 - l0)), g1 = 1.f - g0;
            if (F.lane == 0) tokinfo[m] = (f32x4){__int_as_float(e0), __int_as_float(e1), g0, g1};
        }
    }
    SEAM(16);

    if (IN(17)) {
        if (blockIdx.x == 0) {
            const f32x4* tokinfo = (const f32x4*)(F.ws + WS_ROUTE + R_TOKINFO);
            int* rowtok = (int*)(F.ws + WS_ROUTE + R_ROWTOK); float* rowgate = (float*)(F.ws + WS_ROUTE + R_ROWGATE);
            int* blkexp = (int*)(F.ws + WS_ROUTE + R_BLKEXP); int* nblk = (int*)(F.ws + WS_ROUTE + R_NBLK);
            LAS int* cnt = (LAS int*)F.lds;
            LAS int* tot = cnt + 512 * 17;
            for (int k = 0; k < 16; ++k) cnt[F.tid * 17 + k] = 0;
            for (int i = 0; i < 64; ++i) { const f32x4 ti = tokinfo[F.tid * 64 + i]; cnt[F.tid * 17 + __float_as_int(ti.x)] += 1; cnt[F.tid * 17 + 8 + __float_as_int(ti.y)] += 1; }
            __syncthreads();
            if (F.tid < 16) { int run = 0; for (int i = 0; i < 512; ++i) { const int c = cnt[i * 17 + F.tid]; cnt[i * 17 + F.tid] = run; run += c; } tot[F.tid] = run; }
            __syncthreads();
            if (F.tid < 2) { int ps = 0, nb = 0; for (int e = 0; e < 8; ++e) { tot[16 + F.tid * 8 + e] = ps; const int c = tot[F.tid * 8 + e], bl = (c + 255) >> 8; for (int j = 0; j < bl; ++j) blkexp[F.tid * MOE_BLKS + nb + j] = e; nb += bl; ps += bl * 256; } nblk[F.tid] = nb; }
            __syncthreads();
            for (int i = 0; i < 64; ++i) { const int tok = F.tid * 64 + i; const f32x4 ti = tokinfo[tok]; const int e0 = __float_as_int(ti.x), e1 = __float_as_int(ti.y);
                const int r0 = tot[16 + e0] + cnt[F.tid * 17 + e0]; cnt[F.tid * 17 + e0] += 1; rowtok[r0] = tok; rowgate[r0] = ti.z;
                const int r1 = tot[24 + e1] + cnt[F.tid * 17 + 8 + e1]; cnt[F.tid * 17 + 8 + e1] += 1; rowtok[MOE_ROWS + r1] = tok; rowgate[MOE_ROWS + r1] = ti.w; }
        }
    }
    SEAM(17);

#pragma unroll
    for (int slot = 0; slot < 2; ++slot) {
        if (IN(18 + 2 * slot)) {
            const int* rowtok = (const int*)(F.ws + WS_ROUTE + R_ROWTOK) + slot * MOE_ROWS; const int* blkexp = (const int*)(F.ws + WS_ROUTE + R_BLKEXP) + slot * MOE_BLKS;
            const int nb = ((const int*)(F.ws + WS_ROUTE + R_NBLK))[slot];
            MoeOrder S; S.init(nb, 2 * FFE / 256, F.G, (int)blockIdx.x); pg8::MoeMap MP{rowtok, blkexp, 2 * FFE}; pg8::EpiSwiGLU E{(bf16_t*)(big + B_HMOE), FFE};
            pg8::gemm_phase(F.lds, XN, D, (const bf16_t*)(big + B_WEGU), D, S, MP, E);
        }
        SEAM(18 + 2 * slot);
        if (IN(19 + 2 * slot)) {
            const int* rowtok = (const int*)(F.ws + WS_ROUTE + R_ROWTOK) + slot * MOE_ROWS; const float* rowgate = (const float*)(F.ws + WS_ROUTE + R_ROWGATE) + slot * MOE_ROWS;
            const int* blkexp = (const int*)(F.ws + WS_ROUTE + R_BLKEXP) + slot * MOE_BLKS; const int nb = ((const int*)(F.ws + WS_ROUTE + R_NBLK))[slot];
            MoeOrder S; S.init(nb, D / 256, F.G, (int)blockIdx.x); pg8::MoeMap MP{nullptr, blkexp, D}; pg8::EpiMoeDown E{F.out, rowtok, rowgate};
            pg8::gemm_phase(F.lds, (const bf16_t*)(big + B_HMOE), FFE, (const bf16_t*)(big + B_WED), FFE, S, MP, E);
        }
        if (slot == 0) SEAM(19);
    }
#undef IN
#undef SEAM
}

#ifndef N_LAUNCH_MODE
#define N_LAUNCH_MODE 1
#endif
extern "C" void kernel_launch(void* const* d_in, const int* in_sizes, int n_in, void* d_out, int out_size, void* d_ws, size_t ws_size, hipStream_t stream) {
    static int grid = 0;
    if (grid == 0) {
        if (n_in != 22 || out_size != T * D || ws_size < WS_END) { fprintf(stderr, "kernel_launch: unexpected shapes (n_in %d out %d ws %zu need %zu)\n", n_in, out_size, ws_size, (size_t)WS_END); grid = -1; return; }
        int dev = 0, cus = 0, per_cu = 0;
        if (hipGetDevice(&dev) != hipSuccess || hipDeviceGetAttribute(&cus, hipDeviceAttributeMultiprocessorCount, dev) != hipSuccess) { grid = -1; return; }
        if (hipFuncSetAttribute((const void*)fwd_kernel, hipFuncAttributeMaxDynamicSharedMemorySize, LDS_BYTES) != hipSuccess) { fprintf(stderr, "kernel_launch: hipFuncSetAttribute failed\n"); grid = -1; return; }
        if (hipOccupancyMaxActiveBlocksPerMultiprocessor(&per_cu, (const void*)fwd_kernel, NTHREADS, LDS_BYTES) != hipSuccess || per_cu < 1) { fprintf(stderr, "kernel_launch: occupancy query says %d\n", per_cu); (void)hipGetLastError(); grid = -1; return; }
        grid = cus;
    }
    if (grid < 0) return;
    (void)hipMemsetAsync((char*)d_ws + WS_CTL, 0, CTL_ZERO_BYTES, stream);
    Args a{};
    for (int i = 0; i < 22; ++i) a.in[i] = (const float*)d_in[i];
    a.out = (float*)d_out; a.ws = (unsigned char*)d_ws;
#if N_LAUNCH_MODE == 1
    a.ph_lo = 0; a.ph_hi = NPHASE;
    hipLaunchKernelGGL(fwd_kernel, dim3(grid), dim3(NTHREADS), LDS_BYTES, stream, a);
#else
    for (int p = 0; p < NPHASE; ++p) { a.ph_lo = p; a.ph_hi = p + 1; hipLaunchKernelGGL(fwd_kernel, dim3(grid), dim3(NTHREADS), LDS_BYTES, stream, a); }
#endif
}
```

```cpp
#include <hip/hip_runtime.h>
#include <cstdio>
#include <cstdint>

#ifndef NAIVE_RECUR
#define NAIVE_RECUR 0
#endif
#define LAS __attribute__((address_space(3)))
#define GAS __attribute__((address_space(1)))
typedef unsigned short bf16_t;
typedef short bf16x8 __attribute__((ext_vector_type(8)));
typedef float f32x4 __attribute__((ext_vector_type(4)));
typedef float f32x2 __attribute__((ext_vector_type(2)));
typedef unsigned u32x4 __attribute__((ext_vector_type(4)));
typedef unsigned u32x2 __attribute__((ext_vector_type(2)));
typedef GAS unsigned gu32;
#define RLX_AGENT __ATOMIC_RELAXED, __HIP_MEMORY_SCOPE_AGENT
#define LDS_WAIT() asm volatile("s_waitcnt lgkmcnt(0)" ::: "memory")
#define VM_WAIT() asm volatile("s_waitcnt vmcnt(0)" ::: "memory")

constexpr int NBATCH = 4, SEQ = 8192, T = NBATCH * SEQ, D = 1024;
constexpr float NORM_EPS = 1e-6f, GN_EPS = 1e-5f;
constexpr int LDW0 = 4624, LD0 = 4608;
constexpr int C0_QA = 0, C0_KA = 512, C0_VA = 1024, C0_RA = 2048, C0_QB = 3072, C0_KB = 3584, C0_VB = 4096;
constexpr int W0_LR = 3072;
constexpr int MIX0 = 1536, FF0 = 2816;
constexpr int LD1 = 6144, C1_Q = 0, C1_K = 1024, C1_V = 2048, C1_G = 4096, MIX1 = 2048;
constexpr int NEXP = 8, FFE = 3584;
constexpr int MOE_ROWS = 34816, MOE_BLKS = 136;

constexpr size_t MiB = 1u << 20;
constexpr size_t WS_CTL = 0, CTL_ZERO_BYTES = 1 * MiB;
constexpr size_t WS_WIN0 = 1 * MiB, WS_WOUT0 = 10 * MiB, WS_WGU0 = 13 * MiB, WS_WD0 = 24 * MiB, WS_WIN1 = 30 * MiB, WS_WOUT1 = 42 * MiB;
constexpr size_t WS_LR = 46 * MiB, WS_DECAY = 48 * MiB, WS_LSE = 49 * MiB, WS_ROUTE = 52 * MiB;
constexpr size_t WS_XN = 56 * MiB;
constexpr size_t WS_BIG = 120 * MiB;
constexpr size_t B_HCAT0 = 0, B_ATT0 = 288 * MiB, B_KENDT = 304 * MiB, B_OP2 = 336 * MiB;
constexpr size_t B_H0 = 0;
constexpr size_t B_HCAT1 = 0, B_ATT1 = 384 * MiB;
constexpr size_t B_WEGU = 0, B_WED = 112 * MiB, B_HMOE = 168 * MiB;
constexpr size_t WS_END = WS_BIG + 416 * MiB;
constexpr size_t R_TOKINFO = 0, R_ROWTOK = 512 * 1024, R_ROWGATE = R_ROWTOK + 2 * MOE_ROWS * 4, R_BLKEXP = R_ROWGATE + 2 * MOE_ROWS * 4, R_NBLK = R_BLKEXP + 2 * MOE_BLKS * 4;
constexpr int CW_TMO = 0, CW_CODE = 1, CW_BAR = 4096;

constexpr int LDS_BYTES = 147456;
constexpr int RING_BYTES = 131072;
constexpr int LDSCTL_OFF = 139264;
constexpr int NWAVES = 8, NTHREADS = 512;

__device__ __forceinline__ float bf2f(bf16_t b) { return __uint_as_float(((unsigned)b) << 16); }
__device__ __forceinline__ unsigned f2bf(float f) { unsigned u = __float_as_uint(f); return (u + 0x7fffu + ((u >> 16) & 1u)) >> 16; }
__device__ __forceinline__ unsigned pk2(float lo, float hi) { return f2bf(lo) | (f2bf(hi) << 16); }
__device__ __forceinline__ float bfround(float f) { return __uint_as_float(f2bf(f) << 16); }
typedef __bf16 bf16v2_t __attribute__((ext_vector_type(2)));
__device__ __forceinline__ unsigned cvt_pk_bf16(float lo, float hi) { const bf16v2_t r = __builtin_convertvector((f32x2){lo, hi}, bf16v2_t); return __builtin_bit_cast(unsigned, r); }
__device__ __forceinline__ float wave_sum(float v) {
#pragma unroll
    for (int o = 1; o < 64; o <<= 1) v += __shfl_xor(v, o);
    return v;
}
__device__ __forceinline__ float silu_f(float v) { return v / (1.f + __expf(-v)); }
__device__ __forceinline__ float logsigmoid_f(float z) { return fminf(z, 0.f) - log1pf(__expf(-fabsf(z))); }

#define XB_TMO      128
#define XB_XCNT(j)  (256  + 64 * (j))
#define XB_XSUB(j)  (1280 + 64 * (j))
#define XB_XGEN(j)  (2304 + 64 * (j))
#define XB_TOP      3328
#define XB_TOPGEN   3392
#define XCD_BAR_WORDS 3456
#define XB_SPIN_CAP (1u << 22)
__device__ __forceinline__ unsigned xb_ld(unsigned* p)              { return __hip_atomic_load(p, __ATOMIC_RELAXED, __HIP_MEMORY_SCOPE_AGENT); }
__device__ __forceinline__ unsigned xb_add(unsigned* p, unsigned v) { return __hip_atomic_fetch_add(p, v, __ATOMIC_RELAXED, __HIP_MEMORY_SCOPE_AGENT); }
__device__ __forceinline__ unsigned xb_xcc_id() { return (unsigned)__builtin_amdgcn_s_getreg((3 << 11) | 20) & 0xFu; }
#define XB_SPIN(cond, bar) do { unsigned _sp = 0; while (cond) { __builtin_amdgcn_s_sleep(1); \
    if ((++_sp & 255u) == 0u) { if (xb_ld(&(bar)[XB_TMO])) break; if (_sp > XB_SPIN_CAP) { atomicAdd(&(bar)[XB_TMO], 1u); break; } } } } while (0)
struct XcdBarrier { unsigned* bar; unsigned x; volatile LAS unsigned* st; };
__device__ __forceinline__ XcdBarrier xcd_barrier_post(unsigned* bar, volatile LAS unsigned* st) {
    XcdBarrier b; b.bar = bar; b.x = xb_xcc_id(); b.st = st;
    if (threadIdx.x == 0) (void)xb_add(&bar[XB_XCNT(b.x)], 1u);
    return b;
}
__device__ __forceinline__ void xcd_barrier_complete(unsigned* bar, unsigned x, unsigned& nloc, unsigned& nx) {
    const unsigned G = gridDim.x * gridDim.y * gridDim.z;
    unsigned sum, cnt, mine, sp = 0u;
    for (;;) {
        sum = 0u; cnt = 0u; mine = 0u;
#pragma unroll
        for (unsigned j = 0; j < 16; ++j) { const unsigned c = xb_ld(&bar[XB_XCNT(j)]); sum += c; cnt += (c > 0u) ? 1u : 0u; mine = (j == x) ? c : mine; }
        if (sum == G) break;
        __builtin_amdgcn_s_sleep(1);
        if ((++sp & 255u) == 0u) { if (xb_ld(&bar[XB_TMO])) break; if (sp > XB_SPIN_CAP) { atomicAdd(&bar[XB_TMO], 1u); break; } }
    }
    nloc = mine > 0u ? mine : 1u; nx = cnt > 0u ? cnt : 1u;
}
__device__ __forceinline__ void xcd_barrier(const XcdBarrier& b) {
    asm volatile("s_waitcnt vmcnt(0)" ::: "memory");
    __syncthreads();
    if (threadIdx.x == 0) {
        unsigned* bar = b.bar;
        __builtin_amdgcn_s_waitcnt(0);
        unsigned nloc = b.st[0], nx = b.st[1];
        if (nloc == 0u) { xcd_barrier_complete(bar, b.x, nloc, nx); b.st[0] = nloc; b.st[1] = nx; }
        const unsigned old = xb_add(&bar[XB_XSUB(b.x)], 1u);
        const unsigned gen = old / nloc;
        if (old + 1u == (gen + 1u) * nloc) {
            __builtin_amdgcn_fence(__ATOMIC_RELEASE, "agent");
            asm volatile("s_waitcnt vmcnt(0)" ::: "memory");
            const unsigned og = xb_add(&bar[XB_TOP], 1u);
            const unsigned tg = og / nx;
            if (og + 1u == (tg + 1u) * nx) xb_add(&bar[XB_TOPGEN], 1u);
            else XB_SPIN(xb_ld(&bar[XB_TOPGEN]) == tg, bar);
            __builtin_amdgcn_fence(__ATOMIC_ACQUIRE, "agent");
            xb_add(&bar[XB_XGEN(b.x)], 1u);
            asm volatile("s_waitcnt vmcnt(0)" ::: "memory");
        } else {
            XB_SPIN(xb_ld(&bar[XB_XGEN(b.x)]) == gen, bar);
            __builtin_amdgcn_fence(__ATOMIC_ACQUIRE, "agent");
            asm volatile("s_waitcnt vmcnt(0)" ::: "memory");
        }
    }
    __syncthreads();
}

namespace pg8 {
constexpr int BM = 256, BK = 64, HALF = 128, HTB = HALF * BK * 2, STAGE_BYTES = 8 * HTB;
__device__ __forceinline__ int lds_byte(int r, int c) { const int st = (r >> 4) * 2 + (c >> 5), rr = r & 15, cc = c & 31, ob = rr * 64 + cc * 2; return st * 1024 + (ob ^ (((ob >> 9) & 1) << 5)); }
__device__ __forceinline__ void stage_rc(int b, int& R, int& C) { const int st = b / 1024, sb = b % 1024, swz = sb ^ (((sb >> 9) & 1) << 5); R = (st >> 1) * 16 + swz / 64; C = (st & 1) * 32 + (swz % 64) / 2; }
__device__ __forceinline__ int perm32(int rho) { const int n = rho >> 4, i = rho & 15; return 8 * (i >> 2) + 4 * n + (i & 3); }
struct Unit { int pm, pn; };

struct DenseOrder {
    int nM, nN, nwg, G, c;
    __device__ void init(int M, int N, int G_, int c_) { nM = M / BM; nN = N / BM; nwg = nM * nN; G = G_; c = c_; }
    __device__ bool next(int i, Unit& u) const {
        const long L = (long)i * G + c; if (L >= nwg) return false;
        int wgid = (int)L; { const int q = nwg / 8, r = nwg % 8, xcd = wgid % 8, off = wgid / 8; wgid = (xcd < r ? xcd * (q + 1) : r * (q + 1) + (xcd - r) * q) + off; }
        const int nig = 8 * nN, gid = wgid / nig, fm = gid * 8, gsz = (nM - fm) < 8 ? (nM - fm) : 8;
        u.pm = fm + ((wgid % nig) % gsz); u.pn = (wgid % nig) / gsz; return true;
    }
};
struct PlainMap {
    __device__ __forceinline__ unsigned arow(int pm, int r) const { return (unsigned)(pm * BM + r); }
    __device__ __forceinline__ size_t brow0(const Unit& u) const { return (size_t)u.pn * BM; }
};
struct MoeMap {
    const int* rowtok; const int* blkexp; int nexp_rows;
    __device__ __forceinline__ unsigned arow(int pm, int r) const { if (!rowtok) return (unsigned)(pm * BM + r); const int t = rowtok[pm * BM + r]; return (unsigned)(t < 0 ? 0 : t); }
    __device__ __forceinline__ size_t brow0(const Unit& u) const { return (size_t)blkexp[u.pm] * nexp_rows + (size_t)u.pn * BM; }
};

template <class Epi, class Sched, class Map>
__device__ __forceinline__ void gemm_phase(LAS unsigned char* lds, const bf16_t* A, int lda, const bf16_t* Bt, int K, const Sched& S, const Map& MP, const Epi& E) {
    int tid_ = threadIdx.x; asm volatile("" : "+v"(tid_));
    const int tid = tid_, wid = __builtin_amdgcn_readfirstlane(tid >> 6), lane = tid & 63, wr = wid >> 2, wc = wid & 3, fr = lane & 15, fq = lane >> 4;
    const int nt = K / BK;
    unsigned voffB[2];
#pragma unroll
    for (int i = 0; i < 2; ++i) { int R, C; stage_rc(tid * 16 + i * 8192, R, C); const int Rb = Epi::PERM ? ((R & ~31) + perm32(R & 31)) : R; voffB[i] = (unsigned)(Rb * K + C) * 2u; }
    const size_t kstep = (size_t)(BK * 2);
    const size_t hstepB = (size_t)HALF * K * 2;
    const unsigned ldsw = (unsigned)wid * 1024u;
    const int aoff = lds_byte(wr * 64 + fr, fq * 8), boff = lds_byte(wc * 32 + fr, fq * 8);
#define PG8_SA(b, h) (((b) * 2 + (h)) * HTB)
#define PG8_SB(b, h) ((4 + (b) * 2 + (h)) * HTB)
#define PG8_STAGE(bufoff, gbase, voff) do { _Pragma("unroll") for (int _i = 0; _i < 2; ++_i) \
        __builtin_amdgcn_global_load_lds((const unsigned*)((const char*)(gbase) + (voff)[_i]), (LAS unsigned*)(lds + (bufoff) + ldsw + _i * 8192), 16, 0, 0); } while (0)
#define PG8_LDA(dst, b, h) do { _Pragma("unroll") for (int m = 0; m < 4; ++m) _Pragma("unroll") for (int k = 0; k < 2; ++k) dst[m][k] = *(const LAS bf16x8*)(lds + PG8_SA(b, h) + aoff + m * 2048 + k * 1024); } while (0)
#define PG8_LDB(dst, b, h) do { _Pragma("unroll") for (int n = 0; n < 2; ++n) _Pragma("unroll") for (int k = 0; k < 2; ++k) dst[n][k] = *(const LAS bf16x8*)(lds + PG8_SB(b, h) + boff + n * 2048 + k * 1024); } while (0)
#define PG8_MMA(ai, bj, At, Bt_) do { __builtin_amdgcn_s_setprio(1); _Pragma("unroll") for (int m = 0; m < 4; ++m) _Pragma("unroll") for (int n = 0; n < 2; ++n) _Pragma("unroll") for (int k = 0; k < 2; ++k) \
        acc[ai][bj][m][n] = __builtin_amdgcn_mfma_f32_16x16x32_bf16(Bt_[n][k], At[m][k], acc[ai][bj][m][n], 0, 0, 0); __builtin_amdgcn_s_setprio(0); } while (0)
#define PG8_WAIT_V(n) asm volatile("s_waitcnt vmcnt(" #n ")" ::: "memory")
#define PG8_WAIT_L(n) asm volatile("s_waitcnt lgkmcnt(" #n ")" ::: "memory")
#define PG8_BAR __builtin_amdgcn_s_barrier()
#define PG8_SCHED __builtin_amdgcn_sched_barrier(0)
#define PG8_VOFFA(dst, u_) do { _Pragma("unroll") for (int _i = 0; _i < 2; ++_i) { int _R, _C; stage_rc(tid * 16 + _i * 8192, _R, _C); _Pragma("unroll") for (int _h = 0; _h < 2; ++_h) \
        dst[_h][_i] = (MP.arow((u_).pm, _h * HALF + _R) * (unsigned)lda + (unsigned)_C) * 2u; } } while (0)
#define PG8_STAGE2(bufoff, gbase, va, vb, sel) do { _Pragma("unroll") for (int _i = 0; _i < 2; ++_i) \
        __builtin_amdgcn_global_load_lds((const unsigned*)((const char*)(gbase) + ((sel) ? (vb)[_i] : (va)[_i])), (LAS unsigned*)(lds + (bufoff) + ldsw + _i * 8192), 16, 0, 0); } while (0)
    Unit cur, nxt; int ui = 0;
    if (!S.next(0, cur)) return;
    f32x4 acc[2][2][4][2];
#pragma unroll
    for (int a = 0; a < 2; ++a)
#pragma unroll
        for (int b = 0; b < 2; ++b)
#pragma unroll
            for (int m = 0; m < 4; ++m)
#pragma unroll
                for (int n = 0; n < 2; ++n) acc[a][b][m][n] = (f32x4){0.f, 0.f, 0.f, 0.f};
    bf16x8 At[4][2], B0[2][2], B1[2][2];
    unsigned vc[2][2], vn[2][2];
    PG8_VOFFA(vc, cur);
    const char* cA = (const char*)A; const char* cB = (const char*)Bt + MP.brow0(cur) * (size_t)K * 2;
    PG8_STAGE(PG8_SB(0, 0), cB, voffB); PG8_STAGE(PG8_SB(0, 1), cB + hstepB, voffB); PG8_STAGE(PG8_SA(0, 0), cA, vc[0]); PG8_STAGE(PG8_SA(0, 1), cA, vc[1]);
    if (wr == 1) PG8_BAR;
    PG8_WAIT_V(2); PG8_BAR;
    PG8_STAGE(PG8_SB(1, 0), cB + kstep, voffB); PG8_STAGE(PG8_SA(1, 0), cA + kstep, vc[0]); PG8_STAGE(PG8_SB(1, 1), cB + hstepB + kstep, voffB);
    PG8_WAIT_V(6); PG8_BAR;
    for (;;) {
        const bool has_next = S.next(ui + 1, nxt);
        const char* nB = cB;
        if (has_next) { PG8_VOFFA(vn, nxt); nB = (const char*)Bt + MP.brow0(nxt) * (size_t)K * 2; }
        else {
#pragma unroll
            for (int h = 0; h < 2; ++h)
#pragma unroll
                for (int i = 0; i < 2; ++i) vn[h][i] = vc[h][i];
        }
        for (int t = 0; t < nt; t += 2) {
            const bool last = (t == nt - 2);
            const char* a1 = cA + (size_t)(t + 1) * kstep;
            const char* a2 = last ? cA : cA + (size_t)(t + 2) * kstep; const char* b2 = last ? nB : cB + (size_t)(t + 2) * kstep;
            const char* a3 = a2 + kstep; const char* b3 = b2 + kstep;
            PG8_LDB(B0, 0, 0); PG8_LDB(B1, 0, 1); PG8_SCHED; PG8_LDA(At, 0, 0); PG8_STAGE(PG8_SA(1, 1), a1, vc[1]);
            PG8_WAIT_V(8); PG8_WAIT_L(0); PG8_BAR; PG8_MMA(0, 0, At, B0); PG8_MMA(0, 1, At, B1); PG8_BAR; PG8_SCHED;
            PG8_LDA(At, 0, 1); PG8_STAGE(PG8_SB(0, 0), b2, voffB); PG8_STAGE(PG8_SB(0, 1), b2 + hstepB, voffB); PG8_STAGE2(PG8_SA(0, 0), a2, vc[0], vn[0], last);
            PG8_WAIT_V(8); PG8_WAIT_L(0); PG8_BAR; PG8_MMA(1, 0, At, B0); PG8_MMA(1, 1, At, B1); PG8_BAR; PG8_SCHED;
            PG8_LDB(B0, 1, 0); PG8_LDB(B1, 1, 1); PG8_SCHED; PG8_LDA(At, 1, 0); PG8_STAGE2(PG8_SA(0, 1), a2, vc[1], vn[1], last);
            PG8_WAIT_V(8); PG8_WAIT_L(0); PG8_BAR; PG8_MMA(0, 0, At, B0); PG8_MMA(0, 1, At, B1); PG8_BAR; PG8_SCHED;
            PG8_LDA(At, 1, 1); PG8_STAGE(PG8_SB(1, 0), b3, voffB); PG8_STAGE(PG8_SB(1, 1), b3 + hstepB, voffB); PG8_STAGE2(PG8_SA(1, 0), a3, vc[0], vn[0], last);
            PG8_WAIT_V(8); PG8_WAIT_L(0); PG8_BAR; PG8_MMA(1, 0, At, B0); PG8_MMA(1, 1, At, B1); PG8_BAR; PG8_SCHED;
        }
        if (wr == 0) PG8_BAR;
        E(acc, cur, wr, wc, fr, fq);
        if (!has_next) break;
#pragma unroll
        for (int a = 0; a < 2; ++a)
#pragma unroll
            for (int b = 0; b < 2; ++b)
#pragma unroll
                for (int m = 0; m < 4; ++m)
#pragma unroll
                    for (int n = 0; n < 2; ++n) acc[a][b][m][n] = (f32x4){0.f, 0.f, 0.f, 0.f};
        cur = nxt; cB = nB; ++ui;
#pragma unroll
        for (int h = 0; h < 2; ++h)
#pragma unroll
            for (int i = 0; i < 2; ++i) vc[h][i] = vn[h][i];
        if (wr == 1) PG8_BAR;
    }
    PG8_WAIT_V(0);
    PG8_BAR;
#undef PG8_SA
#undef PG8_SB
#undef PG8_STAGE
#undef PG8_LDA
#undef PG8_LDB
#undef PG8_MMA
#undef PG8_WAIT_V
#undef PG8_WAIT_L
#undef PG8_BAR
#undef PG8_SCHED
#undef PG8_VOFFA
#undef PG8_STAGE2
}

struct EpiBf16 {
    static constexpr bool PERM = true;
    bf16_t* O; int ldc;
    __device__ __forceinline__ void operator()(const f32x4 (&acc)[2][2][4][2], const Unit& u, int wr, int wc, int fr, int fq) const {
        const int row0 = u.pm * BM + wr * 64 + fr, col0 = u.pn * BM + wc * 32 + 8 * fq;
#pragma unroll
        for (int ai = 0; ai < 2; ++ai)
#pragma unroll
            for (int m = 0; m < 4; ++m) { bf16_t* rowp = O + (size_t)(row0 + ai * HALF + m * 16) * ldc + col0;
#pragma unroll
                for (int bj = 0; bj < 2; ++bj) { const f32x4 v0 = acc[ai][bj][m][0], v1 = acc[ai][bj][m][1];
                    u32x4 w; w.x = cvt_pk_bf16(v0[0], v0[1]); w.y = cvt_pk_bf16(v0[2], v0[3]); w.z = cvt_pk_bf16(v1[0], v1[1]); w.w = cvt_pk_bf16(v1[2], v1[3]);
                    *(u32x4*)(rowp + bj * HALF) = w; } }
    }
};
struct EpiSwiGLU {
    static constexpr bool PERM = true;
    bf16_t* H; int ldh;
    __device__ __forceinline__ void operator()(const f32x4 (&acc)[2][2][4][2], const Unit& u, int wr, int wc, int fr, int fq) const {
        const int row0 = u.pm * BM + wr * 64 + fr, col0 = u.pn * HALF + wc * 32 + 8 * fq;
#pragma unroll
        for (int ai = 0; ai < 2; ++ai)
#pragma unroll
            for (int m = 0; m < 4; ++m) { bf16_t* rowp = H + (size_t)(row0 + ai * HALF + m * 16) * ldh + col0;
                f32x4 h0, h1;
#pragma unroll
                for (int j = 0; j < 4; ++j) { const float g0 = acc[ai][0][m][0][j], g1 = acc[ai][0][m][1][j];
                    h0[j] = g0 * __builtin_amdgcn_rcpf(1.f + __expf(-g0)) * acc[ai][1][m][0][j]; h1[j] = g1 * __builtin_amdgcn_rcpf(1.f + __expf(-g1)) * acc[ai][1][m][1][j]; }
                u32x4 w; w.x = cvt_pk_bf16(h0[0], h0[1]); w.y = cvt_pk_bf16(h0[2], h0[3]); w.z = cvt_pk_bf16(h1[0], h1[1]); w.w = cvt_pk_bf16(h1[2], h1[3]);
                *(u32x4*)rowp = w; }
    }
};
struct EpiResF32 {
    static constexpr bool PERM = false;
    const float* base; float* out; int ldc;
    __device__ __forceinline__ void operator()(const f32x4 (&acc)[2][2][4][2], const Unit& u, int wr, int wc, int fr, int fq) const {
        const int row0 = u.pm * BM + wr * 64 + fr, col0 = u.pn * BM + wc * 32 + 4 * fq;
#pragma unroll
        for (int ai = 0; ai < 2; ++ai)
#pragma unroll
            for (int m = 0; m < 4; ++m) { const size_t off = (size_t)(row0 + ai * HALF + m * 16) * ldc + col0;
#pragma unroll
                for (int bj = 0; bj < 2; ++bj)
#pragma unroll
                    for (int n = 0; n < 2; ++n) { const f32x4 bs = *(const f32x4*)(base + off + bj * HALF + n * 16); *(f32x4*)(out + off + bj * HALF + n * 16) = bs + acc[ai][bj][m][n]; } }
    }
};
struct EpiMoeDown {
    static constexpr bool PERM = false;
    float* out; const int* rowtok; const float* rowgate;
    __device__ __forceinline__ void operator()(const f32x4 (&acc)[2][2][4][2], const Unit& u, int wr, int wc, int fr, int fq) const {
        const int row0 = u.pm * BM + wr * 64 + fr, col0 = u.pn * BM + wc * 32 + 4 * fq;
#pragma unroll
        for (int ai = 0; ai < 2; ++ai)
#pragma unroll
            for (int m = 0; m < 4; ++m) { const int r = row0 + ai * HALF + m * 16; const int tok = rowtok[r]; const float g = rowgate[r];
                if (tok >= 0) { float* op = out + (size_t)tok * D + col0;
#pragma unroll
                    for (int bj = 0; bj < 2; ++bj)
#pragma unroll
                        for (int n = 0; n < 2; ++n) { const f32x4 bs = *(const f32x4*)(op + bj * HALF + n * 16); *(f32x4*)(op + bj * HALF + n * 16) = bs + g * acc[ai][bj][m][n]; } } }
    }
};
}

struct MoeOrder {
    int nwg, nN, G, c;
    __device__ void init(int nblk, int nN_, int G_, int c_) { nN = nN_; nwg = nblk * nN_; G = G_; c = c_; }
    __device__ bool next(int i, pg8::Unit& u) const { const long L = (long)i * G + c; if (L >= nwg) return false; u.pm = (int)(L / nN); u.pn = (int)(L % nN); return true; }
};

struct Frame {
    LAS unsigned char* lds;
    gu32* ctl;
    int tid, lane, wave, G, gw, NGW;
    unsigned char* ws;
    float* out;
};
__device__ __forceinline__ const float* inptr(int i) {
    unsigned off = (unsigned)i * 8u; asm volatile("" : "+s"(off));
    return *(const float* const*)((const char*)__builtin_amdgcn_kernarg_segment_ptr() + off);
}
enum { I_X = 0, I_MN0, I_WIN0, I_WGATEUP, I_BGATE, I_GLANORM, I_QNORM, I_KNORM, I_WOUT0, I_FN0, I_WFG, I_WFU, I_WFD, I_MN1, I_WIN1, I_RETGN, I_WOUT1, I_FN1, I_WROUTER, I_WEG, I_WEU, I_WED };

__device__ __forceinline__ void transpose_item(const float* W, int ldw, int src_col0, bf16_t* WT, int ldt, int dst_row0, int k0, LAS float* scr, int lane) {
#pragma unroll 8
    for (int i = 0; i < 32; ++i) { const int kk = 2 * i + (lane >> 5); scr[kk * 33 + (lane & 31)] = W[(size_t)(k0 + kk) * ldw + src_col0 + (lane & 31)]; }
    LDS_WAIT(); asm volatile("" ::: "memory");
    const int c = lane & 7;
#pragma unroll
    for (int j = 0; j < 4; ++j) { const int n = (lane >> 3) + 8 * j; const LAS float* s = scr + (8 * c) * 33 + n;
        u32x4 o; o.x = pk2(s[0 * 33], s[1 * 33]); o.y = pk2(s[2 * 33], s[3 * 33]); o.z = pk2(s[4 * 33], s[5 * 33]); o.w = pk2(s[6 * 33], s[7 * 33]);
        *(u32x4*)(WT + (size_t)(dst_row0 + n) * ldt + k0 + 8 * c) = o; }
    LDS_WAIT(); asm volatile("" ::: "memory");
}
__device__ __forceinline__ void transpose_plain(const float* W, int K, int N, bf16_t* WT, int it, LAS float* scr, int lane) {
    const int nblk = N / 32, kb = it / nblk, nb = it % nblk; transpose_item(W, N, 32 * nb, WT, K, 32 * nb, 64 * kb, scr, lane);
}
__device__ __forceinline__ void transpose_gateup(const float* Wg, const float* Wu, int K, int F, bf16_t* WT, int it, LAS float* scr, int lane) {
    const int nblk = 2 * F / 32, kb = it / nblk, nb = it % nblk, dr = 32 * nb, tile = dr >> 8, within = dr & 255;
    const float* W = within < 128 ? Wg : Wu; const int sc = tile * 128 + (within & 127);
    transpose_item(W, F, sc, WT, K, dr, 64 * kb, scr, lane);
}

__device__ __forceinline__ void rmsnorm_row(const float* xrow, const float* w, bf16_t* orow, int lane, f32x4 (&v)[4]) {
    const f32x4* xr = (const f32x4*)xrow + lane; float s = 0.f;
#pragma unroll
    for (int j = 0; j < 4; ++j) { v[j] = xr[64 * j]; s += (v[j].x * v[j].x + v[j].y * v[j].y) + (v[j].z * v[j].z + v[j].w * v[j].w); }
    const float r = 1.f / sqrtf(wave_sum(s) * (1.f / D) + NORM_EPS);
    const f32x4* wr = (const f32x4*)w + lane;
    unsigned long long* o8 = (unsigned long long*)orow + lane;
#pragma unroll
    for (int j = 0; j < 4; ++j) { const f32x4 ww = wr[64 * j]; v[j] = v[j] * r * ww; o8[64 * j] = (unsigned long long)pk2(v[j].x, v[j].y) | ((unsigned long long)pk2(v[j].z, v[j].w) << 32); }
}


__device__ __forceinline__ void unpack8(const u32x4 raw, float (&x)[8]) {
    x[0] = __uint_as_float(raw.x << 16); x[1] = __uint_as_float(raw.x & 0xffff0000u); x[2] = __uint_as_float(raw.y << 16); x[3] = __uint_as_float(raw.y & 0xffff0000u);
    x[4] = __uint_as_float(raw.z << 16); x[5] = __uint_as_float(raw.z & 0xffff0000u); x[6] = __uint_as_float(raw.w << 16); x[7] = __uint_as_float(raw.w & 0xffff0000u);
}
typedef short s16x4 __attribute__((ext_vector_type(4)));
__device__ __forceinline__ void dilated_phase(const Frame& F, const bf16_t* HC0, bf16_t* op01, bf16_t* op2, float* lse) {
    constexpr int SLOT = 128 * 144;
    constexpr float LOG2E = 1.4426950408889634f, LN2 = 0.6931471805599453f;
    LAS unsigned char* Ks = F.lds; LAS unsigned char* Vs = F.lds + 3 * SLOT;
    for (int i = F.tid; i < 6 * SLOT / 16; i += NTHREADS) ((LAS u32x4*)F.lds)[i] = (u32x4){0u, 0u, 0u, 0u};
    int tid_ = threadIdx.x; asm volatile("" : "+v"(tid_));
    const int lane = tid_ & 63, fr = lane & 15, fq = lane >> 4, w = __builtin_amdgcn_readfirstlane(tid_ >> 6);
    const int srow0 = tid_ >> 3, sc = tid_ & 7;
    float knw[8], qnw[16];
    { const float* kn = inptr(I_KNORM); const float* qn = inptr(I_QNORM);
#pragma unroll
      for (int e = 0; e < 8; ++e) { knw[e] = kn[8 * sc + e]; qnw[e] = qn[8 * fq + e] * (0.125f * LOG2E); qnw[8 + e] = qn[32 + 8 * fq + e] * (0.125f * LOG2E); } }
    const unsigned vlane = (unsigned)((4 * fq + ((lane & 15) >> 2)) * 144 + (lane & 3) * 8);
    __syncthreads();
    for (int item = blockIdx.x; item < 1536; item += F.G) {
        const int p = item >> 9, within = item & 511, dsh = 2 * p, d = 1 << dsh;
        const int strip = within >> (4 - dsh), grp = within & ((16 >> dsh) - 1), r = strip & (d - 1), bh = strip >> dsh, h = bh & 7, b = bh >> 3, n0 = 4 * grp;
        const float cb = exp2f(-(float)(h + 1)) * LOG2E * (float)d;
        bf16_t* op = p < 2 ? op01 + (size_t)p * T * 512 : op2;
        const bf16_t* base = HC0 + (size_t)b * SEQ * LD0 + h * 64;
        u32x4 kreg[2], vreg[2];
#define DIL_LOAD(m) do { _Pragma("unroll") for (int rep = 0; rep < 2; ++rep) { const size_t pos = (size_t)((128 * (m) + srow0 + 64 * rep) * d + r); \
            kreg[rep] = *(const u32x4*)(base + pos * LD0 + C0_KB + 8 * sc); vreg[rep] = *(const u32x4*)(base + pos * LD0 + C0_VB + 8 * sc); } } while (0)
#define DIL_STORE(slot) do { _Pragma("unroll") for (int rep = 0; rep < 2; ++rep) { float x[8]; unpack8(kreg[rep], x); float ss = 0.f; \
            _Pragma("unroll") for (int e = 0; e < 8; ++e) ss += x[e] * x[e]; \
            ss += __shfl_xor(ss, 1); ss += __shfl_xor(ss, 2); ss += __shfl_xor(ss, 4); const float rs = 1.f / sqrtf(ss * (1.f / 64.f) + NORM_EPS); \
            const unsigned ro = (unsigned)((slot) * SLOT + (srow0 + 64 * rep) * 144 + sc * 16); \
            *(LAS u32x4*)(Ks + ro) = (u32x4){cvt_pk_bf16(x[0] * rs * knw[0], x[1] * rs * knw[1]), cvt_pk_bf16(x[2] * rs * knw[2], x[3] * rs * knw[3]), cvt_pk_bf16(x[4] * rs * knw[4], x[5] * rs * knw[5]), cvt_pk_bf16(x[6] * rs * knw[6], x[7] * rs * knw[7])}; \
            *(LAS u32x4*)(Vs + ro) = vreg[rep]; } } while (0)
        if (n0 > 0) { DIL_LOAD(n0 - 1); DIL_STORE((n0 + 2) % 3); }
        DIL_LOAD(n0); DIL_STORE(n0 % 3);
        __syncthreads();
#pragma unroll 1
        for (int n = n0; n < n0 + 4; ++n) {
            const int prev = (n + 2) % 3, cur = n % 3, nxt = (n + 1) % 3;
            const bool more = (n + 1 < n0 + 4);
            if (more) DIL_LOAD(n + 1);
            const size_t tokq = (size_t)b * SEQ + (size_t)((128 * n + 16 * w + fr) * d + r);
            bf16x8 qf0, qf1;
            { const bf16_t* qp = HC0 + tokq * LD0 + C0_QB + h * 64; float x0[8], x1[8]; unpack8(*(const u32x4*)(qp + 8 * fq), x0); unpack8(*(const u32x4*)(qp + 32 + 8 * fq), x1);
              float ss = 0.f;
#pragma unroll
              for (int e = 0; e < 8; ++e) ss += x0[e] * x0[e] + x1[e] * x1[e];
              ss += __shfl_xor(ss, 16); ss += __shfl_xor(ss, 32);
              const float rs = 1.f / sqrtf(ss * (1.f / 64.f) + NORM_EPS);
              const u32x4 a0 = (u32x4){cvt_pk_bf16(x0[0] * rs * qnw[0], x0[1] * rs * qnw[1]), cvt_pk_bf16(x0[2] * rs * qnw[2], x0[3] * rs * qnw[3]), cvt_pk_bf16(x0[4] * rs * qnw[4], x0[5] * rs * qnw[5]), cvt_pk_bf16(x0[6] * rs * qnw[6], x0[7] * rs * qnw[7])};
              const u32x4 a1 = (u32x4){cvt_pk_bf16(x1[0] * rs * qnw[8], x1[1] * rs * qnw[9]), cvt_pk_bf16(x1[2] * rs * qnw[10], x1[3] * rs * qnw[11]), cvt_pk_bf16(x1[4] * rs * qnw[12], x1[5] * rs * qnw[13]), cvt_pk_bf16(x1[6] * rs * qnw[14], x1[7] * rs * qnw[15])};
              qf0 = __builtin_bit_cast(bf16x8, a0); qf1 = __builtin_bit_cast(bf16x8, a1); }
            f32x4 sacc[9];
#pragma unroll
            for (int i = 0; i < 9; ++i) { const int kt = w + i; const unsigned ko = (unsigned)((kt < 8 ? prev : cur) * SLOT + ((kt & 7) * 16 + fr) * 144 + fq * 16);
                const bf16x8 k0 = *(const LAS bf16x8*)(Ks + ko), k1 = *(const LAS bf16x8*)(Ks + ko + 64);
                f32x4 z = (f32x4){0.f, 0.f, 0.f, 0.f};
                z = __builtin_amdgcn_mfma_f32_16x16x32_bf16(k0, qf0, z, 0, 0, 0); sacc[i] = __builtin_amdgcn_mfma_f32_16x16x32_bf16(k1, qf1, z, 0, 0, 0); }
            float mx = -1e30f; const int lpart = fr - 4 * fq;
#pragma unroll
            for (int i = 0; i < 9; ++i) { const bool tile_ok = (w + i >= 8) || (n > 0);
#pragma unroll
                for (int j = 0; j < 4; ++j) { const int steps = 128 - 16 * i - j + lpart; float sv = sacc[i][j] - cb * (float)steps; bool ok = tile_ok;
                    if (i == 0) ok = ok && (steps <= 128); if (i == 8) ok = ok && (steps >= 0);
                    sv = ok ? sv : -1e30f; sacc[i][j] = sv; mx = fmaxf(mx, sv); } }
            mx = fmaxf(mx, __shfl_xor(mx, 16)); mx = fmaxf(mx, __shfl_xor(mx, 32));
            float l = 0.f;
#pragma unroll
            for (int i = 0; i < 9; ++i)
#pragma unroll
                for (int j = 0; j < 4; ++j) { const float pe = __builtin_amdgcn_exp2f(sacc[i][j] - mx); sacc[i][j] = pe; l += pe; }
            l += __shfl_xor(l, 16); l += __shfl_xor(l, 32);
            bf16x8 pf[5];
#pragma unroll
            for (int ks = 0; ks < 5; ++ks) { u32x4 t4; t4.x = cvt_pk_bf16(sacc[2 * ks][0], sacc[2 * ks][1]); t4.y = cvt_pk_bf16(sacc[2 * ks][2], sacc[2 * ks][3]);
                if (ks < 4) { t4.z = cvt_pk_bf16(sacc[2 * ks + 1][0], sacc[2 * ks + 1][1]); t4.w = cvt_pk_bf16(sacc[2 * ks + 1][2], sacc[2 * ks + 1][3]); } else { t4.z = 0u; t4.w = 0u; }
                pf[ks] = __builtin_bit_cast(bf16x8, t4); }
            f32x4 oacc[4];
#pragma unroll
            for (int dt = 0; dt < 4; ++dt) oacc[dt] = (f32x4){0.f, 0.f, 0.f, 0.f};
#pragma unroll
            for (int ks = 0; ks < 5; ++ks) { const int ta = w + 2 * ks, tb = ks < 4 ? ta + 1 : ta;
                const unsigned va = (unsigned)((ta < 8 ? prev : cur) * SLOT + (ta & 7) * 16 * 144) + vlane, vb = (unsigned)((tb < 8 ? prev : cur) * SLOT + (tb & 7) * 16 * 144) + vlane;
#pragma unroll
                for (int dt = 0; dt < 4; ++dt) { const s16x4 lo = __builtin_amdgcn_ds_read_tr16_b64_v4i16((LAS s16x4*)(Vs + va + dt * 32)), hi = __builtin_amdgcn_ds_read_tr16_b64_v4i16((LAS s16x4*)(Vs + vb + dt * 32));
                    const bf16x8 vf = (bf16x8){lo[0], lo[1], lo[2], lo[3], hi[0], hi[1], hi[2], hi[3]};
                    oacc[dt] = __builtin_amdgcn_mfma_f32_16x16x32_bf16(vf, pf[ks], oacc[dt], 0, 0, 0); } }
            const float il = 1.f / l;
            bf16_t* orow = op + tokq * 512 + h * 64 + 4 * fq;
#pragma unroll
            for (int dt = 0; dt < 4; ++dt) *(u32x2*)(orow + 16 * dt) = (u32x2){cvt_pk_bf16(oacc[dt][0] * il, oacc[dt][1] * il), cvt_pk_bf16(oacc[dt][2] * il, oacc[dt][3] * il)};
            if (fq == 0) lse[((size_t)p * T + tokq) * 8 + h] = (mx + __builtin_amdgcn_logf(l)) * LN2;
            if (more) DIL_STORE(nxt);
            __syncthreads();
        }
#undef DIL_LOAD
#undef DIL_STORE
    }
}

template <int C, int DK, int DVS, bool SPLIT, int LD, int CQ, int CV, int DVH, int NCH>
__device__ __forceinline__ void recur_phase(const Frame& F, bf16_t* HC, const bf16_t* att, const bf16_t* keT, const float* decay) {
    constexpr int KA = C / 32, KQ = DK / 32, MTV = DVS / 16;
    constexpr int SP = DK * 2 + 16, VP = DVS * 2;
    constexpr int VBUF = C * VP, SBUF = DVS * SP;
    constexpr int NVCH = C * DVS / 8;
    LAS unsigned char* vb = F.lds; LAS unsigned char* sb = F.lds + 2 * VBUF;
    int tid_ = threadIdx.x; asm volatile("" : "+v"(tid_));
    const int tid = tid_, lane = tid & 63, fr = lane & 15, fq = lane >> 4, w = __builtin_amdgcn_readfirstlane(tid >> 6);
    const bool is_o = SPLIT ? (w < 4) : true, is_s = SPLIT ? (w >= 4) : true;
    const int nto = SPLIT ? (w & 3) : w, mts0 = SPLIT ? 2 * (w & 3) : 2 * w;
    const unsigned trl = (unsigned)((8 * fq + ((lane & 15) >> 2)) * VP + (lane & 3) * 8);
    const int vrow = tid / (DVS / 8), vpart = tid % (DVS / 8);
    for (int item = blockIdx.x; item < 256; item += F.G) {
        const int sl = item & 15, h = (item >> 4) & 3, b = item >> 6;
        const float cdec = __expf((float)C * log1pf(-exp2f(-5.f - (float)h)));
        __syncthreads();
        for (int i = tid; i < SBUF / 16; i += NTHREADS) ((LAS u32x4*)sb)[i] = (u32x4){0u, 0u, 0u, 0u};
        f32x4 accS[2][MTV];
#pragma unroll
        for (int i = 0; i < 2; ++i)
#pragma unroll
            for (int j = 0; j < MTV; ++j) accS[i][j] = (f32x4){0.f, 0.f, 0.f, 0.f};
        bf16x8 ba[KA], bq[KQ], na[KA], nq[KQ], ke[2][KA]; f32x4 dc[2]; u32x4 vreg = (u32x4){0u, 0u, 0u, 0u};
        const size_t vcol = (size_t)CV + h * DVH + sl * DVS;
#define RC_LOAD_O(dsta, dstq, n_) do { const size_t unit_ = (size_t)(b * NCH + (n_)) * 4 + h; const size_t t_ = (size_t)b * SEQ + (size_t)(n_) * C + 16 * nto + fr; \
            const bf16_t* ap_ = att + unit_ * C * C + (size_t)(16 * nto + fr) * C + 8 * fq; const bf16_t* qp_ = HC + t_ * LD + CQ + h * DK + 8 * fq; \
            _Pragma("unroll") for (int ks = 0; ks < KA; ++ks) if (2 * ks <= nto) dsta[ks] = *(const bf16x8*)(ap_ + 32 * ks); \
            _Pragma("unroll") for (int kq = 0; kq < KQ; ++kq) dstq[kq] = *(const bf16x8*)(qp_ + 32 * kq); } while (0)
#define RC_LOAD_S(n_) do { const size_t unit_ = (size_t)(b * NCH + (n_)) * 4 + h; \
            _Pragma("unroll") for (int i = 0; i < 2; ++i) { const bf16_t* kp_ = keT + (unit_ * DK + 16 * (mts0 + i) + fr) * C + 8 * fq; \
                _Pragma("unroll") for (int ks = 0; ks < KA; ++ks) ke[i][ks] = *(const bf16x8*)(kp_ + 32 * ks); \
                if (decay) dc[i] = *(const f32x4*)(decay + unit_ * DK + 16 * (mts0 + i) + 4 * fq); } } while (0)
#define RC_LOAD_V(n_) do { if (tid < NVCH) vreg = *(const u32x4*)(HC + ((size_t)b * SEQ + (size_t)(n_) * C + vrow) * LD + vcol + vpart * 8); } while (0)
#define RC_STORE_V(buf_) do { if (tid < NVCH) *(LAS u32x4*)(vb + (buf_) * VBUF + vrow * VP + vpart * 16) = vreg; } while (0)
        if (is_o) RC_LOAD_O(ba, bq, 0);
        if (is_s) RC_LOAD_S(0);
        RC_LOAD_V(0); RC_STORE_V(0);
        __syncthreads();
#pragma unroll 1
        for (int n = 0; n < NCH; ++n) {
            const int cb = n & 1, nb = cb ^ 1; const bool more = n + 1 < NCH;
            if (more) { if (is_o) RC_LOAD_O(na, nq, n + 1); RC_LOAD_V(n + 1); }
            bf16x8 vT[MTV][KA];
#pragma unroll
            for (int mt = 0; mt < MTV; ++mt)
#pragma unroll
                for (int ks = 0; ks < KA; ++ks) { const LAS unsigned char* p0 = vb + cb * VBUF + trl + (32 * ks) * VP + mt * 32;
                    const s16x4 lo = __builtin_amdgcn_ds_read_tr16_b64_v4i16((LAS s16x4*)p0), hi = __builtin_amdgcn_ds_read_tr16_b64_v4i16((LAS s16x4*)(p0 + 4 * VP));
                    vT[mt][ks] = (bf16x8){lo[0], lo[1], lo[2], lo[3], hi[0], hi[1], hi[2], hi[3]}; }
            if (is_o) {
                f32x4 ao[MTV];
#pragma unroll
                for (int mt = 0; mt < MTV; ++mt) { ao[mt] = (f32x4){0.f, 0.f, 0.f, 0.f};
#pragma unroll
                    for (int ks = 0; ks < KA; ++ks) if (2 * ks <= nto) ao[mt] = __builtin_amdgcn_mfma_f32_16x16x32_bf16(vT[mt][ks], ba[ks], ao[mt], 0, 0, 0);
#pragma unroll
                    for (int kq = 0; kq < KQ; ++kq) { const bf16x8 sa = *(const LAS bf16x8*)(sb + cb * SBUF + (16 * mt + fr) * SP + (32 * kq + 8 * fq) * 2);
                        ao[mt] = __builtin_amdgcn_mfma_f32_16x16x32_bf16(sa, bq[kq], ao[mt], 0, 0, 0); } }
                bf16_t* op = HC + ((size_t)b * SEQ + (size_t)n * C + 16 * nto + fr) * LD + vcol + 4 * fq;
#pragma unroll
                for (int mt = 0; mt < MTV; ++mt) *(u32x2*)(op + 16 * mt) = (u32x2){cvt_pk_bf16(ao[mt][0], ao[mt][1]), cvt_pk_bf16(ao[mt][2], ao[mt][3])};
            }
            if (is_s) {
#pragma unroll
                for (int i = 0; i < 2; ++i)
#pragma unroll
                    for (int nt = 0; nt < MTV; ++nt) { f32x4 a = accS[i][nt];
                        if (decay) a = a * dc[i]; else a = a * cdec;
#pragma unroll
                        for (int ks = 0; ks < KA; ++ks) a = __builtin_amdgcn_mfma_f32_16x16x32_bf16(ke[i][ks], vT[nt][ks], a, 0, 0, 0);
                        accS[i][nt] = a;
                        *(LAS u32x2*)(sb + nb * SBUF + (16 * nt + fr) * SP + (16 * (mts0 + i) + 4 * fq) * 2) = (u32x2){cvt_pk_bf16(a[0], a[1]), cvt_pk_bf16(a[2], a[3])}; }
                if (more) RC_LOAD_S(n + 1);
            }
            if (more) RC_STORE_V(nb);
            __syncthreads();
            if (is_o) {
#pragma unroll
                for (int ks = 0; ks < KA; ++ks) ba[ks] = na[ks];
#pragma unroll
                for (int kq = 0; kq < KQ; ++kq) bq[kq] = nq[kq];
            }
        }
#undef RC_LOAD_O
#undef RC_LOAD_S
#undef RC_LOAD_V
#undef RC_STORE_V
    }
    __syncthreads();
}
struct Args { const float* in[22]; float* out; unsigned char* ws; int ph_lo, ph_hi; };
constexpr int NPHASE = 22;

#define PHASE_IDS int tid = threadIdx.x; asm volatile("" : "+v"(tid)); const int lane = tid & 63, wave = __builtin_amdgcn_readfirstlane(tid >> 6), gw = blockIdx.x * NWAVES + wave, gtid = blockIdx.x * NTHREADS + tid; (void)lane; (void)gw; (void)gtid
__global__ void __launch_bounds__(NTHREADS, 2) fwd_kernel(Args args) {
    extern __shared__ __attribute__((aligned(16))) unsigned char lds_raw[];
    Frame F;
    F.lds = (LAS unsigned char*)lds_raw;
    F.tid = threadIdx.x; F.lane = threadIdx.x & 63; F.wave = __builtin_amdgcn_readfirstlane(threadIdx.x >> 6);
    F.G = gridDim.x; F.gw = 0; F.NGW = F.G * NWAVES;
    F.ws = args.ws; F.ctl = (gu32*)(args.ws + WS_CTL); F.out = args.out;
    volatile LAS unsigned* MISC = (volatile LAS unsigned*)(F.lds + LDSCTL_OFF);
    if (threadIdx.x < 64) MISC[threadIdx.x] = 0u;
    __syncthreads();
    const int lo = args.ph_lo, hi = args.ph_hi;
    const bool use_bar = (hi - lo) > 1;
    XcdBarrier bar; bar.bar = (unsigned*)(F.ctl + CW_BAR); bar.x = 0; bar.st = nullptr;
    if (use_bar) bar = xcd_barrier_post((unsigned*)(F.ctl + CW_BAR), MISC + 8);
#ifndef PHMASK
#define PHMASK 0x3fffff
#endif
#define IN(k) (((PHMASK >> (k)) & 1) && lo <= (k) && (k) < hi)
#define SEAM(k) do { if (IN(k) && IN((k) + 1)) xcd_barrier(bar); } while (0)
    unsigned char* const big = F.ws + WS_BIG;
    bf16_t* const XN = (bf16_t*)(F.ws + WS_XN);
    bf16_t* const HC0 = (bf16_t*)(big + B_HCAT0);
    bf16_t* const HC1 = (bf16_t*)(big + B_HCAT1);
    const int NT = F.G * NTHREADS;

    if (IN(0)) { PHASE_IDS;
        LAS float* scr = (LAS float*)(F.lds + wave * 16384);
        constexpr int I0 = (D / 64) * (LD0 / 32), I1 = (MIX0 / 64) * (D / 32), I2 = (D / 64) * (2 * FF0 / 32), I3 = (FF0 / 64) * (D / 32), I4 = (D / 64) * (LD1 / 32), I5 = (MIX1 / 64) * (D / 32);
        constexpr int NIT = I0 + I1 + I2 + I3 + I4 + I5;
        for (int it = gw; it < NIT; it += F.NGW) {
            int r = it;
            if (r < I0) { const int nblk = LD0 / 32, kb = r / nblk, nb = r % nblk, dr = 32 * nb; transpose_item(inptr(I_WIN0), LDW0, dr < W0_LR ? dr : dr + 16, (bf16_t*)(F.ws + WS_WIN0), D, dr, 64 * kb, scr, lane); continue; } r -= I0;
            if (r < I1) { transpose_plain(inptr(I_WOUT0), MIX0, D, (bf16_t*)(F.ws + WS_WOUT0), r, scr, lane); continue; } r -= I1;
            if (r < I2) { transpose_gateup(inptr(I_WFG), inptr(I_WFU), D, FF0, (bf16_t*)(F.ws + WS_WGU0), r, scr, lane); continue; } r -= I2;
            if (r < I3) { transpose_plain(inptr(I_WFD), FF0, D, (bf16_t*)(F.ws + WS_WD0), r, scr, lane); continue; } r -= I3;
            if (r < I4) { transpose_plain(inptr(I_WIN1), D, LD1, (bf16_t*)(F.ws + WS_WIN1), r, scr, lane); continue; } r -= I4;
            transpose_plain(inptr(I_WOUT1), MIX1, D, (bf16_t*)(F.ws + WS_WOUT1), r, scr, lane);
        }
        float* lr = (float*)(F.ws + WS_LR);
        const float* wlr = inptr(I_WIN0) + W0_LR;
        for (int m = gw; m < T; m += F.NGW) {
            f32x4 v[4]; rmsnorm_row(inptr(I_X) + (size_t)m * D, inptr(I_MN0), XN + (size_t)m * D, lane, v);
            LAS float* rowb = scr;
            LAS float* red = scr + 1024;
#pragma unroll
            for (int j = 0; j < 4; ++j) *(LAS f32x4*)(rowb + 256 * j + 4 * lane) = v[j];
            float a[16];
#pragma unroll
            for (int r = 0; r < 16; ++r) a[r] = 0.f;
#pragma unroll 1
            for (int i = 0; i < 16; ++i) { const int c = 64 * i + lane; const float xv = rowb[c]; const f32x4* wp = (const f32x4*)(wlr + (size_t)c * LDW0);
#pragma unroll
                for (int q = 0; q < 4; ++q) { const f32x4 w4 = wp[q]; a[4 * q] += xv * w4.x; a[4 * q + 1] += xv * w4.y; a[4 * q + 2] += xv * w4.z; a[4 * q + 3] += xv * w4.w; } }
#pragma unroll
            for (int r = 0; r < 16; ++r) red[lane * 17 + r] = a[r];
            if (lane < 16) { float sum = 0.f;
#pragma unroll 8
                for (int l = 0; l < 64; ++l) sum += red[l * 17 + lane];
                lr[(size_t)m * 16 + lane] = sum; }
        }
    }
    SEAM(0);

    if (IN(1)) { PHASE_IDS;
        pg8::DenseOrder S; S.init(T, LD0, F.G, (int)blockIdx.x); pg8::PlainMap MP; pg8::EpiBf16 E{HC0, LD0};
        pg8::gemm_phase(F.lds, XN, D, (const bf16_t*)(F.ws + WS_WIN0), D, S, MP, E);
    }
    SEAM(1);

    if (IN(2)) { PHASE_IDS;
        {
            const float* lr = (const float*)(F.ws + WS_LR); const float* wgu = inptr(I_WGATEUP); const float* bg = inptr(I_BGATE);
            bf16_t* att = (bf16_t*)(big + B_ATT0); bf16_t* kendT = (bf16_t*)(big + B_KENDT); float* decay = (float*)(F.ws + WS_DECAY);
            LAS bf16_t* qd_s = (LAS bf16_t*)F.lds;
            LAS bf16_t* ki_s = qd_s + 64 * 136;
            LAS float* grp = (LAS float*)(ki_s + 64 * 136);
            const int dk = tid & 127, sg = tid >> 7;
            const int fr = lane & 15, fq = lane >> 4, w = wave;
            for (int unit = blockIdx.x; unit < 2048; unit += F.G) {
                const int h = unit & 3, bn = unit >> 2, t0 = bn * 64;
                const int col = h * 128 + dk;
                float w16[16];
#pragma unroll
                for (int r = 0; r < 16; ++r) w16[r] = wgu[r * 512 + col];
                const float bias = bg[col];
                float cum[16]; float run = 0.f;
#pragma unroll
                for (int i = 0; i < 16; ++i) { const int t = t0 + 16 * sg + i; const f32x4* lp = (const f32x4*)(lr + (size_t)t * 16); float z = bias;
#pragma unroll
                    for (int q = 0; q < 4; ++q) { const f32x4 l4 = lp[q]; z += l4.x * w16[4 * q] + l4.y * w16[4 * q + 1] + l4.z * w16[4 * q + 2] + l4.w * w16[4 * q + 3]; }
                    run += logsigmoid_f(z) * (1.f / 16.f); cum[i] = run; }
                __syncthreads();
                grp[sg * 128 + dk] = run;
                __syncthreads();
                float off = 0.f, total = 0.f;
#pragma unroll
                for (int g = 0; g < 4; ++g) { const float gs = grp[g * 128 + dk]; total += gs; off += (g < sg) ? gs : 0.f; }
                unsigned kep[8];
#pragma unroll
                for (int i = 0; i < 16; ++i) { const int s_ = 16 * sg + i, t = t0 + s_; const float c = off + cum[i];
                    bf16_t* qp = HC0 + (size_t)t * LD0 + C0_QA + col; const float q = bf2f(*qp), k = bf2f(HC0[(size_t)t * LD0 + C0_KA + col]);
                    const unsigned qdb = f2bf(q * __expf(c) * 0.08838834764831845f); *qp = (bf16_t)qdb; qd_s[s_ * 136 + dk] = (bf16_t)qdb;
                    ki_s[s_ * 136 + dk] = (bf16_t)f2bf(k * __expf(-c));
                    const unsigned keb = f2bf(k * __expf(total - c)); if (i & 1) kep[i >> 1] |= keb << 16; else kep[i >> 1] = keb; }
                { u32x4* kp = (u32x4*)(kendT + ((size_t)unit * 128 + dk) * 64 + 16 * sg); kp[0] = (u32x4){kep[0], kep[1], kep[2], kep[3]}; kp[1] = (u32x4){kep[4], kep[5], kep[6], kep[7]}; }
                if (sg == 0) decay[unit * 128 + dk] = __expf(total);
                __syncthreads();
                { const int nt = w & 3;
#pragma unroll
                  for (int i2 = 0; i2 < 2; ++i2) { const int mt = 2 * (w >> 2) + i2; f32x4 a = (f32x4){0.f, 0.f, 0.f, 0.f};
                      if (mt <= nt) {
#pragma unroll
                          for (int ks = 0; ks < 4; ++ks) { const bf16x8 ka = *(const LAS bf16x8*)(ki_s + (16 * mt + fr) * 136 + 32 * ks + 8 * fq), qb = *(const LAS bf16x8*)(qd_s + (16 * nt + fr) * 136 + 32 * ks + 8 * fq);
                              a = __builtin_amdgcn_mfma_f32_16x16x32_bf16(ka, qb, a, 0, 0, 0); }
#pragma unroll
                          for (int j = 0; j < 4; ++j) if (16 * mt + 4 * fq + j > 16 * nt + fr) a[j] = 0.f; }
                      *(u32x2*)(att + (size_t)unit * 4096 + (16 * nt + fr) * 64 + 16 * mt + 4 * fq) = (u32x2){cvt_pk_bf16(a[0], a[1]), cvt_pk_bf16(a[2], a[3])}; } }
            }
            __syncthreads();
        }
    }
    SEAM(2);

#if NAIVE_RECUR & 1
    if (IN(3)) { PHASE_IDS;
        const bf16_t* att = (const bf16_t*)(big + B_ATT0); const bf16_t* kendT = (const bf16_t*)(big + B_KENDT); const float* decay = (const float*)(F.ws + WS_DECAY);
        LAS float* att_s = (LAS float*)F.lds;
        LAS float* qd_s = att_s + 64 * 65;
        LAS float* ke_s = qd_s + 64 * 129;
        LAS float* v_s = ke_s + 128 * 65;
        LAS float* S_s = v_s + 64 * 16;
        LAS float* dc_s = S_s + 128 * 16;
        for (int item = blockIdx.x; item < 256; item += F.G) {
            const int sl = item & 15, h = (item >> 4) & 3, b = item >> 6;
            for (int i = tid; i < 128 * 16; i += NTHREADS) S_s[i] = 0.f;
            __syncthreads();
            for (int n = 0; n < 128; ++n) {
                const int unit = (b * 128 + n) * 4 + h, t0 = b * SEQ + n * 64;
                { const u32x4 raw = *(const u32x4*)(att + (size_t)unit * 4096 + tid * 8); const int s = tid >> 3, c0 = (tid & 7) * 8; LAS float* d = att_s + s * 65 + c0;
                  d[0] = __uint_as_float(raw.x << 16); d[1] = __uint_as_float(raw.x & 0xffff0000u); d[2] = __uint_as_float(raw.y << 16); d[3] = __uint_as_float(raw.y & 0xffff0000u);
                  d[4] = __uint_as_float(raw.z << 16); d[5] = __uint_as_float(raw.z & 0xffff0000u); d[6] = __uint_as_float(raw.w << 16); d[7] = __uint_as_float(raw.w & 0xffff0000u); }
#pragma unroll
                for (int rep = 0; rep < 2; ++rep) { const int ch = tid + 512 * rep;
                    { const int s = ch >> 4, c0 = (ch & 15) * 8; const u32x4 raw = *(const u32x4*)(HC0 + (size_t)(t0 + s) * LD0 + C0_QA + h * 128 + c0); LAS float* d = qd_s + s * 129 + c0;
                      d[0] = __uint_as_float(raw.x << 16); d[1] = __uint_as_float(raw.x & 0xffff0000u); d[2] = __uint_as_float(raw.y << 16); d[3] = __uint_as_float(raw.y & 0xffff0000u);
                      d[4] = __uint_as_float(raw.z << 16); d[5] = __uint_as_float(raw.z & 0xffff0000u); d[6] = __uint_as_float(raw.w << 16); d[7] = __uint_as_float(raw.w & 0xffff0000u); }
                    { const int dk = ch >> 3, c0 = (ch & 7) * 8; const u32x4 raw = *(const u32x4*)(kendT + ((size_t)unit * 128 + dk) * 64 + c0); LAS float* d = ke_s + dk * 65 + c0;
                      d[0] = __uint_as_float(raw.x << 16); d[1] = __uint_as_float(raw.x & 0xffff0000u); d[2] = __uint_as_float(raw.y << 16); d[3] = __uint_as_float(raw.y & 0xffff0000u);
                      d[4] = __uint_as_float(raw.z << 16); d[5] = __uint_as_float(raw.z & 0xffff0000u); d[6] = __uint_as_float(raw.w << 16); d[7] = __uint_as_float(raw.w & 0xffff0000u); } }
                if (tid < 128) { const int s = tid >> 1, c0 = (tid & 1) * 8; const u32x4 raw = *(const u32x4*)(HC0 + (size_t)(t0 + s) * LD0 + C0_VA + h * 256 + sl * 16 + c0); LAS float* d = v_s + s * 16 + c0;
                    d[0] = __uint_as_float(raw.x << 16); d[1] = __uint_as_float(raw.x & 0xffff0000u); d[2] = __uint_as_float(raw.y << 16); d[3] = __uint_as_float(raw.y & 0xffff0000u);
                    d[4] = __uint_as_float(raw.z << 16); d[5] = __uint_as_float(raw.z & 0xffff0000u); d[6] = __uint_as_float(raw.w << 16); d[7] = __uint_as_float(raw.w & 0xffff0000u); }
                else if (tid < 256) dc_s[tid - 128] = decay[unit * 128 + tid - 128];
                __syncthreads();
                { const int s = tid >> 3, dv = (tid & 7) * 2; float o0 = 0.f, o1 = 0.f;
                  for (int j = 0; j < 64; ++j) { const float a = att_s[s * 65 + j]; o0 += a * v_s[j * 16 + dv]; o1 += a * v_s[j * 16 + dv + 1]; }
                  for (int d = 0; d < 128; ++d) { const float q = qd_s[s * 129 + d]; o0 += q * S_s[d * 16 + dv]; o1 += q * S_s[d * 16 + dv + 1]; }
                  *(unsigned*)(HC0 + (size_t)(t0 + s) * LD0 + C0_VA + h * 256 + sl * 16 + dv) = pk2(o0, o1); }
                __syncthreads();
                { const int dk = tid >> 2, dv = (tid & 3) * 4; const float dc = dc_s[dk]; float a0 = S_s[dk * 16 + dv] * dc, a1 = S_s[dk * 16 + dv + 1] * dc, a2 = S_s[dk * 16 + dv + 2] * dc, a3 = S_s[dk * 16 + dv + 3] * dc;
                  for (int s = 0; s < 64; ++s) { const float k = ke_s[dk * 65 + s]; a0 += k * v_s[s * 16 + dv]; a1 += k * v_s[s * 16 + dv + 1]; a2 += k * v_s[s * 16 + dv + 2]; a3 += k * v_s[s * 16 + dv + 3]; }
                  S_s[dk * 16 + dv] = a0; S_s[dk * 16 + dv + 1] = a1; S_s[dk * 16 + dv + 2] = a2; S_s[dk * 16 + dv + 3] = a3; }
                __syncthreads();
            }
        }
    }
#else
    if (IN(3)) recur_phase<64, 128, 16, true, LD0, C0_QA, C0_VA, 256, 128>(F, HC0, (const bf16_t*)(big + B_ATT0), (const bf16_t*)(big + B_KENDT), (const float*)(F.ws + WS_DECAY));
#endif
    SEAM(3);

    if (IN(4)) dilated_phase(F, HC0, (bf16_t*)(F.ws + WS_XN), (bf16_t*)(big + B_OP2), (float*)(F.ws + WS_LSE));
    SEAM(4);

    if (IN(5)) { PHASE_IDS;
        const float* gn = inptr(I_GLANORM); const float* lse = (const float*)(F.ws + WS_LSE);
        float gw16[16];
#pragma unroll
        for (int e = 0; e < 16; ++e) gw16[e] = gn[(16 * lane + e) & 255];
        for (int t = gw; t < T; t += F.NGW) {
            bf16_t* row = HC0 + (size_t)t * LD0;
            { const u32x4* op = (const u32x4*)(row + C0_VA + 16 * lane); u32x4* rp = (u32x4*)(row + C0_RA + 16 * lane); float o[16], g[16];
#pragma unroll
              for (int c = 0; c < 2; ++c) { const u32x4 a = op[c], r4 = rp[c];
                  o[8 * c] = __uint_as_float(a.x << 16); o[8 * c + 1] = __uint_as_float(a.x & 0xffff0000u); o[8 * c + 2] = __uint_as_float(a.y << 16); o[8 * c + 3] = __uint_as_float(a.y & 0xffff0000u);
                  o[8 * c + 4] = __uint_as_float(a.z << 16); o[8 * c + 5] = __uint_as_float(a.z & 0xffff0000u); o[8 * c + 6] = __uint_as_float(a.w << 16); o[8 * c + 7] = __uint_as_float(a.w & 0xffff0000u);
                  g[8 * c] = __uint_as_float(r4.x << 16); g[8 * c + 1] = __uint_as_float(r4.x & 0xffff0000u); g[8 * c + 2] = __uint_as_float(r4.y << 16); g[8 * c + 3] = __uint_as_float(r4.y & 0xffff0000u);
                  g[8 * c + 4] = __uint_as_float(r4.z << 16); g[8 * c + 5] = __uint_as_float(r4.z & 0xffff0000u); g[8 * c + 6] = __uint_as_float(r4.w << 16); g[8 * c + 7] = __uint_as_float(r4.w & 0xffff0000u); }
              float ss = 0.f;
#pragma unroll
              for (int e = 0; e < 16; ++e) ss += o[e] * o[e];
              ss += __shfl_xor(ss, 1); ss += __shfl_xor(ss, 2); ss += __shfl_xor(ss, 4); ss += __shfl_xor(ss, 8);
              const float rs = 1.f / sqrtf(ss * (1.f / 256.f) + NORM_EPS);
#pragma unroll
              for (int e = 0; e < 16; ++e) o[e] = o[e] * rs * gw16[e] * silu_f(g[e]);
#pragma unroll
              for (int c = 0; c < 2; ++c) rp[c] = (u32x4){pk2(o[8 * c], o[8 * c + 1]), pk2(o[8 * c + 2], o[8 * c + 3]), pk2(o[8 * c + 4], o[8 * c + 5]), pk2(o[8 * c + 6], o[8 * c + 7])}; }
            { const int hh = lane >> 3; const float l0 = lse[((size_t)0 * T + t) * 8 + hh], l1 = lse[((size_t)1 * T + t) * 8 + hh], l2 = lse[((size_t)2 * T + t) * 8 + hh];
              const float mx = fmaxf(l0, fmaxf(l1, l2)); float w0 = __expf(l0 - mx), w1 = __expf(l1 - mx), w2 = __expf(l2 - mx); const float iw = 1.f / (w0 + w1 + w2); w0 *= iw; w1 *= iw; w2 *= iw;
              const u32x4 a = *(const u32x4*)((const bf16_t*)(F.ws + WS_XN) + (size_t)t * 512 + 8 * lane), bq = *(const u32x4*)((const bf16_t*)(F.ws + WS_XN) + (size_t)(T + t) * 512 + 8 * lane), c = *(const u32x4*)((const bf16_t*)(big + B_OP2) + (size_t)t * 512 + 8 * lane);
              float r[8];
              r[0] = w0 * __uint_as_float(a.x << 16) + w1 * __uint_as_float(bq.x << 16) + w2 * __uint_as_float(c.x << 16); r[1] = w0 * __uint_as_float(a.x & 0xffff0000u) + w1 * __uint_as_float(bq.x & 0xffff0000u) + w2 * __uint_as_float(c.x & 0xffff0000u);
              r[2] = w0 * __uint_as_float(a.y << 16) + w1 * __uint_as_float(bq.y << 16) + w2 * __uint_as_float(c.y << 16); r[3] = w0 * __uint_as_float(a.y & 0xffff0000u) + w1 * __uint_as_float(bq.y & 0xffff0000u) + w2 * __uint_as_float(c.y & 0xffff0000u);
              r[4] = w0 * __uint_as_float(a.z << 16) + w1 * __uint_as_float(bq.z << 16) + w2 * __uint_as_float(c.z << 16); r[5] = w0 * __uint_as_float(a.z & 0xffff0000u) + w1 * __uint_as_float(bq.z & 0xffff0000u) + w2 * __uint_as_float(c.z & 0xffff0000u);
              r[6] = w0 * __uint_as_float(a.w << 16) + w1 * __uint_as_float(bq.w << 16) + w2 * __uint_as_float(c.w << 16); r[7] = w0 * __uint_as_float(a.w & 0xffff0000u) + w1 * __uint_as_float(bq.w & 0xffff0000u) + w2 * __uint_as_float(c.w & 0xffff0000u);
              *(u32x4*)(row + C0_QB + 8 * lane) = (u32x4){pk2(r[0], r[1]), pk2(r[2], r[3]), pk2(r[4], r[5]), pk2(r[6], r[7])}; }
        }
    }
    SEAM(5);

    if (IN(6)) { PHASE_IDS;
        pg8::DenseOrder S; S.init(T, D, F.G, (int)blockIdx.x); pg8::PlainMap MP; pg8::EpiResF32 E{inptr(I_X), F.out, D};
        pg8::gemm_phase(F.lds, HC0 + C0_RA, LD0, (const bf16_t*)(F.ws + WS_WOUT0), MIX0, S, MP, E);
    }
    SEAM(6);

    if (IN(7)) { PHASE_IDS; for (int m = gw; m < T; m += F.NGW) { f32x4 v[4]; rmsnorm_row(F.out + (size_t)m * D, inptr(I_FN0), XN + (size_t)m * D, lane, v); } }
    SEAM(7);

    if (IN(8)) { PHASE_IDS;
        pg8::DenseOrder S; S.init(T, 2 * FF0, F.G, (int)blockIdx.x); pg8::PlainMap MP; pg8::EpiSwiGLU E{(bf16_t*)(big + B_H0), FF0};
        pg8::gemm_phase(F.lds, XN, D, (const bf16_t*)(F.ws + WS_WGU0), D, S, MP, E);
    }
    SEAM(8);

    if (IN(9)) { PHASE_IDS;
        pg8::DenseOrder S; S.init(T, D, F.G, (int)blockIdx.x); pg8::PlainMap MP; pg8::EpiResF32 E{F.out, F.out, D};
        pg8::gemm_phase(F.lds, (const bf16_t*)(big + B_H0), FF0, (const bf16_t*)(F.ws + WS_WD0), FF0, S, MP, E);
    }
    SEAM(9);

    if (IN(10)) { PHASE_IDS; for (int m = gw; m < T; m += F.NGW) { f32x4 v[4]; rmsnorm_row(F.out + (size_t)m * D, inptr(I_MN1), XN + (size_t)m * D, lane, v); } }
    SEAM(10);

    if (IN(11)) { PHASE_IDS;
        pg8::DenseOrder S; S.init(T, LD1, F.G, (int)blockIdx.x); pg8::PlainMap MP; pg8::EpiBf16 E{HC1, LD1};
        pg8::gemm_phase(F.lds, XN, D, (const bf16_t*)(F.ws + WS_WIN1), D, S, MP, E);
    }
    SEAM(11);

    if (IN(12)) { PHASE_IDS;
        bf16_t* att = (bf16_t*)(big + B_ATT1); bf16_t* kdT = (bf16_t*)(F.ws + WS_XN);
        LAS bf16_t* qd_s = (LAS bf16_t*)F.lds;
        LAS bf16_t* ki_s = qd_s + 128 * 264;
        const int dk = tid & 255, sg = tid >> 8;
        const int fr = lane & 15, fq = lane >> 4, w = wave;
        for (int unit = blockIdx.x; unit < 1024; unit += F.G) {
            const int h = unit & 3, bn = unit >> 2, t0 = bn * 128;
            const float lg = log1pf(-exp2f(-5.f - (float)h));
            __syncthreads();
#pragma unroll 1
            for (int i8 = 0; i8 < 8; ++i8) {
                unsigned kp[4];
#pragma unroll
                for (int i = 0; i < 8; ++i) { const int s_ = 64 * sg + 8 * i8 + i, t = t0 + s_;
                    bf16_t* qp = HC1 + (size_t)t * LD1 + C1_Q + h * 256 + dk; const float q = bf2f(*qp), k = bf2f(HC1[(size_t)t * LD1 + C1_K + h * 256 + dk]);
                    const unsigned qdb = f2bf(q * __expf(lg * (float)(s_ + 1))); *qp = (bf16_t)qdb; qd_s[s_ * 264 + dk] = (bf16_t)qdb;
                    ki_s[s_ * 264 + dk] = (bf16_t)f2bf(k * __expf(-lg * (float)(s_ + 1)));
                    const unsigned kdb = f2bf(k * __expf(lg * (float)(127 - s_)) * 0.0625f); if (i & 1) kp[i >> 1] |= kdb << 16; else kp[i >> 1] = kdb; }
                *(u32x4*)(kdT + ((size_t)unit * 256 + dk) * 128 + 64 * sg + 8 * i8) = (u32x4){kp[0], kp[1], kp[2], kp[3]};
            }
            __syncthreads();
#pragma unroll 1
            for (int L = w; L < 36; L += 8) { int nt = 0; while ((nt + 1) * (nt + 2) / 2 <= L) ++nt; const int mt = L - nt * (nt + 1) / 2;
                f32x4 a = (f32x4){0.f, 0.f, 0.f, 0.f};
#pragma unroll
                for (int ks = 0; ks < 8; ++ks) { const bf16x8 ka = *(const LAS bf16x8*)(ki_s + (16 * mt + fr) * 264 + 32 * ks + 8 * fq), qb = *(const LAS bf16x8*)(qd_s + (16 * nt + fr) * 264 + 32 * ks + 8 * fq);
                    a = __builtin_amdgcn_mfma_f32_16x16x32_bf16(ka, qb, a, 0, 0, 0); }
#pragma unroll
                for (int j = 0; j < 4; ++j) a[j] = (16 * mt + 4 * fq + j > 16 * nt + fr) ? 0.f : a[j] * 0.0625f;
                *(u32x2*)(att + (size_t)unit * 16384 + (16 * nt + fr) * 128 + 16 * mt + 4 * fq) = (u32x2){cvt_pk_bf16(a[0], a[1]), cvt_pk_bf16(a[2], a[3])}; }
            if (w < 4) *(u32x2*)(att + (size_t)unit * 16384 + (32 * w + fr) * 128 + 16 * (2 * w + 1) + 4 * fq) = (u32x2){0u, 0u};
        }
        __syncthreads();
    }
    SEAM(12);

#if NAIVE_RECUR & 2
    if (IN(13)) { PHASE_IDS;
        const bf16_t* att = (const bf16_t*)(big + B_ATT1); const bf16_t* kdT = (const bf16_t*)(F.ws + WS_XN);
        LAS float* v_s = (LAS float*)F.lds;
        LAS float* S_s = v_s + 128 * 32;
        for (int item = blockIdx.x; item < 256; item += F.G) {
            const int sl = item & 15, h = (item >> 4) & 3, b = item >> 6;
            const float cdec = __expf(128.f * log1pf(-exp2f(-5.f - (float)h)));
            for (int i = tid; i < 256 * 33; i += NTHREADS) S_s[i] = 0.f;
            __syncthreads();
            for (int n = 0; n < 64; ++n) {
                const int unit = (b * 64 + n) * 4 + h, t0 = b * SEQ + n * 128;
                { const int s = tid >> 2, c0 = (tid & 3) * 8; const u32x4 raw = *(const u32x4*)(HC1 + (size_t)(t0 + s) * LD1 + C1_V + h * 512 + sl * 32 + c0); LAS float* d = v_s + s * 32 + c0;
                  d[0] = __uint_as_float(raw.x << 16); d[1] = __uint_as_float(raw.x & 0xffff0000u); d[2] = __uint_as_float(raw.y << 16); d[3] = __uint_as_float(raw.y & 0xffff0000u);
                  d[4] = __uint_as_float(raw.z << 16); d[5] = __uint_as_float(raw.z & 0xffff0000u); d[6] = __uint_as_float(raw.w << 16); d[7] = __uint_as_float(raw.w & 0xffff0000u); }
                __syncthreads();
                { const int s = tid >> 2, dv0 = (tid & 3) * 8; float o[8];
#pragma unroll
                  for (int e = 0; e < 8; ++e) o[e] = 0.f;
                  const bf16_t* ap = att + (size_t)unit * 16384 + s * 128;
                  for (int j = 0; j <= s; ++j) { const float a = bf2f(ap[j]);
#pragma unroll
                      for (int e = 0; e < 8; ++e) o[e] += a * v_s[j * 32 + dv0 + e]; }
                  const bf16_t* qp = HC1 + (size_t)(t0 + s) * LD1 + C1_Q + h * 256;
                  for (int d = 0; d < 256; ++d) { const float q = bf2f(qp[d]);
#pragma unroll
                      for (int e = 0; e < 8; ++e) o[e] += q * S_s[d * 33 + dv0 + e]; }
                  *(u32x4*)(HC1 + (size_t)(t0 + s) * LD1 + C1_V + h * 512 + sl * 32 + dv0) = (u32x4){pk2(o[0], o[1]), pk2(o[2], o[3]), pk2(o[4], o[5]), pk2(o[6], o[7])}; }
                __syncthreads();
                { const int dk = tid >> 1, dv0 = (tid & 1) * 16; float a[16];
#pragma unroll
                  for (int e = 0; e < 16; ++e) a[e] = S_s[dk * 33 + dv0 + e] * cdec;
                  const bf16_t* kp = kdT + ((size_t)unit * 256 + dk) * 128;
                  for (int s = 0; s < 128; ++s) { const float k = bf2f(kp[s]);
#pragma unroll
                      for (int e = 0; e < 16; ++e) a[e] += k * v_s[s * 32 + dv0 + e]; }
#pragma unroll
                  for (int e = 0; e < 16; ++e) S_s[dk * 33 + dv0 + e] = a[e]; }
                __syncthreads();
            }
        }
    }
#else
    if (IN(13)) recur_phase<128, 256, 32, false, LD1, C1_Q, C1_V, 512, 64>(F, HC1, (const bf16_t*)(big + B_ATT1), (const bf16_t*)(F.ws + WS_XN), nullptr);
#endif
    SEAM(13);

    if (IN(14)) { PHASE_IDS;
        const float* gnw = inptr(I_RETGN);
        for (int t = gw; t < T; t += F.NGW) {
            bf16_t* row = HC1 + (size_t)t * LD1; const u32x4* op = (const u32x4*)(row + C1_V + 32 * lane); u32x4* gp = (u32x4*)(row + C1_G + 32 * lane);
            float o[32]; float s = 0.f;
#pragma unroll
            for (int c = 0; c < 4; ++c) { const u32x4 a = op[c];
                o[8 * c] = __uint_as_float(a.x << 16); o[8 * c + 1] = __uint_as_float(a.x & 0xffff0000u); o[8 * c + 2] = __uint_as_float(a.y << 16); o[8 * c + 3] = __uint_as_float(a.y & 0xffff0000u);
                o[8 * c + 4] = __uint_as_float(a.z << 16); o[8 * c + 5] = __uint_as_float(a.z & 0xffff0000u); o[8 * c + 6] = __uint_as_float(a.w << 16); o[8 * c + 7] = __uint_as_float(a.w & 0xffff0000u); }
#pragma unroll
            for (int e = 0; e < 32; ++e) s += o[e];
            s += __shfl_xor(s, 1); s += __shfl_xor(s, 2); s += __shfl_xor(s, 4); s += __shfl_xor(s, 8);
            const float mu = s * (1.f / 512.f); float q = 0.f;
#pragma unroll
            for (int e = 0; e < 32; ++e) { o[e] -= mu; q += o[e] * o[e]; }
            q += __shfl_xor(q, 1); q += __shfl_xor(q, 2); q += __shfl_xor(q, 4); q += __shfl_xor(q, 8);
            const float rs = 1.f / sqrtf(q * (1.f / 512.f) + GN_EPS);
#pragma unroll
            for (int c = 0; c < 4; ++c) { const u32x4 g4 = gp[c]; const f32x4 w0 = *(const f32x4*)(gnw + 32 * lane + 8 * c), w1 = *(const f32x4*)(gnw + 32 * lane + 8 * c + 4);
                const float g0 = __uint_as_float(g4.x << 16), g1 = __uint_as_float(g4.x & 0xffff0000u), g2 = __uint_as_float(g4.y << 16), g3 = __uint_as_float(g4.y & 0xffff0000u);
                const float g4_ = __uint_as_float(g4.z << 16), g5 = __uint_as_float(g4.z & 0xffff0000u), g6 = __uint_as_float(g4.w << 16), g7 = __uint_as_float(g4.w & 0xffff0000u);
                gp[c] = (u32x4){pk2(o[8 * c] * rs * w0.x * silu_f(g0), o[8 * c + 1] * rs * w0.y * silu_f(g1)), pk2(o[8 * c + 2] * rs * w0.z * silu_f(g2), o[8 * c + 3] * rs * w0.w * silu_f(g3)),
                                pk2(o[8 * c + 4] * rs * w1.x * silu_f(g4_), o[8 * c + 5] * rs * w1.y * silu_f(g5)), pk2(o[8 * c + 6] * rs * w1.z * silu_f(g6), o[8 * c + 7] * rs * w1.w * silu_f(g7))}; }
        }
    }
    SEAM(14);

    if (IN(15)) { PHASE_IDS;
        pg8::DenseOrder S; S.init(T, D, F.G, (int)blockIdx.x); pg8::PlainMap MP; pg8::EpiResF32 E{F.out, F.out, D};
        pg8::gemm_phase(F.lds, HC1 + C1_G, LD1, (const bf16_t*)(F.ws + WS_WOUT1), MIX1, S, MP, E);
    }
    SEAM(15);

    if (IN(16)) { PHASE_IDS;
        LAS float* scr = (LAS float*)(F.lds + wave * 16384);
        constexpr int IGU = (D / 64) * (2 * FFE / 32), IDN = (FFE / 64) * (D / 32);
        for (int it = gw; it < NEXP * (IGU + IDN); it += F.NGW) {
            const int e = it / (IGU + IDN), r = it % (IGU + IDN);
            if (r < IGU) transpose_gateup(inptr(I_WEG) + (size_t)e * D * FFE, inptr(I_WEU) + (size_t)e * D * FFE, D, FFE, (bf16_t*)(big + B_WEGU) + (size_t)e * 2 * FFE * D, r, scr, lane);
            else transpose_plain(inptr(I_WED) + (size_t)e * FFE * D, FFE, D, (bf16_t*)(big + B_WED) + (size_t)e * D * FFE, r - IGU, scr, lane);
        }
        int* rowtok = (int*)(F.ws + WS_ROUTE + R_ROWTOK); float* rowgate = (float*)(F.ws + WS_ROUTE + R_ROWGATE);
        for (int i = gtid; i < 2 * MOE_ROWS; i += NT) { rowtok[i] = -1; rowgate[i] = 0.f; }
        f32x4* tokinfo = (f32x4*)(F.ws + WS_ROUTE + R_TOKINFO);
        const float* wr_ = inptr(I_WROUTER);
        for (int m = gw; m < T; m += F.NGW) {
            f32x4 v[4]; rmsnorm_row(F.out + (size_t)m * D, inptr(I_FN1), XN + (size_t)m * D, lane, v);
            float a[8];
#pragma unroll
            for (int r = 0; r < 8; ++r) a[r] = 0.f;
#pragma unroll
            for (int j = 0; j < 4; ++j)
#pragma unroll
                for (int e = 0; e < 4; ++e) { const int c = 256 * j + 4 * lane + e; const f32x4* wp = (const f32x4*)(wr_ + (size_t)c * 8); const float xv = v[j][e]; const f32x4 w0 = wp[0], w1 = wp[1];
                    a[0] += xv * w0.x; a[1] += xv * w0.y; a[2] += xv * w0.z; a[3] += xv * w0.w; a[4] += xv * w1.x; a[5] += xv * w1.y; a[6] += xv * w1.z; a[7] += xv * w1.w; }
#pragma unroll
            for (int r = 0; r < 8; ++r) a[r] = wave_sum(a[r]);
            int e0 = 0; float l0 = a[0];
#pragma unroll
            for (int r = 1; r < 8; ++r) if (a[r] > l0) { l0 = a[r]; e0 = r; }
            int e1 = -1; float l1 = -3.4e38f;
#pragma unroll
            for (int r = 0; r < 8; ++r) if (r != e0 && a[r] > l1) { l1 = a[r]; e1 = r; }
            const float g0 = 1.f / (1.f + __expf(l1 - l0)), g1 = 1.f - g0;
            if (lane == 0) tokinfo[m] = (f32x4){__int_as_float(e0), __int_as_float(e1), g0, g1};
        }
    }
    SEAM(16);

    if (IN(17)) { PHASE_IDS;
        if (blockIdx.x == 0) {
            const f32x4* tokinfo = (const f32x4*)(F.ws + WS_ROUTE + R_TOKINFO);
            int* rowtok = (int*)(F.ws + WS_ROUTE + R_ROWTOK); float* rowgate = (float*)(F.ws + WS_ROUTE + R_ROWGATE);
            int* blkexp = (int*)(F.ws + WS_ROUTE + R_BLKEXP); int* nblk = (int*)(F.ws + WS_ROUTE + R_NBLK);
            LAS int* cnt = (LAS int*)F.lds;
            LAS int* tot = cnt + 512 * 17;
            for (int k = 0; k < 16; ++k) cnt[tid * 17 + k] = 0;
            for (int i = 0; i < 64; ++i) { const f32x4 ti = tokinfo[tid * 64 + i]; cnt[tid * 17 + __float_as_int(ti.x)] += 1; cnt[tid * 17 + 8 + __float_as_int(ti.y)] += 1; }
            __syncthreads();
            if (tid < 16) { int run = 0; for (int i = 0; i < 512; ++i) { const int c = cnt[i * 17 + tid]; cnt[i * 17 + tid] = run; run += c; } tot[tid] = run; }
            __syncthreads();
            if (tid < 2) { int ps = 0, nb = 0; for (int e = 0; e < 8; ++e) { tot[16 + tid * 8 + e] = ps; const int c = tot[tid * 8 + e], bl = (c + 255) >> 8; for (int j = 0; j < bl; ++j) blkexp[tid * MOE_BLKS + nb + j] = e; nb += bl; ps += bl * 256; } nblk[tid] = nb; }
            __syncthreads();
            for (int i = 0; i < 64; ++i) { const int tok = tid * 64 + i; const f32x4 ti = tokinfo[tok]; const int e0 = __float_as_int(ti.x), e1 = __float_as_int(ti.y);
                const int r0 = tot[16 + e0] + cnt[tid * 17 + e0]; cnt[tid * 17 + e0] += 1; rowtok[r0] = tok; rowgate[r0] = ti.z;
                const int r1 = tot[24 + e1] + cnt[tid * 17 + 8 + e1]; cnt[tid * 17 + 8 + e1] += 1; rowtok[MOE_ROWS + r1] = tok; rowgate[MOE_ROWS + r1] = ti.w; }
        }
    }
    SEAM(17);

#pragma unroll
    for (int slot = 0; slot < 2; ++slot) {
        if (IN(18 + 2 * slot)) { PHASE_IDS;
            const int* rowtok = (const int*)(F.ws + WS_ROUTE + R_ROWTOK) + slot * MOE_ROWS; const int* blkexp = (const int*)(F.ws + WS_ROUTE + R_BLKEXP) + slot * MOE_BLKS;
            const int nb = ((const int*)(F.ws + WS_ROUTE + R_NBLK))[slot];
            MoeOrder S; S.init(nb, 2 * FFE / 256, F.G, (int)blockIdx.x); pg8::MoeMap MP{rowtok, blkexp, 2 * FFE}; pg8::EpiSwiGLU E{(bf16_t*)(big + B_HMOE), FFE};
            pg8::gemm_phase(F.lds, XN, D, (const bf16_t*)(big + B_WEGU), D, S, MP, E);
        }
        SEAM(18 + 2 * slot);
        if (IN(19 + 2 * slot)) { PHASE_IDS;
            const int* rowtok = (const int*)(F.ws + WS_ROUTE + R_ROWTOK) + slot * MOE_ROWS; const float* rowgate = (const float*)(F.ws + WS_ROUTE + R_ROWGATE) + slot * MOE_ROWS;
            const int* blkexp = (const int*)(F.ws + WS_ROUTE + R_BLKEXP) + slot * MOE_BLKS; const int nb = ((const int*)(F.ws + WS_ROUTE + R_NBLK))[slot];
            MoeOrder S; S.init(nb, D / 256, F.G, (int)blockIdx.x); pg8::MoeMap MP{nullptr, blkexp, D}; pg8::EpiMoeDown E{F.out, rowtok, rowgate};
            pg8::gemm_phase(F.lds, (const bf16_t*)(big + B_HMOE), FFE, (const bf16_t*)(big + B_WED), FFE, S, MP, E);
        }
        if (slot == 0) SEAM(19);
    }
#undef IN
#undef SEAM
}

#ifndef N_LAUNCH_MODE
#define N_LAUNCH_MODE 1
#endif
extern "C" void kernel_launch(void* const* d_in, const int* in_sizes, int n_in, void* d_out, int out_size, void* d_ws, size_t ws_size, hipStream_t stream) {
    static int grid = 0;
    if (grid == 0) {
        if (n_in != 22 || out_size != T * D || ws_size < WS_END) { fprintf(stderr, "kernel_launch: unexpected shapes (n_in %d out %d ws %zu need %zu)\n", n_in, out_size, ws_size, (size_t)WS_END); grid = -1; return; }
        int dev = 0, cus = 0, per_cu = 0;
        if (hipGetDevice(&dev) != hipSuccess || hipDeviceGetAttribute(&cus, hipDeviceAttributeMultiprocessorCount, dev) != hipSuccess) { grid = -1; return; }
        if (hipFuncSetAttribute((const void*)fwd_kernel, hipFuncAttributeMaxDynamicSharedMemorySize, LDS_BYTES) != hipSuccess) { fprintf(stderr, "kernel_launch: hipFuncSetAttribute failed\n"); grid = -1; return; }
        if (hipOccupancyMaxActiveBlocksPerMultiprocessor(&per_cu, (const void*)fwd_kernel, NTHREADS, LDS_BYTES) != hipSuccess || per_cu < 1) { fprintf(stderr, "kernel_launch: occupancy query says %d\n", per_cu); (void)hipGetLastError(); grid = -1; return; }
        grid = cus;
    }
    if (grid < 0) return;
    (void)hipMemsetAsync((char*)d_ws + WS_CTL, 0, CTL_ZERO_BYTES, stream);
    Args a{};
    for (int i = 0; i < 22; ++i) a.in[i] = (const float*)d_in[i];
    a.out = (float*)d_out; a.ws = (unsigned char*)d_ws;
#if N_LAUNCH_MODE == 1
    a.ph_lo = 0; a.ph_hi = NPHASE;
    hipLaunchKernelGGL(fwd_kernel, dim3(grid), dim3(NTHREADS), LDS_BYTES, stream, a);
#else
    for (int p = 0; p < NPHASE; ++p) { a.ph_lo = p; a.ph_hi = p + 1; hipLaunchKernelGGL(fwd_kernel, dim3(grid), dim3(NTHREADS), LDS_BYTES, stream, a); }
#endif
}
```

```cpp
#include <hip/hip_runtime.h>
#include <cstdio>
#include <cstdint>

#ifndef NAIVE_RECUR
#define NAIVE_RECUR 0
#endif
#define LAS __attribute__((address_space(3)))
#define GAS __attribute__((address_space(1)))
typedef unsigned short bf16_t;
typedef short bf16x8 __attribute__((ext_vector_type(8)));
typedef float f32x4 __attribute__((ext_vector_type(4)));
typedef float f32x2 __attribute__((ext_vector_type(2)));
typedef unsigned u32x4 __attribute__((ext_vector_type(4)));
typedef unsigned u32x2 __attribute__((ext_vector_type(2)));
typedef GAS unsigned gu32;
#define RLX_AGENT __ATOMIC_RELAXED, __HIP_MEMORY_SCOPE_AGENT
#define LDS_WAIT() asm volatile("s_waitcnt lgkmcnt(0)" ::: "memory")
#define VM_WAIT() asm volatile("s_waitcnt vmcnt(0)" ::: "memory")

constexpr int NBATCH = 4, SEQ = 8192, T = NBATCH * SEQ, D = 1024;
constexpr float NORM_EPS = 1e-6f, GN_EPS = 1e-5f;
constexpr int LDW0 = 4624, LD0 = 4608;
constexpr int C0_QA = 0, C0_KA = 512, C0_VA = 1024, C0_RA = 2048, C0_QB = 3072, C0_KB = 3584, C0_VB = 4096;
constexpr int W0_LR = 3072;
constexpr int MIX0 = 1536, FF0 = 2816;
constexpr int LD1 = 6144, C1_Q = 0, C1_K = 1024, C1_V = 2048, C1_G = 4096, MIX1 = 2048;
constexpr int NEXP = 8, FFE = 3584;
constexpr int MOE_ROWS = 34816, MOE_BLKS = 136;

constexpr size_t MiB = 1u << 20;
constexpr size_t WS_CTL = 0, CTL_ZERO_BYTES = 1 * MiB;
constexpr size_t WS_WIN0 = 1 * MiB, WS_WOUT0 = 10 * MiB, WS_WGU0 = 13 * MiB, WS_WD0 = 24 * MiB, WS_WIN1 = 30 * MiB, WS_WOUT1 = 42 * MiB;
constexpr size_t WS_LR = 46 * MiB, WS_DECAY = 48 * MiB, WS_LSE = 49 * MiB, WS_ROUTE = 52 * MiB;
constexpr size_t WS_XN = 56 * MiB;
constexpr size_t WS_BIG = 120 * MiB;
constexpr size_t B_HCAT0 = 0, B_ATT0 = 288 * MiB, B_KENDT = 304 * MiB, B_OP2 = 336 * MiB;
constexpr size_t B_H0 = 0;
constexpr size_t B_HCAT1 = 0, B_ATT1 = 384 * MiB;
constexpr size_t B_WEGU = 0, B_WED = 112 * MiB, B_HMOE = 168 * MiB;
constexpr size_t WS_END = WS_BIG + 416 * MiB;
constexpr size_t R_TOKINFO = 0, R_ROWTOK = 512 * 1024, R_ROWGATE = R_ROWTOK + 2 * MOE_ROWS * 4, R_BLKEXP = R_ROWGATE + 2 * MOE_ROWS * 4, R_NBLK = R_BLKEXP + 2 * MOE_BLKS * 4;
constexpr int CW_TMO = 0, CW_CODE = 1, CW_BAR = 4096, CW_MOE = 8192;

constexpr int LDS_BYTES = 147456;
constexpr int RING_BYTES = 131072;
constexpr int LDSCTL_OFF = 139264;
constexpr int NWAVES = 8, NTHREADS = 512;

__device__ __forceinline__ float bf2f(bf16_t b) { return __uint_as_float(((unsigned)b) << 16); }
__device__ __forceinline__ unsigned f2bf(float f) { unsigned u = __float_as_uint(f); return (u + 0x7fffu + ((u >> 16) & 1u)) >> 16; }
__device__ __forceinline__ unsigned pk2(float lo, float hi) { return f2bf(lo) | (f2bf(hi) << 16); }
__device__ __forceinline__ float bfround(float f) { return __uint_as_float(f2bf(f) << 16); }
typedef __bf16 bf16v2_t __attribute__((ext_vector_type(2)));
__device__ __forceinline__ unsigned cvt_pk_bf16(float lo, float hi) { const bf16v2_t r = __builtin_convertvector((f32x2){lo, hi}, bf16v2_t); return __builtin_bit_cast(unsigned, r); }
__device__ __forceinline__ float wave_sum(float v) {
#pragma unroll
    for (int o = 1; o < 64; o <<= 1) v += __shfl_xor(v, o);
    return v;
}
__device__ __forceinline__ float silu_f(float v) { return v / (1.f + __expf(-v)); }
__device__ __forceinline__ float logsigmoid_f(float z) { return fminf(z, 0.f) - log1pf(__expf(-fabsf(z))); }

#define XB_TMO      128
#define XB_XCNT(j)  (256  + 64 * (j))
#define XB_XSUB(j)  (1280 + 64 * (j))
#define XB_XGEN(j)  (2304 + 64 * (j))
#define XB_TOP      3328
#define XB_TOPGEN   3392
#define XCD_BAR_WORDS 3456
#define XB_SPIN_CAP (1u << 22)
__device__ __forceinline__ unsigned xb_ld(unsigned* p)              { return __hip_atomic_load(p, __ATOMIC_RELAXED, __HIP_MEMORY_SCOPE_AGENT); }
__device__ __forceinline__ unsigned xb_add(unsigned* p, unsigned v) { return __hip_atomic_fetch_add(p, v, __ATOMIC_RELAXED, __HIP_MEMORY_SCOPE_AGENT); }
__device__ __forceinline__ unsigned xb_xcc_id() { return (unsigned)__builtin_amdgcn_s_getreg((3 << 11) | 20) & 0xFu; }
#define XB_SPIN(cond, bar) do { unsigned _sp = 0; while (cond) { __builtin_amdgcn_s_sleep(1); \
    if ((++_sp & 255u) == 0u) { if (xb_ld(&(bar)[XB_TMO])) break; if (_sp > XB_SPIN_CAP) { atomicAdd(&(bar)[XB_TMO], 1u); break; } } } } while (0)
struct XcdBarrier { unsigned* bar; unsigned x; volatile LAS unsigned* st; };
__device__ __forceinline__ XcdBarrier xcd_barrier_post(unsigned* bar, volatile LAS unsigned* st) {
    XcdBarrier b; b.bar = bar; b.x = xb_xcc_id(); b.st = st;
    if (threadIdx.x == 0) (void)xb_add(&bar[XB_XCNT(b.x)], 1u);
    return b;
}
__device__ __forceinline__ void xcd_barrier_complete(unsigned* bar, unsigned x, unsigned& nloc, unsigned& nx) {
    const unsigned G = gridDim.x * gridDim.y * gridDim.z;
    unsigned sum, cnt, mine, sp = 0u;
    for (;;) {
        sum = 0u; cnt = 0u; mine = 0u;
#pragma unroll
        for (unsigned j = 0; j < 16; ++j) { const unsigned c = xb_ld(&bar[XB_XCNT(j)]); sum += c; cnt += (c > 0u) ? 1u : 0u; mine = (j == x) ? c : mine; }
        if (sum == G) break;
        __builtin_amdgcn_s_sleep(1);
        if ((++sp & 255u) == 0u) { if (xb_ld(&bar[XB_TMO])) break; if (sp > XB_SPIN_CAP) { atomicAdd(&bar[XB_TMO], 1u); break; } }
    }
    nloc = mine > 0u ? mine : 1u; nx = cnt > 0u ? cnt : 1u;
}
__device__ __forceinline__ void xcd_barrier(const XcdBarrier& b) {
    asm volatile("s_waitcnt vmcnt(0)" ::: "memory");
    __syncthreads();
    if (threadIdx.x == 0) {
        unsigned* bar = b.bar;
        __builtin_amdgcn_s_waitcnt(0);
        unsigned nloc = b.st[0], nx = b.st[1];
        if (nloc == 0u) { xcd_barrier_complete(bar, b.x, nloc, nx); b.st[0] = nloc; b.st[1] = nx; }
        const unsigned old = xb_add(&bar[XB_XSUB(b.x)], 1u);
        const unsigned gen = old / nloc;
        if (old + 1u == (gen + 1u) * nloc) {
            __builtin_amdgcn_fence(__ATOMIC_RELEASE, "agent");
            asm volatile("s_waitcnt vmcnt(0)" ::: "memory");
            const unsigned og = xb_add(&bar[XB_TOP], 1u);
            const unsigned tg = og / nx;
            if (og + 1u == (tg + 1u) * nx) xb_add(&bar[XB_TOPGEN], 1u);
            else XB_SPIN(xb_ld(&bar[XB_TOPGEN]) == tg, bar);
            __builtin_amdgcn_fence(__ATOMIC_ACQUIRE, "agent");
            xb_add(&bar[XB_XGEN(b.x)], 1u);
            asm volatile("s_waitcnt vmcnt(0)" ::: "memory");
        } else {
            XB_SPIN(xb_ld(&bar[XB_XGEN(b.x)]) == gen, bar);
            __builtin_amdgcn_fence(__ATOMIC_ACQUIRE, "agent");
            asm volatile("s_waitcnt vmcnt(0)" ::: "memory");
        }
    }
    __syncthreads();
}

namespace pg8 {
constexpr int BM = 256, BK = 64, HALF = 128, HTB = HALF * BK * 2, STAGE_BYTES = 8 * HTB;
__device__ __forceinline__ int lds_byte(int r, int c) { const int st = (r >> 4) * 2 + (c >> 5), rr = r & 15, cc = c & 31, ob = rr * 64 + cc * 2; return st * 1024 + (ob ^ (((ob >> 9) & 1) << 5)); }
__device__ __forceinline__ void stage_rc(int b, int& R, int& C) { const int st = b / 1024, sb = b % 1024, swz = sb ^ (((sb >> 9) & 1) << 5); R = (st >> 1) * 16 + swz / 64; C = (st & 1) * 32 + (swz % 64) / 2; }
__device__ __forceinline__ int perm32(int rho) { const int n = rho >> 4, i = rho & 15; return 8 * (i >> 2) + 4 * n + (i & 3); }
struct Unit { int pm, pn; };

struct DenseOrder {
    int nM, nN, nwg, G, c;
    __device__ void init(int M, int N, int G_, int c_) { nM = M / BM; nN = N / BM; nwg = nM * nN; G = G_; c = c_; }
    __device__ bool next(int i, Unit& u) const {
        const long L = (long)i * G + c; if (L >= nwg) return false;
        int wgid = (int)L; { const int q = nwg / 8, r = nwg % 8, xcd = wgid % 8, off = wgid / 8; wgid = (xcd < r ? xcd * (q + 1) : r * (q + 1) + (xcd - r) * q) + off; }
        const int nig = 8 * nN, gid = wgid / nig, fm = gid * 8, gsz = (nM - fm) < 8 ? (nM - fm) : 8;
        u.pm = fm + ((wgid % nig) % gsz); u.pn = (wgid % nig) / gsz; return true;
    }
};
struct PlainMap {
    __device__ __forceinline__ unsigned arow(int pm, int r) const { return (unsigned)(pm * BM + r); }
    __device__ __forceinline__ size_t brow0(const Unit& u) const { return (size_t)u.pn * BM; }
};
struct MoeMap {
    const int* rowtok; const int* blkexp; int nexp_rows;
    __device__ __forceinline__ unsigned arow(int pm, int r) const { if (!rowtok) return (unsigned)(pm * BM + r); const int t = rowtok[pm * BM + r]; return (unsigned)(t < 0 ? 0 : t); }
    __device__ __forceinline__ size_t brow0(const Unit& u) const { return (size_t)blkexp[u.pm] * nexp_rows + (size_t)u.pn * BM; }
};

template <class Epi, class Sched, class Map>
__device__ __forceinline__ void gemm_phase(LAS unsigned char* lds, const bf16_t* A, int lda, const bf16_t* Bt, int K, const Sched& S, const Map& MP, const Epi& E) {
    int tid_ = threadIdx.x; asm volatile("" : "+v"(tid_));
    const int tid = tid_, wid = __builtin_amdgcn_readfirstlane(tid >> 6), lane = tid & 63, wr = wid >> 2, wc = wid & 3, fr = lane & 15, fq = lane >> 4;
    const int nt = K / BK;
    unsigned voffB[2];
#pragma unroll
    for (int i = 0; i < 2; ++i) { int R, C; stage_rc(tid * 16 + i * 8192, R, C); const int Rb = Epi::PERM ? ((R & ~31) + perm32(R & 31)) : R; voffB[i] = (unsigned)(Rb * K + C) * 2u; }
    const size_t kstep = (size_t)(BK * 2);
    const size_t hstepB = (size_t)HALF * K * 2;
    const unsigned ldsw = (unsigned)wid * 1024u;
    const int aoff = lds_byte(wr * 64 + fr, fq * 8), boff = lds_byte(wc * 32 + fr, fq * 8);
#define PG8_SA(b, h) (((b) * 2 + (h)) * HTB)
#define PG8_SB(b, h) ((4 + (b) * 2 + (h)) * HTB)
#define PG8_STAGE(bufoff, gbase, voff) do { _Pragma("unroll") for (int _i = 0; _i < 2; ++_i) \
        __builtin_amdgcn_global_load_lds((const unsigned*)((const char*)(gbase) + (voff)[_i]), (LAS unsigned*)(lds + (bufoff) + ldsw + _i * 8192), 16, 0, 0); } while (0)
#define PG8_LDA(dst, b, h) do { _Pragma("unroll") for (int m = 0; m < 4; ++m) _Pragma("unroll") for (int k = 0; k < 2; ++k) dst[m][k] = *(const LAS bf16x8*)(lds + PG8_SA(b, h) + aoff + m * 2048 + k * 1024); } while (0)
#define PG8_LDB(dst, b, h) do { _Pragma("unroll") for (int n = 0; n < 2; ++n) _Pragma("unroll") for (int k = 0; k < 2; ++k) dst[n][k] = *(const LAS bf16x8*)(lds + PG8_SB(b, h) + boff + n * 2048 + k * 1024); } while (0)
#define PG8_MMA(ai, bj, At, Bt_) do { __builtin_amdgcn_s_setprio(1); _Pragma("unroll") for (int m = 0; m < 4; ++m) _Pragma("unroll") for (int n = 0; n < 2; ++n) _Pragma("unroll") for (int k = 0; k < 2; ++k) \
        acc[ai][bj][m][n] = __builtin_amdgcn_mfma_f32_16x16x32_bf16(Bt_[n][k], At[m][k], acc[ai][bj][m][n], 0, 0, 0); __builtin_amdgcn_s_setprio(0); } while (0)
#define PG8_WAIT_V(n) asm volatile("s_waitcnt vmcnt(" #n ")" ::: "memory")
#define PG8_WAIT_L(n) asm volatile("s_waitcnt lgkmcnt(" #n ")" ::: "memory")
#define PG8_BAR __builtin_amdgcn_s_barrier()
#define PG8_SCHED __builtin_amdgcn_sched_barrier(0)
#define PG8_VOFFA(dst, u_) do { _Pragma("unroll") for (int _i = 0; _i < 2; ++_i) { int _R, _C; stage_rc(tid * 16 + _i * 8192, _R, _C); _Pragma("unroll") for (int _h = 0; _h < 2; ++_h) \
        dst[_h][_i] = (MP.arow((u_).pm, _h * HALF + _R) * (unsigned)lda + (unsigned)_C) * 2u; } } while (0)
#define PG8_STAGE2(bufoff, gbase, va, vb, sel) do { _Pragma("unroll") for (int _i = 0; _i < 2; ++_i) \
        __builtin_amdgcn_global_load_lds((const unsigned*)((const char*)(gbase) + ((sel) ? (vb)[_i] : (va)[_i])), (LAS unsigned*)(lds + (bufoff) + ldsw + _i * 8192), 16, 0, 0); } while (0)
    Unit cur, nxt; int ui = 0;
    if (!S.next(0, cur)) return;
    f32x4 acc[2][2][4][2];
#pragma unroll
    for (int a = 0; a < 2; ++a)
#pragma unroll
        for (int b = 0; b < 2; ++b)
#pragma unroll
            for (int m = 0; m < 4; ++m)
#pragma unroll
                for (int n = 0; n < 2; ++n) acc[a][b][m][n] = (f32x4){0.f, 0.f, 0.f, 0.f};
    bf16x8 At[4][2], B0[2][2], B1[2][2];
    unsigned vc[2][2], vn[2][2];
    PG8_VOFFA(vc, cur);
    const char* cA = (const char*)A; const char* cB = (const char*)Bt + MP.brow0(cur) * (size_t)K * 2;
    PG8_STAGE(PG8_SB(0, 0), cB, voffB); PG8_STAGE(PG8_SB(0, 1), cB + hstepB, voffB); PG8_STAGE(PG8_SA(0, 0), cA, vc[0]); PG8_STAGE(PG8_SA(0, 1), cA, vc[1]);
    if (wr == 1) PG8_BAR;
    PG8_WAIT_V(2); PG8_BAR;
    PG8_STAGE(PG8_SB(1, 0), cB + kstep, voffB); PG8_STAGE(PG8_SA(1, 0), cA + kstep, vc[0]); PG8_STAGE(PG8_SB(1, 1), cB + hstepB + kstep, voffB);
    PG8_WAIT_V(6); PG8_BAR;
    for (;;) {
        const bool has_next = S.next(ui + 1, nxt);
        const char* nB = cB;
        if (has_next) { PG8_VOFFA(vn, nxt); nB = (const char*)Bt + MP.brow0(nxt) * (size_t)K * 2; }
        else {
#pragma unroll
            for (int h = 0; h < 2; ++h)
#pragma unroll
                for (int i = 0; i < 2; ++i) vn[h][i] = vc[h][i];
        }
        for (int t = 0; t < nt; t += 2) {
            const bool last = (t == nt - 2);
            const char* a1 = cA + (size_t)(t + 1) * kstep;
            const char* a2 = last ? cA : cA + (size_t)(t + 2) * kstep; const char* b2 = last ? nB : cB + (size_t)(t + 2) * kstep;
            const char* a3 = a2 + kstep; const char* b3 = b2 + kstep;
            PG8_LDB(B0, 0, 0); PG8_LDB(B1, 0, 1); PG8_SCHED; PG8_LDA(At, 0, 0); PG8_STAGE(PG8_SA(1, 1), a1, vc[1]);
            PG8_WAIT_V(8); PG8_WAIT_L(0); PG8_BAR; PG8_MMA(0, 0, At, B0); PG8_MMA(0, 1, At, B1); PG8_BAR; PG8_SCHED;
            PG8_LDA(At, 0, 1); PG8_STAGE(PG8_SB(0, 0), b2, voffB); PG8_STAGE(PG8_SB(0, 1), b2 + hstepB, voffB); PG8_STAGE2(PG8_SA(0, 0), a2, vc[0], vn[0], last);
            PG8_WAIT_V(8); PG8_WAIT_L(0); PG8_BAR; PG8_MMA(1, 0, At, B0); PG8_MMA(1, 1, At, B1); PG8_BAR; PG8_SCHED;
            PG8_LDB(B0, 1, 0); PG8_LDB(B1, 1, 1); PG8_SCHED; PG8_LDA(At, 1, 0); PG8_STAGE2(PG8_SA(0, 1), a2, vc[1], vn[1], last);
            PG8_WAIT_V(8); PG8_WAIT_L(0); PG8_BAR; PG8_MMA(0, 0, At, B0); PG8_MMA(0, 1, At, B1); PG8_BAR; PG8_SCHED;
            PG8_LDA(At, 1, 1); PG8_STAGE(PG8_SB(1, 0), b3, voffB); PG8_STAGE(PG8_SB(1, 1), b3 + hstepB, voffB); PG8_STAGE2(PG8_SA(1, 0), a3, vc[0], vn[0], last);
            PG8_WAIT_V(8); PG8_WAIT_L(0); PG8_BAR; PG8_MMA(1, 0, At, B0); PG8_MMA(1, 1, At, B1); PG8_BAR; PG8_SCHED;
        }
        if (wr == 0) PG8_BAR;
        E(acc, cur, wr, wc, fr, fq);
        if (!has_next) break;
#pragma unroll
        for (int a = 0; a < 2; ++a)
#pragma unroll
            for (int b = 0; b < 2; ++b)
#pragma unroll
                for (int m = 0; m < 4; ++m)
#pragma unroll
                    for (int n = 0; n < 2; ++n) acc[a][b][m][n] = (f32x4){0.f, 0.f, 0.f, 0.f};
        cur = nxt; cB = nB; ++ui;
#pragma unroll
        for (int h = 0; h < 2; ++h)
#pragma unroll
            for (int i = 0; i < 2; ++i) vc[h][i] = vn[h][i];
        if (wr == 1) PG8_BAR;
    }
    PG8_WAIT_V(0);
    PG8_BAR;
#undef PG8_SA
#undef PG8_SB
#undef PG8_STAGE
#undef PG8_LDA
#undef PG8_LDB
#undef PG8_MMA
#undef PG8_WAIT_V
#undef PG8_WAIT_L
#undef PG8_BAR
#undef PG8_SCHED
#undef PG8_VOFFA
#undef PG8_STAGE2
}

struct EpiBf16 {
    static constexpr bool PERM = true;
    bf16_t* O; int ldc;
    __device__ __forceinline__ void operator()(const f32x4 (&acc)[2][2][4][2], const Unit& u, int wr, int wc, int fr, int fq) const {
        const int row0 = u.pm * BM + wr * 64 + fr, col0 = u.pn * BM + wc * 32 + 8 * fq;
#pragma unroll
        for (int ai = 0; ai < 2; ++ai)
#pragma unroll
            for (int m = 0; m < 4; ++m) { bf16_t* rowp = O + (size_t)(row0 + ai * HALF + m * 16) * ldc + col0;
#pragma unroll
                for (int bj = 0; bj < 2; ++bj) { const f32x4 v0 = acc[ai][bj][m][0], v1 = acc[ai][bj][m][1];
                    u32x4 w; w.x = cvt_pk_bf16(v0[0], v0[1]); w.y = cvt_pk_bf16(v0[2], v0[3]); w.z = cvt_pk_bf16(v1[0], v1[1]); w.w = cvt_pk_bf16(v1[2], v1[3]);
                    *(u32x4*)(rowp + bj * HALF) = w; } }
    }
};
struct EpiSwiGLU {
    static constexpr bool PERM = true;
    bf16_t* H; int ldh;
    __device__ __forceinline__ void operator()(const f32x4 (&acc)[2][2][4][2], const Unit& u, int wr, int wc, int fr, int fq) const {
        const int row0 = u.pm * BM + wr * 64 + fr, col0 = u.pn * HALF + wc * 32 + 8 * fq;
#pragma unroll
        for (int ai = 0; ai < 2; ++ai)
#pragma unroll
            for (int m = 0; m < 4; ++m) { bf16_t* rowp = H + (size_t)(row0 + ai * HALF + m * 16) * ldh + col0;
                f32x4 h0, h1;
#pragma unroll
                for (int j = 0; j < 4; ++j) { const float g0 = acc[ai][0][m][0][j], g1 = acc[ai][0][m][1][j];
                    h0[j] = g0 * __builtin_amdgcn_rcpf(1.f + __expf(-g0)) * acc[ai][1][m][0][j]; h1[j] = g1 * __builtin_amdgcn_rcpf(1.f + __expf(-g1)) * acc[ai][1][m][1][j]; }
                u32x4 w; w.x = cvt_pk_bf16(h0[0], h0[1]); w.y = cvt_pk_bf16(h0[2], h0[3]); w.z = cvt_pk_bf16(h1[0], h1[1]); w.w = cvt_pk_bf16(h1[2], h1[3]);
                *(u32x4*)rowp = w; }
    }
};
struct EpiResF32 {
    static constexpr bool PERM = false;
    const float* base; float* out; int ldc;
    __device__ __forceinline__ void operator()(const f32x4 (&acc)[2][2][4][2], const Unit& u, int wr, int wc, int fr, int fq) const {
        const int row0 = u.pm * BM + wr * 64 + fr, col0 = u.pn * BM + wc * 32 + 4 * fq;
#pragma unroll
        for (int ai = 0; ai < 2; ++ai)
#pragma unroll
            for (int m = 0; m < 4; ++m) { const size_t off = (size_t)(row0 + ai * HALF + m * 16) * ldc + col0;
#pragma unroll
                for (int bj = 0; bj < 2; ++bj)
#pragma unroll
                    for (int n = 0; n < 2; ++n) { const f32x4 bs = *(const f32x4*)(base + off + bj * HALF + n * 16); *(f32x4*)(out + off + bj * HALF + n * 16) = bs + acc[ai][bj][m][n]; } }
    }
};
struct EpiMoeDown {
    static constexpr bool PERM = false;
    float* out; const int* rowtok; const float* rowgate;
    __device__ __forceinline__ void operator()(const f32x4 (&acc)[2][2][4][2], const Unit& u, int wr, int wc, int fr, int fq) const {
        const int row0 = u.pm * BM + wr * 64 + fr, col0 = u.pn * BM + wc * 32 + 4 * fq;
#pragma unroll
        for (int ai = 0; ai < 2; ++ai)
#pragma unroll
            for (int m = 0; m < 4; ++m) { const int r = row0 + ai * HALF + m * 16; const int tok = rowtok[r]; const float g = rowgate[r];
                if (tok >= 0) { float* op = out + (size_t)tok * D + col0;
#pragma unroll
                    for (int bj = 0; bj < 2; ++bj)
#pragma unroll
                        for (int n = 0; n < 2; ++n) { const f32x4 bs = *(const f32x4*)(op + bj * HALF + n * 16); *(f32x4*)(op + bj * HALF + n * 16) = bs + g * acc[ai][bj][m][n]; } } }
    }
};
}

struct MoeOrder {
    int nwg, nN, G, c;
    __device__ void init(int nblk, int nN_, int G_, int c_) { nN = nN_; nwg = nblk * nN_; G = G_; c = c_; }
    __device__ bool next(int i, pg8::Unit& u) const { const long L = (long)i * G + c; if (L >= nwg) return false; u.pm = (int)(L / nN); u.pn = (int)(L % nN); return true; }
};

struct Frame {
    LAS unsigned char* lds;
    gu32* ctl;
    int tid, lane, wave, G, gw, NGW;
    unsigned char* ws;
    float* out;
};
__device__ __forceinline__ const float* inptr(int i) {
    unsigned off = (unsigned)i * 8u; asm volatile("" : "+s"(off));
    return *(const float* const*)((const char*)__builtin_amdgcn_kernarg_segment_ptr() + off);
}
enum { I_X = 0, I_MN0, I_WIN0, I_WGATEUP, I_BGATE, I_GLANORM, I_QNORM, I_KNORM, I_WOUT0, I_FN0, I_WFG, I_WFU, I_WFD, I_MN1, I_WIN1, I_RETGN, I_WOUT1, I_FN1, I_WROUTER, I_WEG, I_WEU, I_WED };

__device__ __forceinline__ void transpose_item(const float* W, int ldw, int src_col0, bf16_t* WT, int ldt, int dst_row0, int k0, LAS float* scr, int lane) {
#pragma unroll 8
    for (int i = 0; i < 32; ++i) { const int kk = 2 * i + (lane >> 5); scr[kk * 33 + (lane & 31)] = W[(size_t)(k0 + kk) * ldw + src_col0 + (lane & 31)]; }
    LDS_WAIT(); asm volatile("" ::: "memory");
    const int c = lane & 7;
#pragma unroll
    for (int j = 0; j < 4; ++j) { const int n = (lane >> 3) + 8 * j; const LAS float* s = scr + (8 * c) * 33 + n;
        u32x4 o; o.x = pk2(s[0 * 33], s[1 * 33]); o.y = pk2(s[2 * 33], s[3 * 33]); o.z = pk2(s[4 * 33], s[5 * 33]); o.w = pk2(s[6 * 33], s[7 * 33]);
        *(u32x4*)(WT + (size_t)(dst_row0 + n) * ldt + k0 + 8 * c) = o; }
    LDS_WAIT(); asm volatile("" ::: "memory");
}
__device__ __forceinline__ void transpose_plain(const float* W, int K, int N, bf16_t* WT, int it, LAS float* scr, int lane) {
    const int nblk = N / 32, kb = it / nblk, nb = it % nblk; transpose_item(W, N, 32 * nb, WT, K, 32 * nb, 64 * kb, scr, lane);
}
__device__ __forceinline__ void transpose_gateup(const float* Wg, const float* Wu, int K, int F, bf16_t* WT, int it, LAS float* scr, int lane) {
    const int nblk = 2 * F / 32, kb = it / nblk, nb = it % nblk, dr = 32 * nb, tile = dr >> 8, within = dr & 255;
    const float* W = within < 128 ? Wg : Wu; const int sc = tile * 128 + (within & 127);
    transpose_item(W, F, sc, WT, K, dr, 64 * kb, scr, lane);
}

__device__ __forceinline__ void rmsnorm_row(const float* xrow, const float* w, bf16_t* orow, int lane, f32x4 (&v)[4]) {
    const f32x4* xr = (const f32x4*)xrow + lane; float s = 0.f;
#pragma unroll
    for (int j = 0; j < 4; ++j) { v[j] = xr[64 * j]; s += (v[j].x * v[j].x + v[j].y * v[j].y) + (v[j].z * v[j].z + v[j].w * v[j].w); }
    const float r = 1.f / sqrtf(wave_sum(s) * (1.f / D) + NORM_EPS);
    const f32x4* wr = (const f32x4*)w + lane;
    unsigned long long* o8 = (unsigned long long*)orow + lane;
#pragma unroll
    for (int j = 0; j < 4; ++j) { const f32x4 ww = wr[64 * j]; v[j] = v[j] * r * ww; o8[64 * j] = (unsigned long long)pk2(v[j].x, v[j].y) | ((unsigned long long)pk2(v[j].z, v[j].w) << 32); }
}


__device__ __forceinline__ void unpack8(const u32x4 raw, float (&x)[8]) {
    x[0] = __uint_as_float(raw.x << 16); x[1] = __uint_as_float(raw.x & 0xffff0000u); x[2] = __uint_as_float(raw.y << 16); x[3] = __uint_as_float(raw.y & 0xffff0000u);
    x[4] = __uint_as_float(raw.z << 16); x[5] = __uint_as_float(raw.z & 0xffff0000u); x[6] = __uint_as_float(raw.w << 16); x[7] = __uint_as_float(raw.w & 0xffff0000u);
}
typedef short s16x4 __attribute__((ext_vector_type(4)));
__device__ __forceinline__ void dilated_phase(const Frame& F, const bf16_t* HC0, bf16_t* op01, bf16_t* op2, float* lse) {
    constexpr int SLOT = 128 * 144;
    constexpr float LOG2E = 1.4426950408889634f, LN2 = 0.6931471805599453f;
    LAS unsigned char* Ks = F.lds; LAS unsigned char* Vs = F.lds + 3 * SLOT;
    for (int i = F.tid; i < 6 * SLOT / 16; i += NTHREADS) ((LAS u32x4*)F.lds)[i] = (u32x4){0u, 0u, 0u, 0u};
    int tid_ = threadIdx.x; asm volatile("" : "+v"(tid_));
    const int lane = tid_ & 63, fr = lane & 15, fq = lane >> 4, w = __builtin_amdgcn_readfirstlane(tid_ >> 6);
    const int srow0 = tid_ >> 3, sc = tid_ & 7;
    float knw[8], qnw[16];
    { const float* kn = inptr(I_KNORM); const float* qn = inptr(I_QNORM);
#pragma unroll
      for (int e = 0; e < 8; ++e) { knw[e] = kn[8 * sc + e]; qnw[e] = qn[8 * fq + e] * (0.125f * LOG2E); qnw[8 + e] = qn[32 + 8 * fq + e] * (0.125f * LOG2E); } }
    const unsigned vlane = (unsigned)((4 * fq + ((lane & 15) >> 2)) * 144 + (lane & 3) * 8);
    __syncthreads();
    for (int item = blockIdx.x; item < 1536; item += F.G) {
        const int p = item >> 9, within = item & 511, dsh = 2 * p, d = 1 << dsh;
        const int strip = within >> (4 - dsh), grp = within & ((16 >> dsh) - 1), r = strip & (d - 1), bh = strip >> dsh, h = bh & 7, b = bh >> 3, n0 = 4 * grp;
        const float cb = exp2f(-(float)(h + 1)) * LOG2E * (float)d;
        bf16_t* op = p < 2 ? op01 + (size_t)p * T * 512 : op2;
        const bf16_t* base = HC0 + (size_t)b * SEQ * LD0 + h * 64;
        u32x4 kreg[2], vreg[2];
#define DIL_LOAD(m) do { _Pragma("unroll") for (int rep = 0; rep < 2; ++rep) { const size_t pos = (size_t)((128 * (m) + srow0 + 64 * rep) * d + r); \
            kreg[rep] = *(const u32x4*)(base + pos * LD0 + C0_KB + 8 * sc); vreg[rep] = *(const u32x4*)(base + pos * LD0 + C0_VB + 8 * sc); } } while (0)
#define DIL_STORE(slot) do { _Pragma("unroll") for (int rep = 0; rep < 2; ++rep) { float x[8]; unpack8(kreg[rep], x); float ss = 0.f; \
            _Pragma("unroll") for (int e = 0; e < 8; ++e) ss += x[e] * x[e]; \
            ss += __shfl_xor(ss, 1); ss += __shfl_xor(ss, 2); ss += __shfl_xor(ss, 4); const float rs = 1.f / sqrtf(ss * (1.f / 64.f) + NORM_EPS); \
            const unsigned ro = (unsigned)((slot) * SLOT + (srow0 + 64 * rep) * 144 + sc * 16); \
            *(LAS u32x4*)(Ks + ro) = (u32x4){cvt_pk_bf16(x[0] * rs * knw[0], x[1] * rs * knw[1]), cvt_pk_bf16(x[2] * rs * knw[2], x[3] * rs * knw[3]), cvt_pk_bf16(x[4] * rs * knw[4], x[5] * rs * knw[5]), cvt_pk_bf16(x[6] * rs * knw[6], x[7] * rs * knw[7])}; \
            *(LAS u32x4*)(Vs + ro) = vreg[rep]; } } while (0)
        if (n0 > 0) { DIL_LOAD(n0 - 1); DIL_STORE((n0 + 2) % 3); }
        DIL_LOAD(n0); DIL_STORE(n0 % 3);
        u32x4 qraw0, qraw1;
#define DIL_LOADQ(m) do { const bf16_t* qp_ = HC0 + ((size_t)b * SEQ + (size_t)((128 * (m) + 16 * w + fr) * d + r)) * LD0 + C0_QB + h * 64; qraw0 = *(const u32x4*)(qp_ + 8 * fq); qraw1 = *(const u32x4*)(qp_ + 32 + 8 * fq); } while (0)
        DIL_LOADQ(n0);
        __syncthreads();
#pragma unroll 1
        for (int n = n0; n < n0 + 4; ++n) {
            const int prev = (n + 2) % 3, cur = n % 3, nxt = (n + 1) % 3;
            const bool more = (n + 1 < n0 + 4);
            const size_t tokq = (size_t)b * SEQ + (size_t)((128 * n + 16 * w + fr) * d + r);
            bf16x8 qf0, qf1;
            { float x0[8], x1[8]; unpack8(qraw0, x0); unpack8(qraw1, x1);
              float ss = 0.f;
#pragma unroll
              for (int e = 0; e < 8; ++e) ss += x0[e] * x0[e] + x1[e] * x1[e];
              ss += __shfl_xor(ss, 16); ss += __shfl_xor(ss, 32);
              const float rs = 1.f / sqrtf(ss * (1.f / 64.f) + NORM_EPS);
              const u32x4 a0 = (u32x4){cvt_pk_bf16(x0[0] * rs * qnw[0], x0[1] * rs * qnw[1]), cvt_pk_bf16(x0[2] * rs * qnw[2], x0[3] * rs * qnw[3]), cvt_pk_bf16(x0[4] * rs * qnw[4], x0[5] * rs * qnw[5]), cvt_pk_bf16(x0[6] * rs * qnw[6], x0[7] * rs * qnw[7])};
              const u32x4 a1 = (u32x4){cvt_pk_bf16(x1[0] * rs * qnw[8], x1[1] * rs * qnw[9]), cvt_pk_bf16(x1[2] * rs * qnw[10], x1[3] * rs * qnw[11]), cvt_pk_bf16(x1[4] * rs * qnw[12], x1[5] * rs * qnw[13]), cvt_pk_bf16(x1[6] * rs * qnw[14], x1[7] * rs * qnw[15])};
              qf0 = __builtin_bit_cast(bf16x8, a0); qf1 = __builtin_bit_cast(bf16x8, a1); }
            if (more) { DIL_LOAD(n + 1); DIL_LOADQ(n + 1); }
            f32x4 sacc[9];
#pragma unroll
            for (int i = 0; i < 9; ++i) { const int kt = w + i; const unsigned ko = (unsigned)((kt < 8 ? prev : cur) * SLOT + ((kt & 7) * 16 + fr) * 144 + fq * 16);
                const bf16x8 k0 = *(const LAS bf16x8*)(Ks + ko), k1 = *(const LAS bf16x8*)(Ks + ko + 64);
                f32x4 z = (f32x4){0.f, 0.f, 0.f, 0.f};
                z = __builtin_amdgcn_mfma_f32_16x16x32_bf16(k0, qf0, z, 0, 0, 0); sacc[i] = __builtin_amdgcn_mfma_f32_16x16x32_bf16(k1, qf1, z, 0, 0, 0); }
            float mx = -1e30f; const int lpart = fr - 4 * fq;
#pragma unroll
            for (int i = 0; i < 9; ++i) { const bool tile_ok = (w + i >= 8) || (n > 0);
#pragma unroll
                for (int j = 0; j < 4; ++j) { const int steps = 128 - 16 * i - j + lpart; float sv = sacc[i][j] - cb * (float)steps; bool ok = tile_ok;
                    if (i == 0) ok = ok && (steps <= 128); if (i == 8) ok = ok && (steps >= 0);
                    sv = ok ? sv : -1e30f; sacc[i][j] = sv; mx = fmaxf(mx, sv); } }
            mx = fmaxf(mx, __shfl_xor(mx, 16)); mx = fmaxf(mx, __shfl_xor(mx, 32));
            float l = 0.f;
#pragma unroll
            for (int i = 0; i < 9; ++i)
#pragma unroll
                for (int j = 0; j < 4; ++j) { const float pe = __builtin_amdgcn_exp2f(sacc[i][j] - mx); sacc[i][j] = pe; l += pe; }
            l += __shfl_xor(l, 16); l += __shfl_xor(l, 32);
            bf16x8 pf[5];
#pragma unroll
            for (int ks = 0; ks < 5; ++ks) { u32x4 t4; t4.x = cvt_pk_bf16(sacc[2 * ks][0], sacc[2 * ks][1]); t4.y = cvt_pk_bf16(sacc[2 * ks][2], sacc[2 * ks][3]);
                if (ks < 4) { t4.z = cvt_pk_bf16(sacc[2 * ks + 1][0], sacc[2 * ks + 1][1]); t4.w = cvt_pk_bf16(sacc[2 * ks + 1][2], sacc[2 * ks + 1][3]); } else { t4.z = 0u; t4.w = 0u; }
                pf[ks] = __builtin_bit_cast(bf16x8, t4); }
            f32x4 oacc[4];
#pragma unroll
            for (int dt = 0; dt < 4; ++dt) oacc[dt] = (f32x4){0.f, 0.f, 0.f, 0.f};
#pragma unroll
            for (int ks = 0; ks < 5; ++ks) { const int ta = w + 2 * ks, tb = ks < 4 ? ta + 1 : ta;
                const unsigned va = (unsigned)((ta < 8 ? prev : cur) * SLOT + (ta & 7) * 16 * 144) + vlane, vb = (unsigned)((tb < 8 ? prev : cur) * SLOT + (tb & 7) * 16 * 144) + vlane;
#pragma unroll
                for (int dt = 0; dt < 4; ++dt) { const s16x4 lo = __builtin_amdgcn_ds_read_tr16_b64_v4i16((LAS s16x4*)(Vs + va + dt * 32)), hi = __builtin_amdgcn_ds_read_tr16_b64_v4i16((LAS s16x4*)(Vs + vb + dt * 32));
                    const bf16x8 vf = (bf16x8){lo[0], lo[1], lo[2], lo[3], hi[0], hi[1], hi[2], hi[3]};
                    oacc[dt] = __builtin_amdgcn_mfma_f32_16x16x32_bf16(vf, pf[ks], oacc[dt], 0, 0, 0); } }
            const float il = 1.f / l;
            bf16_t* orow = op + tokq * 512 + h * 64 + 4 * fq;
#pragma unroll
            for (int dt = 0; dt < 4; ++dt) *(u32x2*)(orow + 16 * dt) = (u32x2){cvt_pk_bf16(oacc[dt][0] * il, oacc[dt][1] * il), cvt_pk_bf16(oacc[dt][2] * il, oacc[dt][3] * il)};
            if (fq == 0) lse[((size_t)p * T + tokq) * 8 + h] = (mx + __builtin_amdgcn_logf(l)) * LN2;
            if (more) DIL_STORE(nxt);
            __syncthreads();
        }
#undef DIL_LOAD
#undef DIL_LOADQ
#undef DIL_STORE
    }
}

template <int C, int DK, int DVS, bool SPLIT, int LD, int CQ, int CV, int DVH, int NCH, int PFO, int PFS, int PFV>
__device__ __forceinline__ void recur_phase(const Frame& F, bf16_t* HC, const bf16_t* att, const bf16_t* keT, const float* decay) {
    constexpr int KA = C / 32, KQ = DK / 32, MTV = DVS / 16;
    constexpr int SP = DK * 2 + 16, VP = DVS * 2;
    constexpr int VBUF = C * VP, SBUF = DVS * SP;
    constexpr int NVCH = C * DVS / 8;
    constexpr int UNR = PFO > PFS ? (PFO > PFV ? PFO : PFV) : (PFS > PFV ? PFS : PFV);
    static_assert(UNR % PFO == 0 && UNR % PFS == 0 && UNR % PFV == 0 && UNR % 2 == 0 && NCH % UNR == 0, "ring depths");
    LAS unsigned char* vb = F.lds; LAS unsigned char* sb = F.lds + 2 * VBUF;
    int tid_ = threadIdx.x; asm volatile("" : "+v"(tid_));
    const int tid = tid_, lane = tid & 63, fr = lane & 15, fq = lane >> 4, w = __builtin_amdgcn_readfirstlane(tid >> 6);
    const bool is_o = SPLIT ? (w < 4) : true, is_s = SPLIT ? (w >= 4) : true;
    const int nto = SPLIT ? (w & 3) : w, mts0 = SPLIT ? 2 * (w & 3) : 2 * w;
    const unsigned trl = (unsigned)((8 * fq + ((lane & 15) >> 2)) * VP + (lane & 3) * 8);
    const int vrow = tid / (DVS / 8), vpart = tid % (DVS / 8);
    for (int item = blockIdx.x; item < 256; item += F.G) {
        const int sl = item & 15, h = (item >> 4) & 3, b = item >> 6;
        const float cdec = __expf((float)C * log1pf(-exp2f(-5.f - (float)h)));
        __syncthreads();
        for (int i = tid; i < SBUF / 16; i += NTHREADS) ((LAS u32x4*)sb)[i] = (u32x4){0u, 0u, 0u, 0u};
        f32x4 accS[2][MTV];
#pragma unroll
        for (int i = 0; i < 2; ++i)
#pragma unroll
            for (int j = 0; j < MTV; ++j) accS[i][j] = (f32x4){0.f, 0.f, 0.f, 0.f};
        static_assert(!SPLIT || (PFO == PFS && KA + KQ >= 2 * KA + 2), "aliased rings");
        u32x4 RO[PFO][KA + KQ], RSx[SPLIT ? 1 : PFS][SPLIT ? 1 : 2 * KA + 2]; u32x4 vreg[PFV];
#define BA_(u_, ks_) RO[u_][ks_]
#define BQ_(u_, kq_) RO[u_][KA + (kq_)]
#define KE_(u_, i_, ks_) (*(SPLIT ? &RO[u_][(i_) * KA + (ks_)] : &RSx[SPLIT ? 0 : (u_)][SPLIT ? 0 : (i_) * KA + (ks_)]))
#define DC_(u_, i_) (*(SPLIT ? &RO[u_][2 * KA + (i_)] : &RSx[SPLIT ? 0 : (u_)][SPLIT ? 0 : 2 * KA + (i_)]))
        const size_t vcol = (size_t)CV + h * DVH + sl * DVS;
#define RC_LOAD_O(u_, n_) do { const size_t unit_ = (size_t)(b * NCH + (n_)) * 4 + h; const size_t t_ = (size_t)b * SEQ + (size_t)(n_) * C + 16 * nto + fr; \
            const bf16_t* ap_ = att + unit_ * C * C + (size_t)(16 * nto + fr) * C + 8 * fq; const bf16_t* qp_ = HC + t_ * LD + CQ + h * DK + 8 * fq; \
            _Pragma("unroll") for (int ks = 0; ks < KA; ++ks) if (2 * ks <= nto) BA_(u_, ks) = *(const u32x4*)(ap_ + 32 * ks); \
            _Pragma("unroll") for (int kq = 0; kq < KQ; ++kq) BQ_(u_, kq) = *(const u32x4*)(qp_ + 32 * kq); } while (0)
#define RC_LOAD_S(u_, n_) do { const size_t unit_ = (size_t)(b * NCH + (n_)) * 4 + h; \
            _Pragma("unroll") for (int i = 0; i < 2; ++i) { const bf16_t* kp_ = keT + (unit_ * DK + 16 * (mts0 + i) + fr) * C + 8 * fq; \
                _Pragma("unroll") for (int ks = 0; ks < KA; ++ks) KE_(u_, i, ks) = *(const u32x4*)(kp_ + 32 * ks); \
                if (decay) DC_(u_, i) = *(const u32x4*)(decay + unit_ * DK + 16 * (mts0 + i) + 4 * fq); } } while (0)
#define RC_LOAD_V(u_, n_) do { if (tid < NVCH) vreg[u_] = *(const u32x4*)(HC + ((size_t)b * SEQ + (size_t)(n_) * C + vrow) * LD + vcol + vpart * 8); } while (0)
#define RC_STORE_V(buf_, u_) do { if (tid < NVCH) *(LAS u32x4*)(vb + (buf_) * VBUF + vrow * VP + vpart * 16) = vreg[u_]; } while (0)
#pragma unroll
        for (int u = 0; u < PFV; ++u) vreg[u] = (u32x4){0u, 0u, 0u, 0u};
#pragma unroll
        for (int u = 0; u < PFO; ++u) if (is_o) RC_LOAD_O(u, u);
#pragma unroll
        for (int u = 0; u < PFS; ++u) if (is_s) RC_LOAD_S(u, u);
#pragma unroll
        for (int u = 0; u < PFV; ++u) RC_LOAD_V(u, u);
        RC_STORE_V(0, 0);
        if (PFV < NCH) RC_LOAD_V(0, PFV);
        __syncthreads();
#pragma unroll 1
        for (int n0 = 0; n0 < NCH; n0 += UNR) {
#pragma unroll
            for (int u = 0; u < UNR; ++u) {
                const int n = n0 + u; constexpr int dummy = 0; (void)dummy;
                const int cb = u & 1, nb = cb ^ 1;
#define RC_VT(dst, mt_) do { _Pragma("unroll") for (int ks = 0; ks < KA; ++ks) { const LAS unsigned char* p0 = vb + cb * VBUF + trl + (32 * ks) * VP + (mt_) * 32; \
                    const s16x4 lo = __builtin_amdgcn_ds_read_tr16_b64_v4i16((LAS s16x4*)p0), hi = __builtin_amdgcn_ds_read_tr16_b64_v4i16((LAS s16x4*)(p0 + 4 * VP)); \
                    dst[ks] = (bf16x8){lo[0], lo[1], lo[2], lo[3], hi[0], hi[1], hi[2], hi[3]}; } } while (0)
                if (is_o) {
                    f32x4 ao[MTV];
#pragma unroll
                    for (int mt = 0; mt < MTV; ++mt) { bf16x8 vT[KA]; RC_VT(vT, mt); ao[mt] = (f32x4){0.f, 0.f, 0.f, 0.f};
#pragma unroll
                        for (int ks = 0; ks < KA; ++ks) if (2 * ks <= nto) ao[mt] = __builtin_amdgcn_mfma_f32_16x16x32_bf16(vT[ks], __builtin_bit_cast(bf16x8, BA_(u % PFO, ks)), ao[mt], 0, 0, 0);
#pragma unroll
                        for (int kq = 0; kq < KQ; ++kq) { const bf16x8 sa = *(const LAS bf16x8*)(sb + cb * SBUF + (16 * mt + fr) * SP + (32 * kq + 8 * fq) * 2);
                            ao[mt] = __builtin_amdgcn_mfma_f32_16x16x32_bf16(sa, __builtin_bit_cast(bf16x8, BQ_(u % PFO, kq)), ao[mt], 0, 0, 0); } }
                    bf16_t* op = HC + ((size_t)b * SEQ + (size_t)n * C + 16 * nto + fr) * LD + vcol + 4 * fq;
#pragma unroll
                    for (int mt = 0; mt < MTV; ++mt) *(u32x2*)(op + 16 * mt) = (u32x2){cvt_pk_bf16(ao[mt][0], ao[mt][1]), cvt_pk_bf16(ao[mt][2], ao[mt][3])};
                    if (n + PFO < NCH) RC_LOAD_O(u % PFO, n + PFO);
                }
                if (is_s) {
#pragma unroll
                    for (int nt = 0; nt < MTV; ++nt) { bf16x8 vT[KA]; RC_VT(vT, nt);
#pragma unroll
                        for (int i = 0; i < 2; ++i) { f32x4 a = accS[i][nt];
                            if (decay) a = a * __builtin_bit_cast(f32x4, DC_(u % PFS, i)); else a = a * cdec;
#pragma unroll
                            for (int ks = 0; ks < KA; ++ks) a = __builtin_amdgcn_mfma_f32_16x16x32_bf16(__builtin_bit_cast(bf16x8, KE_(u % PFS, i, ks)), vT[ks], a, 0, 0, 0);
                            accS[i][nt] = a;
                            *(LAS u32x2*)(sb + nb * SBUF + (16 * nt + fr) * SP + (16 * (mts0 + i) + 4 * fq) * 2) = (u32x2){cvt_pk_bf16(a[0], a[1]), cvt_pk_bf16(a[2], a[3])}; } }
                    if (n + PFS < NCH) RC_LOAD_S(u % PFS, n + PFS);
                }
#undef RC_VT
                if (n + 1 < NCH) RC_STORE_V(nb, (u + 1) % PFV);
                if (n + 1 + PFV - 1 < NCH && PFV > 1) { }
                __syncthreads();
                if (n + 1 + PFV < NCH + 0) RC_LOAD_V((u + 1) % PFV, n + 1 + PFV);
            }
        }
#undef RC_LOAD_O
#undef BA_
#undef BQ_
#undef KE_
#undef DC_
#undef RC_LOAD_S
#undef RC_LOAD_V
#undef RC_STORE_V
    }
    __syncthreads();
}

struct Args { const float* in[22]; float* out; unsigned char* ws; int ph_lo, ph_hi; };
constexpr int NPHASE = 22;

#define PHASE_IDS int tid = threadIdx.x; asm volatile("" : "+v"(tid)); const int lane = tid & 63, wave = __builtin_amdgcn_readfirstlane(tid >> 6), gw = blockIdx.x * NWAVES + wave, gtid = blockIdx.x * NTHREADS + tid; (void)lane; (void)gw; (void)gtid
__global__ void __launch_bounds__(NTHREADS, 2) fwd_kernel(Args args) {
    extern __shared__ __attribute__((aligned(16))) unsigned char lds_raw[];
    Frame F;
    F.lds = (LAS unsigned char*)lds_raw;
    F.tid = threadIdx.x; F.lane = threadIdx.x & 63; F.wave = __builtin_amdgcn_readfirstlane(threadIdx.x >> 6);
    F.G = gridDim.x; F.gw = 0; F.NGW = F.G * NWAVES;
    F.ws = args.ws; F.ctl = (gu32*)(args.ws + WS_CTL); F.out = args.out;
    volatile LAS unsigned* MISC = (volatile LAS unsigned*)(F.lds + LDSCTL_OFF);
    if (threadIdx.x < 64) MISC[threadIdx.x] = 0u;
    __syncthreads();
    const int lo = args.ph_lo, hi = args.ph_hi;
    const bool use_bar = (hi - lo) > 1;
    XcdBarrier bar; bar.bar = (unsigned*)(F.ctl + CW_BAR); bar.x = 0; bar.st = nullptr;
    if (use_bar) bar = xcd_barrier_post((unsigned*)(F.ctl + CW_BAR), MISC + 8);
#ifndef PHMASK
#define PHMASK 0x3fffff
#endif
#define IN(k) (((PHMASK >> (k)) & 1) && lo <= (k) && (k) < hi)
#define SEAM(k) do { if (IN(k) && IN((k) + 1)) xcd_barrier(bar); } while (0)
    unsigned char* const big = F.ws + WS_BIG;
    bf16_t* const XN = (bf16_t*)(F.ws + WS_XN);
    bf16_t* const HC0 = (bf16_t*)(big + B_HCAT0);
    bf16_t* const HC1 = (bf16_t*)(big + B_HCAT1);
    const int NT = F.G * NTHREADS;

    if (IN(0)) { PHASE_IDS;
        LAS float* scr = (LAS float*)(F.lds + wave * 9216);
        LAS bf16_t* wl = (LAS bf16_t*)(F.lds + 73728);
        { const float* wlr = inptr(I_WIN0) + W0_LR;
          for (int c = tid; c < D; c += NTHREADS) { const f32x4* wp = (const f32x4*)(wlr + (size_t)c * LDW0);
#pragma unroll
              for (int q = 0; q < 4; ++q) { const f32x4 w4 = wp[q]; wl[(4 * q) * 1032 + c] = (bf16_t)f2bf(w4.x); wl[(4 * q + 1) * 1032 + c] = (bf16_t)f2bf(w4.y); wl[(4 * q + 2) * 1032 + c] = (bf16_t)f2bf(w4.z); wl[(4 * q + 3) * 1032 + c] = (bf16_t)f2bf(w4.w); } } }
        __syncthreads();
        constexpr int I0 = (D / 64) * (LD0 / 32), I1 = (MIX0 / 64) * (D / 32), I2 = (D / 64) * (2 * FF0 / 32), I3 = (FF0 / 64) * (D / 32), I4 = (D / 64) * (LD1 / 32), I5 = (MIX1 / 64) * (D / 32);
        constexpr int NIT = I0 + I1 + I2 + I3 + I4 + I5;
        for (int it = gw; it < NIT; it += F.NGW) {
            int r = it;
            if (r < I0) { const int nblk = LD0 / 32, kb = r / nblk, nb = r % nblk, dr = 32 * nb; transpose_item(inptr(I_WIN0), LDW0, dr < W0_LR ? dr : dr + 16, (bf16_t*)(F.ws + WS_WIN0), D, dr, 64 * kb, scr, lane); continue; } r -= I0;
            if (r < I1) { transpose_plain(inptr(I_WOUT0), MIX0, D, (bf16_t*)(F.ws + WS_WOUT0), r, scr, lane); continue; } r -= I1;
            if (r < I2) { transpose_gateup(inptr(I_WFG), inptr(I_WFU), D, FF0, (bf16_t*)(F.ws + WS_WGU0), r, scr, lane); continue; } r -= I2;
            if (r < I3) { transpose_plain(inptr(I_WFD), FF0, D, (bf16_t*)(F.ws + WS_WD0), r, scr, lane); continue; } r -= I3;
            if (r < I4) { transpose_plain(inptr(I_WIN1), D, LD1, (bf16_t*)(F.ws + WS_WIN1), r, scr, lane); continue; } r -= I4;
            transpose_plain(inptr(I_WOUT1), MIX1, D, (bf16_t*)(F.ws + WS_WOUT1), r, scr, lane);
        }
        float* lr = (float*)(F.ws + WS_LR);
        const int fr = lane & 15, fq = lane >> 4;
        for (int g = gw; g < T / 16; g += F.NGW) {
#pragma unroll 1
            for (int r = 0; r < 16; ++r) { const int m = 16 * g + r; f32x4 v[4]; rmsnorm_row(inptr(I_X) + (size_t)m * D, inptr(I_MN0), XN + (size_t)m * D, lane, v); }
            asm volatile("s_waitcnt vmcnt(0)" ::: "memory");
            f32x4 acc = (f32x4){0.f, 0.f, 0.f, 0.f};
            const bf16_t* ap = XN + (size_t)(16 * g + fr) * D + 8 * fq;
#pragma unroll 8
            for (int ks = 0; ks < 32; ++ks) { const bf16x8 af = *(const bf16x8*)(ap + 32 * ks); const bf16x8 bfr = *(const LAS bf16x8*)(wl + fr * 1032 + 32 * ks + 8 * fq);
                acc = __builtin_amdgcn_mfma_f32_16x16x32_bf16(af, bfr, acc, 0, 0, 0); }
#pragma unroll
            for (int j = 0; j < 4; ++j) lr[(size_t)(16 * g + 4 * fq + j) * 16 + fr] = acc[j];
        }
    }
    SEAM(0);

    if (IN(1)) { PHASE_IDS;
        pg8::DenseOrder S; S.init(T, LD0, F.G, (int)blockIdx.x); pg8::PlainMap MP; pg8::EpiBf16 E{HC0, LD0};
        pg8::gemm_phase(F.lds, XN, D, (const bf16_t*)(F.ws + WS_WIN0), D, S, MP, E);
    }
    SEAM(1);

    if (IN(2)) { PHASE_IDS;
        {
            const float* lr = (const float*)(F.ws + WS_LR); const float* wgu = inptr(I_WGATEUP); const float* bg = inptr(I_BGATE);
            bf16_t* att = (bf16_t*)(big + B_ATT0); bf16_t* kendT = (bf16_t*)(big + B_KENDT); float* decay = (float*)(F.ws + WS_DECAY);
            LAS bf16_t* qd_s = (LAS bf16_t*)F.lds;
            LAS bf16_t* ki_s = qd_s + 64 * 136;
            LAS float* grp = (LAS float*)(ki_s + 64 * 136);
            const int dk = tid & 127, sg = tid >> 7;
            const int fr = lane & 15, fq = lane >> 4, w = wave;
            for (int unit = blockIdx.x; unit < 2048; unit += F.G) {
                const int h = unit & 3, bn = unit >> 2, t0 = bn * 64;
                const int col = h * 128 + dk;
                float w16[16];
#pragma unroll
                for (int r = 0; r < 16; ++r) w16[r] = wgu[r * 512 + col];
                const float bias = bg[col];
                float cum[16]; float run = 0.f;
#pragma unroll
                for (int i = 0; i < 16; ++i) { const int t = t0 + 16 * sg + i; const f32x4* lp = (const f32x4*)(lr + (size_t)t * 16); float z = bias;
#pragma unroll
                    for (int q = 0; q < 4; ++q) { const f32x4 l4 = lp[q]; z += l4.x * w16[4 * q] + l4.y * w16[4 * q + 1] + l4.z * w16[4 * q + 2] + l4.w * w16[4 * q + 3]; }
                    run += logsigmoid_f(z) * (1.f / 16.f); cum[i] = run; }
                __syncthreads();
                grp[sg * 128 + dk] = run;
                __syncthreads();
                float off = 0.f, total = 0.f;
#pragma unroll
                for (int g = 0; g < 4; ++g) { const float gs = grp[g * 128 + dk]; total += gs; off += (g < sg) ? gs : 0.f; }
                unsigned kep[8];
#pragma unroll
                for (int i = 0; i < 16; ++i) { const int s_ = 16 * sg + i, t = t0 + s_; const float c = off + cum[i];
                    bf16_t* qp = HC0 + (size_t)t * LD0 + C0_QA + col; const float q = bf2f(*qp), k = bf2f(HC0[(size_t)t * LD0 + C0_KA + col]);
                    const unsigned qdb = f2bf(q * __expf(c) * 0.08838834764831845f); *qp = (bf16_t)qdb; qd_s[s_ * 136 + dk] = (bf16_t)qdb;
                    ki_s[s_ * 136 + dk] = (bf16_t)f2bf(k * __expf(-c));
                    const unsigned keb = f2bf(k * __expf(total - c)); if (i & 1) kep[i >> 1] |= keb << 16; else kep[i >> 1] = keb; }
                { u32x4* kp = (u32x4*)(kendT + ((size_t)unit * 128 + dk) * 64 + 16 * sg); kp[0] = (u32x4){kep[0], kep[1], kep[2], kep[3]}; kp[1] = (u32x4){kep[4], kep[5], kep[6], kep[7]}; }
                if (sg == 0) decay[unit * 128 + dk] = __expf(total);
                __syncthreads();
                { const int nt = w & 3;
#pragma unroll
                  for (int i2 = 0; i2 < 2; ++i2) { const int mt = 2 * (w >> 2) + i2; f32x4 a = (f32x4){0.f, 0.f, 0.f, 0.f};
                      if (mt <= nt) {
#pragma unroll
                          for (int ks = 0; ks < 4; ++ks) { const bf16x8 ka = *(const LAS bf16x8*)(ki_s + (16 * mt + fr) * 136 + 32 * ks + 8 * fq), qb = *(const LAS bf16x8*)(qd_s + (16 * nt + fr) * 136 + 32 * ks + 8 * fq);
                              a = __builtin_amdgcn_mfma_f32_16x16x32_bf16(ka, qb, a, 0, 0, 0); }
#pragma unroll
                          for (int j = 0; j < 4; ++j) if (16 * mt + 4 * fq + j > 16 * nt + fr) a[j] = 0.f; }
                      *(u32x2*)(att + (size_t)unit * 4096 + (16 * nt + fr) * 64 + 16 * mt + 4 * fq) = (u32x2){cvt_pk_bf16(a[0], a[1]), cvt_pk_bf16(a[2], a[3])}; } }
            }
            __syncthreads();
        }
    }
    SEAM(2);

#if NAIVE_RECUR & 1
    if (IN(3)) { PHASE_IDS;
        const bf16_t* att = (const bf16_t*)(big + B_ATT0); const bf16_t* kendT = (const bf16_t*)(big + B_KENDT); const float* decay = (const float*)(F.ws + WS_DECAY);
        LAS float* att_s = (LAS float*)F.lds;
        LAS float* qd_s = att_s + 64 * 65;
        LAS float* ke_s = qd_s + 64 * 129;
        LAS float* v_s = ke_s + 128 * 65;
        LAS float* S_s = v_s + 64 * 16;
        LAS float* dc_s = S_s + 128 * 16;
        for (int item = blockIdx.x; item < 256; item += F.G) {
            const int sl = item & 15, h = (item >> 4) & 3, b = item >> 6;
            for (int i = tid; i < 128 * 16; i += NTHREADS) S_s[i] = 0.f;
            __syncthreads();
            for (int n = 0; n < 128; ++n) {
                const int unit = (b * 128 + n) * 4 + h, t0 = b * SEQ + n * 64;
                { const u32x4 raw = *(const u32x4*)(att + (size_t)unit * 4096 + tid * 8); const int s = tid >> 3, c0 = (tid & 7) * 8; LAS float* d = att_s + s * 65 + c0;
                  d[0] = __uint_as_float(raw.x << 16); d[1] = __uint_as_float(raw.x & 0xffff0000u); d[2] = __uint_as_float(raw.y << 16); d[3] = __uint_as_float(raw.y & 0xffff0000u);
                  d[4] = __uint_as_float(raw.z << 16); d[5] = __uint_as_float(raw.z & 0xffff0000u); d[6] = __uint_as_float(raw.w << 16); d[7] = __uint_as_float(raw.w & 0xffff0000u); }
#pragma unroll
                for (int rep = 0; rep < 2; ++rep) { const int ch = tid + 512 * rep;
                    { const int s = ch >> 4, c0 = (ch & 15) * 8; const u32x4 raw = *(const u32x4*)(HC0 + (size_t)(t0 + s) * LD0 + C0_QA + h * 128 + c0); LAS float* d = qd_s + s * 129 + c0;
                      d[0] = __uint_as_float(raw.x << 16); d[1] = __uint_as_float(raw.x & 0xffff0000u); d[2] = __uint_as_float(raw.y << 16); d[3] = __uint_as_float(raw.y & 0xffff0000u);
                      d[4] = __uint_as_float(raw.z << 16); d[5] = __uint_as_float(raw.z & 0xffff0000u); d[6] = __uint_as_float(raw.w << 16); d[7] = __uint_as_float(raw.w & 0xffff0000u); }
                    { const int dk = ch >> 3, c0 = (ch & 7) * 8; const u32x4 raw = *(const u32x4*)(kendT + ((size_t)unit * 128 + dk) * 64 + c0); LAS float* d = ke_s + dk * 65 + c0;
                      d[0] = __uint_as_float(raw.x << 16); d[1] = __uint_as_float(raw.x & 0xffff0000u); d[2] = __uint_as_float(raw.y << 16); d[3] = __uint_as_float(raw.y & 0xffff0000u);
                      d[4] = __uint_as_float(raw.z << 16); d[5] = __uint_as_float(raw.z & 0xffff0000u); d[6] = __uint_as_float(raw.w << 16); d[7] = __uint_as_float(raw.w & 0xffff0000u); } }
                if (tid < 128) { const int s = tid >> 1, c0 = (tid & 1) * 8; const u32x4 raw = *(const u32x4*)(HC0 + (size_t)(t0 + s) * LD0 + C0_VA + h * 256 + sl * 16 + c0); LAS float* d = v_s + s * 16 + c0;
                    d[0] = __uint_as_float(raw.x << 16); d[1] = __uint_as_float(raw.x & 0xffff0000u); d[2] = __uint_as_float(raw.y << 16); d[3] = __uint_as_float(raw.y & 0xffff0000u);
                    d[4] = __uint_as_float(raw.z << 16); d[5] = __uint_as_float(raw.z & 0xffff0000u); d[6] = __uint_as_float(raw.w << 16); d[7] = __uint_as_float(raw.w & 0xffff0000u); }
                else if (tid < 256) dc_s[tid - 128] = decay[unit * 128 + tid - 128];
                __syncthreads();
                { const int s = tid >> 3, dv = (tid & 7) * 2; float o0 = 0.f, o1 = 0.f;
                  for (int j = 0; j < 64; ++j) { const float a = att_s[s * 65 + j]; o0 += a * v_s[j * 16 + dv]; o1 += a * v_s[j * 16 + dv + 1]; }
                  for (int d = 0; d < 128; ++d) { const float q = qd_s[s * 129 + d]; o0 += q * S_s[d * 16 + dv]; o1 += q * S_s[d * 16 + dv + 1]; }
                  *(unsigned*)(HC0 + (size_t)(t0 + s) * LD0 + C0_VA + h * 256 + sl * 16 + dv) = pk2(o0, o1); }
                __syncthreads();
                { const int dk = tid >> 2, dv = (tid & 3) * 4; const float dc = dc_s[dk]; float a0 = S_s[dk * 16 + dv] * dc, a1 = S_s[dk * 16 + dv + 1] * dc, a2 = S_s[dk * 16 + dv + 2] * dc, a3 = S_s[dk * 16 + dv + 3] * dc;
                  for (int s = 0; s < 64; ++s) { const float k = ke_s[dk * 65 + s]; a0 += k * v_s[s * 16 + dv]; a1 += k * v_s[s * 16 + dv + 1]; a2 += k * v_s[s * 16 + dv + 2]; a3 += k * v_s[s * 16 + dv + 3]; }
                  S_s[dk * 16 + dv] = a0; S_s[dk * 16 + dv + 1] = a1; S_s[dk * 16 + dv + 2] = a2; S_s[dk * 16 + dv + 3] = a3; }
                __syncthreads();
            }
        }
    }
#else
    if (IN(3)) recur_phase<64, 128, 16, true, LD0, C0_QA, C0_VA, 256, 128, 4, 4, 4>(F, HC0, (const bf16_t*)(big + B_ATT0), (const bf16_t*)(big + B_KENDT), (const float*)(F.ws + WS_DECAY));
#endif
    SEAM(3);

    if (IN(4)) dilated_phase(F, HC0, (bf16_t*)(F.ws + WS_XN), (bf16_t*)(big + B_OP2), (float*)(F.ws + WS_LSE));
    SEAM(4);

    if (IN(5)) { PHASE_IDS;
        const float* gn = inptr(I_GLANORM); const float* lse = (const float*)(F.ws + WS_LSE);
        float gw16[16];
#pragma unroll
        for (int e = 0; e < 16; ++e) gw16[e] = gn[(16 * lane + e) & 255];
        for (int t = gw; t < T; t += F.NGW) {
            bf16_t* row = HC0 + (size_t)t * LD0;
            { const u32x4* op = (const u32x4*)(row + C0_VA + 16 * lane); u32x4* rp = (u32x4*)(row + C0_RA + 16 * lane); float o[16], g[16];
#pragma unroll
              for (int c = 0; c < 2; ++c) { const u32x4 a = op[c], r4 = rp[c];
                  o[8 * c] = __uint_as_float(a.x << 16); o[8 * c + 1] = __uint_as_float(a.x & 0xffff0000u); o[8 * c + 2] = __uint_as_float(a.y << 16); o[8 * c + 3] = __uint_as_float(a.y & 0xffff0000u);
                  o[8 * c + 4] = __uint_as_float(a.z << 16); o[8 * c + 5] = __uint_as_float(a.z & 0xffff0000u); o[8 * c + 6] = __uint_as_float(a.w << 16); o[8 * c + 7] = __uint_as_float(a.w & 0xffff0000u);
                  g[8 * c] = __uint_as_float(r4.x << 16); g[8 * c + 1] = __uint_as_float(r4.x & 0xffff0000u); g[8 * c + 2] = __uint_as_float(r4.y << 16); g[8 * c + 3] = __uint_as_float(r4.y & 0xffff0000u);
                  g[8 * c + 4] = __uint_as_float(r4.z << 16); g[8 * c + 5] = __uint_as_float(r4.z & 0xffff0000u); g[8 * c + 6] = __uint_as_float(r4.w << 16); g[8 * c + 7] = __uint_as_float(r4.w & 0xffff0000u); }
              float ss = 0.f;
#pragma unroll
              for (int e = 0; e < 16; ++e) ss += o[e] * o[e];
              ss += __shfl_xor(ss, 1); ss += __shfl_xor(ss, 2); ss += __shfl_xor(ss, 4); ss += __shfl_xor(ss, 8);
              const float rs = 1.f / sqrtf(ss * (1.f / 256.f) + NORM_EPS);
#pragma unroll
              for (int e = 0; e < 16; ++e) o[e] = o[e] * rs * gw16[e] * silu_f(g[e]);
#pragma unroll
              for (int c = 0; c < 2; ++c) rp[c] = (u32x4){pk2(o[8 * c], o[8 * c + 1]), pk2(o[8 * c + 2], o[8 * c + 3]), pk2(o[8 * c + 4], o[8 * c + 5]), pk2(o[8 * c + 6], o[8 * c + 7])}; }
            { const int hh = lane >> 3; const float l0 = lse[((size_t)0 * T + t) * 8 + hh], l1 = lse[((size_t)1 * T + t) * 8 + hh], l2 = lse[((size_t)2 * T + t) * 8 + hh];
              const float mx = fmaxf(l0, fmaxf(l1, l2)); float w0 = __expf(l0 - mx), w1 = __expf(l1 - mx), w2 = __expf(l2 - mx); const float iw = 1.f / (w0 + w1 + w2); w0 *= iw; w1 *= iw; w2 *= iw;
              const u32x4 a = *(const u32x4*)((const bf16_t*)(F.ws + WS_XN) + (size_t)t * 512 + 8 * lane), bq = *(const u32x4*)((const bf16_t*)(F.ws + WS_XN) + (size_t)(T + t) * 512 + 8 * lane), c = *(const u32x4*)((const bf16_t*)(big + B_OP2) + (size_t)t * 512 + 8 * lane);
              float r[8];
              r[0] = w0 * __uint_as_float(a.x << 16) + w1 * __uint_as_float(bq.x << 16) + w2 * __uint_as_float(c.x << 16); r[1] = w0 * __uint_as_float(a.x & 0xffff0000u) + w1 * __uint_as_float(bq.x & 0xffff0000u) + w2 * __uint_as_float(c.x & 0xffff0000u);
              r[2] = w0 * __uint_as_float(a.y << 16) + w1 * __uint_as_float(bq.y << 16) + w2 * __uint_as_float(c.y << 16); r[3] = w0 * __uint_as_float(a.y & 0xffff0000u) + w1 * __uint_as_float(bq.y & 0xffff0000u) + w2 * __uint_as_float(c.y & 0xffff0000u);
              r[4] = w0 * __uint_as_float(a.z << 16) + w1 * __uint_as_float(bq.z << 16) + w2 * __uint_as_float(c.z << 16); r[5] = w0 * __uint_as_float(a.z & 0xffff0000u) + w1 * __uint_as_float(bq.z & 0xffff0000u) + w2 * __uint_as_float(c.z & 0xffff0000u);
              r[6] = w0 * __uint_as_float(a.w << 16) + w1 * __uint_as_float(bq.w << 16) + w2 * __uint_as_float(c.w << 16); r[7] = w0 * __uint_as_float(a.w & 0xffff0000u) + w1 * __uint_as_float(bq.w & 0xffff0000u) + w2 * __uint_as_float(c.w & 0xffff0000u);
              *(u32x4*)(row + C0_QB + 8 * lane) = (u32x4){pk2(r[0], r[1]), pk2(r[2], r[3]), pk2(r[4], r[5]), pk2(r[6], r[7])}; }
        }
    }
    SEAM(5);

    if (IN(6)) { PHASE_IDS;
        pg8::DenseOrder S; S.init(T, D, F.G, (int)blockIdx.x); pg8::PlainMap MP; pg8::EpiResF32 E{inptr(I_X), F.out, D};
        pg8::gemm_phase(F.lds, HC0 + C0_RA, LD0, (const bf16_t*)(F.ws + WS_WOUT0), MIX0, S, MP, E);
    }
    SEAM(6);

    if (IN(7)) { PHASE_IDS; for (int m = gw; m < T; m += F.NGW) { f32x4 v[4]; rmsnorm_row(F.out + (size_t)m * D, inptr(I_FN0), XN + (size_t)m * D, lane, v); } }
    SEAM(7);

    if (IN(8)) { PHASE_IDS;
        pg8::DenseOrder S; S.init(T, 2 * FF0, F.G, (int)blockIdx.x); pg8::PlainMap MP; pg8::EpiSwiGLU E{(bf16_t*)(big + B_H0), FF0};
        pg8::gemm_phase(F.lds, XN, D, (const bf16_t*)(F.ws + WS_WGU0), D, S, MP, E);
    }
    SEAM(8);

    if (IN(9)) { PHASE_IDS;
        pg8::DenseOrder S; S.init(T, D, F.G, (int)blockIdx.x); pg8::PlainMap MP; pg8::EpiResF32 E{F.out, F.out, D};
        pg8::gemm_phase(F.lds, (const bf16_t*)(big + B_H0), FF0, (const bf16_t*)(F.ws + WS_WD0), FF0, S, MP, E);
    }
    SEAM(9);

    if (IN(10)) { PHASE_IDS; for (int m = gw; m < T; m += F.NGW) { f32x4 v[4]; rmsnorm_row(F.out + (size_t)m * D, inptr(I_MN1), XN + (size_t)m * D, lane, v); } }
    SEAM(10);

    if (IN(11)) { PHASE_IDS;
        pg8::DenseOrder S; S.init(T, LD1, F.G, (int)blockIdx.x); pg8::PlainMap MP; pg8::EpiBf16 E{HC1, LD1};
        pg8::gemm_phase(F.lds, XN, D, (const bf16_t*)(F.ws + WS_WIN1), D, S, MP, E);
    }
    SEAM(11);

    if (IN(12)) { PHASE_IDS;
        bf16_t* att = (bf16_t*)(big + B_ATT1); bf16_t* kdT = (bf16_t*)(F.ws + WS_XN);
        LAS bf16_t* qd_s = (LAS bf16_t*)F.lds;
        LAS bf16_t* ki_s = qd_s + 128 * 264;
        const int dk = tid & 255, sg = tid >> 8;
        const int fr = lane & 15, fq = lane >> 4, w = wave;
        for (int unit = blockIdx.x; unit < 1024; unit += F.G) {
            const int h = unit & 3, bn = unit >> 2, t0 = bn * 128;
            const float lg = log1pf(-exp2f(-5.f - (float)h));
            __syncthreads();
#pragma unroll 1
            for (int i8 = 0; i8 < 8; ++i8) {
                unsigned kp[4];
#pragma unroll
                for (int i = 0; i < 8; ++i) { const int s_ = 64 * sg + 8 * i8 + i, t = t0 + s_;
                    bf16_t* qp = HC1 + (size_t)t * LD1 + C1_Q + h * 256 + dk; const float q = bf2f(*qp), k = bf2f(HC1[(size_t)t * LD1 + C1_K + h * 256 + dk]);
                    const unsigned qdb = f2bf(q * __expf(lg * (float)(s_ + 1))); *qp = (bf16_t)qdb; qd_s[s_ * 264 + dk] = (bf16_t)qdb;
                    ki_s[s_ * 264 + dk] = (bf16_t)f2bf(k * __expf(-lg * (float)(s_ + 1)));
                    const unsigned kdb = f2bf(k * __expf(lg * (float)(127 - s_)) * 0.0625f); if (i & 1) kp[i >> 1] |= kdb << 16; else kp[i >> 1] = kdb; }
                *(u32x4*)(kdT + ((size_t)unit * 256 + dk) * 128 + 64 * sg + 8 * i8) = (u32x4){kp[0], kp[1], kp[2], kp[3]};
            }
            __syncthreads();
#pragma unroll 1
            for (int L = w; L < 36; L += 8) { int nt = 0; while ((nt + 1) * (nt + 2) / 2 <= L) ++nt; const int mt = L - nt * (nt + 1) / 2;
                f32x4 a = (f32x4){0.f, 0.f, 0.f, 0.f};
#pragma unroll
                for (int ks = 0; ks < 8; ++ks) { const bf16x8 ka = *(const LAS bf16x8*)(ki_s + (16 * mt + fr) * 264 + 32 * ks + 8 * fq), qb = *(const LAS bf16x8*)(qd_s + (16 * nt + fr) * 264 + 32 * ks + 8 * fq);
                    a = __builtin_amdgcn_mfma_f32_16x16x32_bf16(ka, qb, a, 0, 0, 0); }
#pragma unroll
                for (int j = 0; j < 4; ++j) a[j] = (16 * mt + 4 * fq + j > 16 * nt + fr) ? 0.f : a[j] * 0.0625f;
                *(u32x2*)(att + (size_t)unit * 16384 + (16 * nt + fr) * 128 + 16 * mt + 4 * fq) = (u32x2){cvt_pk_bf16(a[0], a[1]), cvt_pk_bf16(a[2], a[3])}; }
            if (w < 4) *(u32x2*)(att + (size_t)unit * 16384 + (32 * w + fr) * 128 + 16 * (2 * w + 1) + 4 * fq) = (u32x2){0u, 0u};
        }
        __syncthreads();
    }
    SEAM(12);

#if NAIVE_RECUR & 2
    if (IN(13)) { PHASE_IDS;
        const bf16_t* att = (const bf16_t*)(big + B_ATT1); const bf16_t* kdT = (const bf16_t*)(F.ws + WS_XN);
        LAS float* v_s = (LAS float*)F.lds;
        LAS float* S_s = v_s + 128 * 32;
        for (int item = blockIdx.x; item < 256; item += F.G) {
            const int sl = item & 15, h = (item >> 4) & 3, b = item >> 6;
            const float cdec = __expf(128.f * log1pf(-exp2f(-5.f - (float)h)));
            for (int i = tid; i < 256 * 33; i += NTHREADS) S_s[i] = 0.f;
            __syncthreads();
            for (int n = 0; n < 64; ++n) {
                const int unit = (b * 64 + n) * 4 + h, t0 = b * SEQ + n * 128;
                { const int s = tid >> 2, c0 = (tid & 3) * 8; const u32x4 raw = *(const u32x4*)(HC1 + (size_t)(t0 + s) * LD1 + C1_V + h * 512 + sl * 32 + c0); LAS float* d = v_s + s * 32 + c0;
                  d[0] = __uint_as_float(raw.x << 16); d[1] = __uint_as_float(raw.x & 0xffff0000u); d[2] = __uint_as_float(raw.y << 16); d[3] = __uint_as_float(raw.y & 0xffff0000u);
                  d[4] = __uint_as_float(raw.z << 16); d[5] = __uint_as_float(raw.z & 0xffff0000u); d[6] = __uint_as_float(raw.w << 16); d[7] = __uint_as_float(raw.w & 0xffff0000u); }
                __syncthreads();
                { const int s = tid >> 2, dv0 = (tid & 3) * 8; float o[8];
#pragma unroll
                  for (int e = 0; e < 8; ++e) o[e] = 0.f;
                  const bf16_t* ap = att + (size_t)unit * 16384 + s * 128;
                  for (int j = 0; j <= s; ++j) { const float a = bf2f(ap[j]);
#pragma unroll
                      for (int e = 0; e < 8; ++e) o[e] += a * v_s[j * 32 + dv0 + e]; }
                  const bf16_t* qp = HC1 + (size_t)(t0 + s) * LD1 + C1_Q + h * 256;
                  for (int d = 0; d < 256; ++d) { const float q = bf2f(qp[d]);
#pragma unroll
                      for (int e = 0; e < 8; ++e) o[e] += q * S_s[d * 33 + dv0 + e]; }
                  *(u32x4*)(HC1 + (size_t)(t0 + s) * LD1 + C1_V + h * 512 + sl * 32 + dv0) = (u32x4){pk2(o[0], o[1]), pk2(o[2], o[3]), pk2(o[4], o[5]), pk2(o[6], o[7])}; }
                __syncthreads();
                { const int dk = tid >> 1, dv0 = (tid & 1) * 16; float a[16];
#pragma unroll
                  for (int e = 0; e < 16; ++e) a[e] = S_s[dk * 33 + dv0 + e] * cdec;
                  const bf16_t* kp = kdT + ((size_t)unit * 256 + dk) * 128;
                  for (int s = 0; s < 128; ++s) { const float k = bf2f(kp[s]);
#pragma unroll
                      for (int e = 0; e < 16; ++e) a[e] += k * v_s[s * 32 + dv0 + e]; }
#pragma unroll
                  for (int e = 0; e < 16; ++e) S_s[dk * 33 + dv0 + e] = a[e]; }
                __syncthreads();
            }
        }
    }
#else
    if (IN(13)) recur_phase<128, 256, 32, false, LD1, C1_Q, C1_V, 512, 64, 2, 1, 2>(F, HC1, (const bf16_t*)(big + B_ATT1), (const bf16_t*)(F.ws + WS_XN), nullptr);
#endif
    SEAM(13);

    if (IN(14)) { PHASE_IDS;
        const float* gnw = inptr(I_RETGN);
        for (int t = gw; t < T; t += F.NGW) {
            bf16_t* row = HC1 + (size_t)t * LD1; const u32x4* op = (const u32x4*)(row + C1_V + 32 * lane); u32x4* gp = (u32x4*)(row + C1_G + 32 * lane);
            float o[32]; float s = 0.f;
#pragma unroll
            for (int c = 0; c < 4; ++c) { const u32x4 a = op[c];
                o[8 * c] = __uint_as_float(a.x << 16); o[8 * c + 1] = __uint_as_float(a.x & 0xffff0000u); o[8 * c + 2] = __uint_as_float(a.y << 16); o[8 * c + 3] = __uint_as_float(a.y & 0xffff0000u);
                o[8 * c + 4] = __uint_as_float(a.z << 16); o[8 * c + 5] = __uint_as_float(a.z & 0xffff0000u); o[8 * c + 6] = __uint_as_float(a.w << 16); o[8 * c + 7] = __uint_as_float(a.w & 0xffff0000u); }
#pragma unroll
            for (int e = 0; e < 32; ++e) s += o[e];
            s += __shfl_xor(s, 1); s += __shfl_xor(s, 2); s += __shfl_xor(s, 4); s += __shfl_xor(s, 8);
            const float mu = s * (1.f / 512.f); float q = 0.f;
#pragma unroll
            for (int e = 0; e < 32; ++e) { o[e] -= mu; q += o[e] * o[e]; }
            q += __shfl_xor(q, 1); q += __shfl_xor(q, 2); q += __shfl_xor(q, 4); q += __shfl_xor(q, 8);
            const float rs = 1.f / sqrtf(q * (1.f / 512.f) + GN_EPS);
#pragma unroll
            for (int c = 0; c < 4; ++c) { const u32x4 g4 = gp[c]; const f32x4 w0 = *(const f32x4*)(gnw + 32 * lane + 8 * c), w1 = *(const f32x4*)(gnw + 32 * lane + 8 * c + 4);
                const float g0 = __uint_as_float(g4.x << 16), g1 = __uint_as_float(g4.x & 0xffff0000u), g2 = __uint_as_float(g4.y << 16), g3 = __uint_as_float(g4.y & 0xffff0000u);
                const float g4_ = __uint_as_float(g4.z << 16), g5 = __uint_as_float(g4.z & 0xffff0000u), g6 = __uint_as_float(g4.w << 16), g7 = __uint_as_float(g4.w & 0xffff0000u);
                gp[c] = (u32x4){pk2(o[8 * c] * rs * w0.x * silu_f(g0), o[8 * c + 1] * rs * w0.y * silu_f(g1)), pk2(o[8 * c + 2] * rs * w0.z * silu_f(g2), o[8 * c + 3] * rs * w0.w * silu_f(g3)),
                                pk2(o[8 * c + 4] * rs * w1.x * silu_f(g4_), o[8 * c + 5] * rs * w1.y * silu_f(g5)), pk2(o[8 * c + 6] * rs * w1.z * silu_f(g6), o[8 * c + 7] * rs * w1.w * silu_f(g7))}; }
        }
    }
    SEAM(14);

    if (IN(15)) { PHASE_IDS;
        pg8::DenseOrder S; S.init(T, D, F.G, (int)blockIdx.x); pg8::PlainMap MP; pg8::EpiResF32 E{F.out, F.out, D};
        pg8::gemm_phase(F.lds, HC1 + C1_G, LD1, (const bf16_t*)(F.ws + WS_WOUT1), MIX1, S, MP, E);
    }
    SEAM(15);

    if (IN(16)) { PHASE_IDS;
        LAS float* scr = (LAS float*)(F.lds + wave * 16384);
        constexpr int IGU = (D / 64) * (2 * FFE / 32), IDN = (FFE / 64) * (D / 32);
        for (int it = gw; it < NEXP * (IGU + IDN); it += F.NGW) {
            const int e = it / (IGU + IDN), r = it % (IGU + IDN);
            if (r < IGU) transpose_gateup(inptr(I_WEG) + (size_t)e * D * FFE, inptr(I_WEU) + (size_t)e * D * FFE, D, FFE, (bf16_t*)(big + B_WEGU) + (size_t)e * 2 * FFE * D, r, scr, lane);
            else transpose_plain(inptr(I_WED) + (size_t)e * FFE * D, FFE, D, (bf16_t*)(big + B_WED) + (size_t)e * D * FFE, r - IGU, scr, lane);
        }
        int* rowtok = (int*)(F.ws + WS_ROUTE + R_ROWTOK); float* rowgate = (float*)(F.ws + WS_ROUTE + R_ROWGATE);
        for (int i = gtid; i < 2 * MOE_ROWS; i += NT) { rowtok[i] = -1; rowgate[i] = 0.f; }
        f32x4* tokinfo = (f32x4*)(F.ws + WS_ROUTE + R_TOKINFO);
        const float* wr_ = inptr(I_WROUTER);
        for (int m = gw; m < T; m += F.NGW) {
            f32x4 v[4]; rmsnorm_row(F.out + (size_t)m * D, inptr(I_FN1), XN + (size_t)m * D, lane, v);
            float a[8];
#pragma unroll
            for (int r = 0; r < 8; ++r) a[r] = 0.f;
#pragma unroll
            for (int j = 0; j < 4; ++j)
#pragma unroll
                for (int e = 0; e < 4; ++e) { const int c = 256 * j + 4 * lane + e; const f32x4* wp = (const f32x4*)(wr_ + (size_t)c * 8); const float xv = v[j][e]; const f32x4 w0 = wp[0], w1 = wp[1];
                    a[0] += xv * w0.x; a[1] += xv * w0.y; a[2] += xv * w0.z; a[3] += xv * w0.w; a[4] += xv * w1.x; a[5] += xv * w1.y; a[6] += xv * w1.z; a[7] += xv * w1.w; }
#pragma unroll
            for (int r = 0; r < 8; ++r) a[r] = wave_sum(a[r]);
            int e0 = 0; float l0 = a[0];
#pragma unroll
            for (int r = 1; r < 8; ++r) if (a[r] > l0) { l0 = a[r]; e0 = r; }
            int e1 = -1; float l1 = -3.4e38f;
#pragma unroll
            for (int r = 0; r < 8; ++r) if (r != e0 && a[r] > l1) { l1 = a[r]; e1 = r; }
            const float g0 = 1.f / (1.f + __expf(l1 - l0));
            if (lane == 0) { const unsigned r0 = __hip_atomic_fetch_add((unsigned*)(F.ctl + CW_MOE + 64 * e0), 1u, __ATOMIC_RELAXED, __HIP_MEMORY_SCOPE_AGENT);
                const unsigned r1 = __hip_atomic_fetch_add((unsigned*)(F.ctl + CW_MOE + 64 * (8 + e1)), 1u, __ATOMIC_RELAXED, __HIP_MEMORY_SCOPE_AGENT);
                tokinfo[m] = (f32x4){__int_as_float(e0 | (e1 << 4)), __uint_as_float(r0), __uint_as_float(r1), g0}; }
        }
    }
    SEAM(16);

    if (IN(17)) { PHASE_IDS;
        const f32x4* tokinfo = (const f32x4*)(F.ws + WS_ROUTE + R_TOKINFO);
        int* rowtok = (int*)(F.ws + WS_ROUTE + R_ROWTOK); float* rowgate = (float*)(F.ws + WS_ROUTE + R_ROWGATE);
        int* blkexp = (int*)(F.ws + WS_ROUTE + R_BLKEXP); int* nblk = (int*)(F.ws + WS_ROUTE + R_NBLK);
        LAS int* pst = (LAS int*)F.lds;
        if (tid < 2) { int ps = 0, nb = 0;
            for (int e = 0; e < 8; ++e) { pst[tid * 8 + e] = ps; const int c = (int)__hip_atomic_load((unsigned*)(F.ctl + CW_MOE + 64 * (tid * 8 + e)), __ATOMIC_RELAXED, __HIP_MEMORY_SCOPE_AGENT), bl = (c + 255) >> 8;
                if (blockIdx.x == 0) for (int j = 0; j < bl; ++j) blkexp[tid * MOE_BLKS + nb + j] = e;
                nb += bl; ps += bl * 256; }
            if (blockIdx.x == 0) nblk[tid] = nb; }
        __syncthreads();
        for (int tok = gtid; tok < T; tok += NT) { const f32x4 ti = tokinfo[tok]; const int ee = __float_as_int(ti.x), e0 = ee & 15, e1 = ee >> 4;
            const int r0 = pst[e0] + (int)__float_as_uint(ti.y), r1 = pst[8 + e1] + (int)__float_as_uint(ti.z);
            rowtok[r0] = tok; rowgate[r0] = ti.w; rowtok[MOE_ROWS + r1] = tok; rowgate[MOE_ROWS + r1] = 1.f - ti.w; }
        __syncthreads();
    }
    SEAM(17);

#pragma unroll
    for (int slot = 0; slot < 2; ++slot) {
        if (IN(18 + 2 * slot)) { PHASE_IDS;
            const int* rowtok = (const int*)(F.ws + WS_ROUTE + R_ROWTOK) + slot * MOE_ROWS; const int* blkexp = (const int*)(F.ws + WS_ROUTE + R_BLKEXP) + slot * MOE_BLKS;
            const int nb = ((const int*)(F.ws + WS_ROUTE + R_NBLK))[slot];
            MoeOrder S; S.init(nb, 2 * FFE / 256, F.G, (int)blockIdx.x); pg8::MoeMap MP{rowtok, blkexp, 2 * FFE}; pg8::EpiSwiGLU E{(bf16_t*)(big + B_HMOE), FFE};
            pg8::gemm_phase(F.lds, XN, D, (const bf16_t*)(big + B_WEGU), D, S, MP, E);
        }
        SEAM(18 + 2 * slot);
        if (IN(19 + 2 * slot)) { PHASE_IDS;
            const int* rowtok = (const int*)(F.ws + WS_ROUTE + R_ROWTOK) + slot * MOE_ROWS; const float* rowgate = (const float*)(F.ws + WS_ROUTE + R_ROWGATE) + slot * MOE_ROWS;
            const int* blkexp = (const int*)(F.ws + WS_ROUTE + R_BLKEXP) + slot * MOE_BLKS; const int nb = ((const int*)(F.ws + WS_ROUTE + R_NBLK))[slot];
            MoeOrder S; S.init(nb, D / 256, F.G, (int)blockIdx.x); pg8::MoeMap MP{nullptr, blkexp, D}; pg8::EpiMoeDown E{F.out, rowtok, rowgate};
            pg8::gemm_phase(F.lds, (const bf16_t*)(big + B_HMOE), FFE, (const bf16_t*)(big + B_WED), FFE, S, MP, E);
        }
        if (slot == 0) SEAM(19);
    }
#undef IN
#undef SEAM
}

#ifndef N_LAUNCH_MODE
#define N_LAUNCH_MODE 1
#endif
extern "C" void kernel_launch(void* const* d_in, const int* in_sizes, int n_in, void* d_out, int out_size, void* d_ws, size_t ws_size, hipStream_t stream) {
    static int grid = 0;
    if (grid == 0) {
        if (n_in != 22 || out_size != T * D || ws_size < WS_END) { fprintf(stderr, "kernel_launch: unexpected shapes (n_in %d out %d ws %zu need %zu)\n", n_in, out_size, ws_size, (size_t)WS_END); grid = -1; return; }
        int dev = 0, cus = 0, per_cu = 0;
        if (hipGetDevice(&dev) != hipSuccess || hipDeviceGetAttribute(&cus, hipDeviceAttributeMultiprocessorCount, dev) != hipSuccess) { grid = -1; return; }
        if (hipFuncSetAttribute((const void*)fwd_kernel, hipFuncAttributeMaxDynamicSharedMemorySize, LDS_BYTES) != hipSuccess) { fprintf(stderr, "kernel_launch: hipFuncSetAttribute failed\n"); grid = -1; return; }
        if (hipOccupancyMaxActiveBlocksPerMultiprocessor(&per_cu, (const void*)fwd_kernel, NTHREADS, LDS_BYTES) != hipSuccess || per_cu < 1) { fprintf(stderr, "kernel_launch: occupancy query says %d\n", per_cu); (void)hipGetLastError(); grid = -1; return; }
        grid = cus;
    }
    if (grid < 0) return;
    (void)hipMemsetAsync((char*)d_ws + WS_CTL, 0, CTL_ZERO_BYTES, stream);
    Args a{};
    for (int i = 0; i < 22; ++i) a.in[i] = (const float*)d_in[i];
    a.out = (float*)d_out; a.ws = (unsigned char*)d_ws;
#if N_LAUNCH_MODE == 1
    a.ph_lo = 0; a.ph_hi = NPHASE;
    hipLaunchKernelGGL(fwd_kernel, dim3(grid), dim3(NTHREADS), LDS_BYTES, stream, a);
#else
    for (int p = 0; p < NPHASE; ++p) { a.ph_lo = p; a.ph_hi = p + 1; hipLaunchKernelGGL(fwd_kernel, dim3(grid), dim3(NTHREADS), LDS_BYTES, stream, a); }
#endif
}
```

```cpp
#include <hip/hip_runtime.h>
#include <cstdio>
#include <cstdint>

#define LAS __attribute__((address_space(3)))
#define GAS __attribute__((address_space(1)))
typedef unsigned short bf16_t;
typedef short bf16x8 __attribute__((ext_vector_type(8)));
typedef float f32x4 __attribute__((ext_vector_type(4)));
typedef float f32x2 __attribute__((ext_vector_type(2)));
typedef unsigned u32x4 __attribute__((ext_vector_type(4)));
typedef unsigned u32x2 __attribute__((ext_vector_type(2)));
typedef GAS unsigned gu32;
#define RLX_AGENT __ATOMIC_RELAXED, __HIP_MEMORY_SCOPE_AGENT
#define LDS_WAIT() asm volatile("s_waitcnt lgkmcnt(0)" ::: "memory")
#define VM_WAIT() asm volatile("s_waitcnt vmcnt(0)" ::: "memory")

constexpr int NBATCH = 4, SEQ = 8192, T = NBATCH * SEQ, D = 1024;
constexpr float NORM_EPS = 1e-6f, GN_EPS = 1e-5f;
constexpr int LDW0 = 4624, LD0 = 4608;
constexpr int C0_QA = 0, C0_KA = 512, C0_VA = 1024, C0_RA = 2048, C0_QB = 3072, C0_KB = 3584, C0_VB = 4096;
constexpr int W0_LR = 3072;
constexpr int MIX0 = 1536, FF0 = 2816;
constexpr int LD1 = 6144, C1_Q = 0, C1_K = 1024, C1_V = 2048, C1_G = 4096, MIX1 = 2048;
constexpr int NEXP = 8, FFE = 3584;
constexpr int MOE_ROWS = 34816, MOE_BLKS = 136;

constexpr size_t MiB = 1u << 20;
constexpr size_t WS_CTL = 0, CTL_ZERO_BYTES = 1 * MiB;
constexpr size_t WS_WIN0 = 1 * MiB, WS_WOUT0 = 10 * MiB, WS_WGU0 = 13 * MiB, WS_WD0 = 24 * MiB, WS_WIN1 = 30 * MiB, WS_WOUT1 = 42 * MiB;
constexpr size_t WS_LR = 46 * MiB, WS_DECAY = 48 * MiB, WS_LSE = 49 * MiB, WS_ROUTE = 52 * MiB;
constexpr size_t WS_XN = 56 * MiB;
constexpr size_t WS_BIG = 120 * MiB;
constexpr size_t B_HCAT0 = 0, B_ATT0 = 288 * MiB, B_KENDT = 304 * MiB, B_OP2 = 336 * MiB;
constexpr size_t B_H0 = 0;
constexpr size_t B_HCAT1 = 0, B_ATT1 = 384 * MiB;
constexpr size_t B_WEGU = 0, B_WED = 112 * MiB, B_HMOE = 168 * MiB;
constexpr size_t WS_END = WS_BIG + 416 * MiB;
constexpr size_t R_TOKINFO = 0, R_ROWTOK = 512 * 1024, R_ROWGATE = R_ROWTOK + 2 * MOE_ROWS * 4, R_BLKEXP = R_ROWGATE + 2 * MOE_ROWS * 4, R_NBLK = R_BLKEXP + 2 * MOE_BLKS * 4;
constexpr int CW_TMO = 0, CW_CODE = 1, CW_BAR = 4096, CW_MOE = 8192;

constexpr int LDS_BYTES = 147456;
constexpr int RING_BYTES = 131072;
constexpr int LDSCTL_OFF = 139264;
constexpr int NWAVES = 8, NTHREADS = 512;

__device__ __forceinline__ float bf2f(bf16_t b) { return __uint_as_float(((unsigned)b) << 16); }
typedef __bf16 bf16v2_t __attribute__((ext_vector_type(2)));
__device__ __forceinline__ unsigned cvt_pk_bf16(float lo, float hi) { const bf16v2_t r = __builtin_convertvector((f32x2){lo, hi}, bf16v2_t); return __builtin_bit_cast(unsigned, r); }
__device__ __forceinline__ unsigned pk2(float lo, float hi) { return cvt_pk_bf16(lo, hi); }
__device__ __forceinline__ unsigned f2bf(float f) { return cvt_pk_bf16(f, 0.f) & 0xffffu; }
__device__ __forceinline__ float bfround(float f) { return __uint_as_float(cvt_pk_bf16(f, 0.f) << 16); }
__device__ __forceinline__ float wave_sum(float v) {
#pragma unroll
    for (int o = 1; o < 64; o <<= 1) v += __shfl_xor(v, o);
    return v;
}
__device__ __forceinline__ float silu_f(float v) { return v * __builtin_amdgcn_rcpf(1.f + __expf(-v)); }
__device__ __forceinline__ float logsigmoid_f(float z) { return fminf(z, 0.f) - 0.6931471805599453f * __builtin_amdgcn_logf(1.f + __builtin_amdgcn_exp2f(-1.4426950408889634f * fabsf(z))); }

#define XB_TMO      128
#define XB_XCNT(j)  (256  + 64 * (j))
#define XB_XSUB(j)  (1280 + 64 * (j))
#define XB_XGEN(j)  (2304 + 64 * (j))
#define XB_TOP      3328
#define XB_TOPGEN   3392
#define XCD_BAR_WORDS 3456
#define XB_SPIN_CAP (1u << 22)
__device__ __forceinline__ unsigned xb_ld(unsigned* p)              { return __hip_atomic_load(p, __ATOMIC_RELAXED, __HIP_MEMORY_SCOPE_AGENT); }
__device__ __forceinline__ unsigned xb_add(unsigned* p, unsigned v) { return __hip_atomic_fetch_add(p, v, __ATOMIC_RELAXED, __HIP_MEMORY_SCOPE_AGENT); }
__device__ __forceinline__ unsigned xb_xcc_id() { return (unsigned)__builtin_amdgcn_s_getreg((3 << 11) | 20) & 0xFu; }
#define XB_SPIN(cond, bar) do { unsigned _sp = 0; while (cond) { __builtin_amdgcn_s_sleep(1); \
    if ((++_sp & 255u) == 0u) { if (xb_ld(&(bar)[XB_TMO])) break; if (_sp > XB_SPIN_CAP) { atomicAdd(&(bar)[XB_TMO], 1u); break; } } } } while (0)
struct XcdBarrier { unsigned* bar; unsigned x; volatile LAS unsigned* st; };
__device__ __forceinline__ XcdBarrier xcd_barrier_post(unsigned* bar, volatile LAS unsigned* st) {
    XcdBarrier b; b.bar = bar; b.x = xb_xcc_id(); b.st = st;
    if (threadIdx.x == 0) (void)xb_add(&bar[XB_XCNT(b.x)], 1u);
    return b;
}
__device__ __forceinline__ void xcd_barrier_complete(unsigned* bar, unsigned x, unsigned& nloc, unsigned& nx) {
    const unsigned G = gridDim.x * gridDim.y * gridDim.z;
    unsigned sum, cnt, mine, sp = 0u;
    for (;;) {
        sum = 0u; cnt = 0u; mine = 0u;
#pragma unroll
        for (unsigned j = 0; j < 16; ++j) { const unsigned c = xb_ld(&bar[XB_XCNT(j)]); sum += c; cnt += (c > 0u) ? 1u : 0u; mine = (j == x) ? c : mine; }
        if (sum == G) break;
        __builtin_amdgcn_s_sleep(1);
        if ((++sp & 255u) == 0u) { if (xb_ld(&bar[XB_TMO])) break; if (sp > XB_SPIN_CAP) { atomicAdd(&bar[XB_TMO], 1u); break; } }
    }
    nloc = mine > 0u ? mine : 1u; nx = cnt > 0u ? cnt : 1u;
}
__device__ __forceinline__ void xcd_barrier(const XcdBarrier& b) {
    asm volatile("s_waitcnt vmcnt(0)" ::: "memory");
    __syncthreads();
    if (threadIdx.x == 0) {
        unsigned* bar = b.bar;
        __builtin_amdgcn_s_waitcnt(0);
        unsigned nloc = b.st[0], nx = b.st[1];
        if (nloc == 0u) { xcd_barrier_complete(bar, b.x, nloc, nx); b.st[0] = nloc; b.st[1] = nx; }
        const unsigned old = xb_add(&bar[XB_XSUB(b.x)], 1u);
        const unsigned gen = old / nloc;
        if (old + 1u == (gen + 1u) * nloc) {
            __builtin_amdgcn_fence(__ATOMIC_RELEASE, "agent");
            asm volatile("s_waitcnt vmcnt(0)" ::: "memory");
            const unsigned og = xb_add(&bar[XB_TOP], 1u);
            const unsigned tg = og / nx;
            if (og + 1u == (tg + 1u) * nx) xb_add(&bar[XB_TOPGEN], 1u);
            else XB_SPIN(xb_ld(&bar[XB_TOPGEN]) == tg, bar);
            __builtin_amdgcn_fence(__ATOMIC_ACQUIRE, "agent");
            xb_add(&bar[XB_XGEN(b.x)], 1u);
            asm volatile("s_waitcnt vmcnt(0)" ::: "memory");
        } else {
            XB_SPIN(xb_ld(&bar[XB_XGEN(b.x)]) == gen, bar);
            __builtin_amdgcn_fence(__ATOMIC_ACQUIRE, "agent");
            asm volatile("s_waitcnt vmcnt(0)" ::: "memory");
        }
    }
    __syncthreads();
}

namespace pg8 {
constexpr int BM = 256, BK = 64, HALF = 128, HTB = HALF * BK * 2, STAGE_BYTES = 8 * HTB;
__device__ __forceinline__ int lds_byte(int r, int c) { const int st = (r >> 4) * 2 + (c >> 5), rr = r & 15, cc = c & 31, ob = rr * 64 + cc * 2; return st * 1024 + (ob ^ (((ob >> 9) & 1) << 5)); }
__device__ __forceinline__ void stage_rc(int b, int& R, int& C) { const int st = b / 1024, sb = b % 1024, swz = sb ^ (((sb >> 9) & 1) << 5); R = (st >> 1) * 16 + swz / 64; C = (st & 1) * 32 + (swz % 64) / 2; }
__device__ __forceinline__ int perm32(int rho) { const int n = rho >> 4, i = rho & 15; return 8 * (i >> 2) + 4 * n + (i & 3); }
struct Unit { int pm, pn, ks; };

struct DenseOrder {
    int nM, nN, nwg, G, c;
    __device__ void init(int M, int N, int G_, int c_) { nM = M / BM; nN = N / BM; nwg = nM * nN; G = G_; c = c_; }
    __device__ bool next(int i, Unit& u) const {
        const long L = (long)i * G + c; if (L >= nwg) return false;
        int wgid = (int)L; { const int q = nwg / 8, r = nwg % 8, xcd = wgid % 8, off = wgid / 8; wgid = (xcd < r ? xcd * (q + 1) : r * (q + 1) + (xcd - r) * q) + off; }
        const int nig = 4 * nN, gid = wgid / nig, fm = gid * 4, gsz = (nM - fm) < 4 ? (nM - fm) : 4;
        u.pm = fm + ((wgid % nig) % gsz); u.pn = (wgid % nig) / gsz; u.ks = 0; return true;
    }
};
struct PlainMap {
    __device__ __forceinline__ unsigned arow(int pm, int r) const { return (unsigned)(pm * BM + r); }
    __device__ __forceinline__ size_t brow0(const Unit& u) const { return (size_t)u.pn * BM; }
    __device__ __forceinline__ unsigned koffA(const Unit&) const { return 0u; }
    __device__ __forceinline__ size_t koffB(const Unit&) const { return 0; }
    __device__ __forceinline__ int araw(int pm, int r) const { return pm * BM + r; }
    __device__ __forceinline__ unsigned afix(int raw) const { return (unsigned)raw; }
    __device__ __forceinline__ int braw(const Unit&) const { return 0; }
    __device__ __forceinline__ size_t bfix(int, const Unit& u) const { return (size_t)u.pn * BM; }
};
struct TiledMap {
    int nkt, nrows_b;
    __device__ __forceinline__ unsigned arow(int pm, int r) const { return (unsigned)(pm * nkt * BM + r); }
    __device__ __forceinline__ size_t brow0(const Unit& u) const { return (size_t)u.pn * BM; }
    __device__ __forceinline__ unsigned koffA(const Unit&) const { return 0u; }
    __device__ __forceinline__ size_t koffB(const Unit&) const { return 0; }
    __device__ __forceinline__ int araw(int pm, int r) const { return pm * nkt * BM + r; }
    __device__ __forceinline__ unsigned afix(int raw) const { return (unsigned)raw; }
    __device__ __forceinline__ int braw(const Unit&) const { return 0; }
    __device__ __forceinline__ size_t bfix(int, const Unit& u) const { return (size_t)u.pn * BM; }
};
struct MoeMap {
    const int* rowtok; const int* blkexp; int nexp_rows;
    __device__ __forceinline__ unsigned arow(int pm, int r) const { if (!rowtok) return (unsigned)(pm * atile + r); const int t = rowtok[pm * BM + r]; return (unsigned)(t < 0 ? 0 : t); }
    __device__ __forceinline__ size_t brow0(const Unit& u) const { return (size_t)blkexp[u.pm] * nexp_rows + (size_t)u.pn * BM; }
    __device__ __forceinline__ unsigned koffA(const Unit& u) const { return (unsigned)u.ks * kslA; }
    __device__ __forceinline__ size_t koffB(const Unit& u) const { return (size_t)u.ks * kslB; }
    __device__ __forceinline__ int araw(int pm, int r) const { if (!rowtok) return pm * atile + r; int v; const int* p = rowtok + pm * BM + r; asm volatile("global_load_dword %0, %1, off" : "=v"(v) : "v"(p) : "memory"); return v; }
    __device__ __forceinline__ unsigned afix(int raw) const { return (unsigned)(raw < 0 ? 0 : raw); }
    __device__ __forceinline__ int braw(const Unit& u) const { int v; const int* p = blkexp + u.pm; asm volatile("global_load_dword %0, %1, off" : "=v"(v) : "v"(p) : "memory"); return v; }
    __device__ __forceinline__ size_t bfix(int e, const Unit& u) const { return (size_t)e * nexp_rows + (size_t)u.pn * BM; }
    int atile; unsigned kslA; size_t kslB;
};

template <class Epi, class Sched, class Map>
__device__ __forceinline__ void gemm_phase(LAS unsigned char* lds, const bf16_t* A, int lda, const bf16_t* Bt, int K, const Sched& S, const Map& MP, const Epi& E, int ldb = 0, size_t kstepA = BK * 2, size_t kstepB = BK * 2) {
    if (ldb == 0) ldb = K;
    int tid_ = threadIdx.x; asm volatile("" : "+v"(tid_));
    const int tid = tid_, wid = __builtin_amdgcn_readfirstlane(tid >> 6), lane = tid & 63, wr = wid >> 2, wc = wid & 3, fr = lane & 15, fq = lane >> 4;
    const int nt = K / BK;
    unsigned voffB[2];
#pragma unroll
    for (int i = 0; i < 2; ++i) { int R, C; stage_rc(tid * 16 + i * 8192, R, C); const int Rb = Epi::PERM ? ((R & ~31) + perm32(R & 31)) : R; voffB[i] = (unsigned)(Rb * ldb + C) * 2u; }
    const size_t hstepB = (size_t)HALF * ldb * 2;
    const unsigned ldsw = (unsigned)wid * 1024u;
    const int aoff = lds_byte(wr * 64 + fr, fq * 8), boff = lds_byte(wc * 32 + fr, fq * 8);
#define PG8_SA(b, h) (((b) * 2 + (h)) * HTB)
#define PG8_SB(b, h) ((4 + (b) * 2 + (h)) * HTB)
#define PG8_STAGE(bufoff, gbase, voff) do { _Pragma("unroll") for (int _i = 0; _i < 2; ++_i) \
        __builtin_amdgcn_global_load_lds((const unsigned*)((const char*)(gbase) + (voff)[_i]), (LAS unsigned*)(lds + (bufoff) + ldsw + _i * 8192), 16, 0, 0); } while (0)
#define PG8_LDA(dst, b, h) do { _Pragma("unroll") for (int m = 0; m < 4; ++m) _Pragma("unroll") for (int k = 0; k < 2; ++k) dst[m][k] = *(const LAS bf16x8*)(lds + PG8_SA(b, h) + aoff + m * 2048 + k * 1024); } while (0)
#define PG8_LDB(dst, b, h) do { _Pragma("unroll") for (int n = 0; n < 2; ++n) _Pragma("unroll") for (int k = 0; k < 2; ++k) dst[n][k] = *(const LAS bf16x8*)(lds + PG8_SB(b, h) + boff + n * 2048 + k * 1024); } while (0)
#define PG8_MMA(ai, bj, At, Bt_) do { __builtin_amdgcn_s_setprio(1); _Pragma("unroll") for (int m = 0; m < 4; ++m) _Pragma("unroll") for (int n = 0; n < 2; ++n) _Pragma("unroll") for (int k = 0; k < 2; ++k) \
        acc[ai][bj][m][n] = __builtin_amdgcn_mfma_f32_16x16x32_bf16(Bt_[n][k], At[m][k], acc[ai][bj][m][n], 0, 0, 0); __builtin_amdgcn_s_setprio(0); } while (0)
#define PG8_WAIT_V(n) asm volatile("s_waitcnt vmcnt(" #n ")" ::: "memory")
#define PG8_WAIT_L(n) asm volatile("s_waitcnt lgkmcnt(" #n ")" ::: "memory")
#define PG8_BAR __builtin_amdgcn_s_barrier()
#define PG8_SCHED __builtin_amdgcn_sched_barrier(0)
#define PG8_VOFFA(dst, u_) do { _Pragma("unroll") for (int _i = 0; _i < 2; ++_i) { int _R, _C; stage_rc(tid * 16 + _i * 8192, _R, _C); _Pragma("unroll") for (int _h = 0; _h < 2; ++_h) \
        dst[_h][_i] = (MP.arow((u_).pm, _h * HALF + _R) * (unsigned)lda + (unsigned)_C) * 2u + MP.koffA(u_); } } while (0)
#define PG8_STAGE2(bufoff, gbase, va, vb, sel) do { _Pragma("unroll") for (int _i = 0; _i < 2; ++_i) \
        __builtin_amdgcn_global_load_lds((const unsigned*)((const char*)(gbase) + ((sel) ? (vb)[_i] : (va)[_i])), (LAS unsigned*)(lds + (bufoff) + ldsw + _i * 8192), 16, 0, 0); } while (0)
    Unit cur, nxt; int ui = 0;
    if (!S.next(0, cur)) return;
    f32x4 acc[2][2][4][2];
#pragma unroll
    for (int a = 0; a < 2; ++a)
#pragma unroll
        for (int b = 0; b < 2; ++b)
#pragma unroll
            for (int m = 0; m < 4; ++m)
#pragma unroll
                for (int n = 0; n < 2; ++n) acc[a][b][m][n] = (f32x4){0.f, 0.f, 0.f, 0.f};
    bf16x8 At[4][2], B0[2][2], B1[2][2];
    unsigned vc[2][2], vn[2][2];
    PG8_VOFFA(vc, cur);
    const char* cA = (const char*)A; const char* cB = (const char*)Bt + MP.brow0(cur) * (size_t)ldb * 2 + MP.koffB(cur);
    PG8_STAGE(PG8_SB(0, 0), cB, voffB); PG8_STAGE(PG8_SB(0, 1), cB + hstepB, voffB); PG8_STAGE(PG8_SA(0, 0), cA, vc[0]); PG8_STAGE(PG8_SA(0, 1), cA, vc[1]);
    if (wr == 1) PG8_BAR;
    PG8_WAIT_V(2); PG8_BAR;
    PG8_STAGE(PG8_SB(1, 0), cB + kstepB, voffB); PG8_STAGE(PG8_SA(1, 0), cA + kstepA, vc[0]); PG8_STAGE(PG8_SB(1, 1), cB + hstepB + kstepB, voffB);
    PG8_WAIT_V(6); PG8_BAR;
    for (;;) {
        const bool has_next = S.next(ui + 1, nxt);
        if (!has_next) nxt = cur;
        int rawB = MP.braw(nxt);
#pragma unroll
        for (int _i = 0; _i < 2; ++_i) { int _R, _C; stage_rc(tid * 16 + _i * 8192, _R, _C);
#pragma unroll
            for (int _h = 0; _h < 2; ++_h) vn[_h][_i] = (unsigned)MP.araw(nxt.pm, _h * HALF + _R); }
        const char* nB = cB;
        for (int t = 0; t < nt; t += 2) {
            const bool last = (t == nt - 2);
            const char* a1 = cA + (size_t)(t + 1) * kstepA;
            const char* a2 = last ? cA : cA + (size_t)(t + 2) * kstepA; const char* b2 = last ? nB : cB + (size_t)(t + 2) * kstepB;
            const char* a3 = a2 + kstepA; const char* b3 = b2 + kstepB;
            PG8_LDB(B0, 0, 0); PG8_LDB(B1, 0, 1); PG8_SCHED; PG8_LDA(At, 0, 0); PG8_STAGE(PG8_SA(1, 1), a1, vc[1]);
            PG8_WAIT_V(8); PG8_WAIT_L(0); PG8_BAR; PG8_MMA(0, 0, At, B0); PG8_MMA(0, 1, At, B1); PG8_BAR; PG8_SCHED;
            PG8_LDA(At, 0, 1); PG8_STAGE(PG8_SB(0, 0), b2, voffB); PG8_STAGE(PG8_SB(0, 1), b2 + hstepB, voffB); PG8_STAGE2(PG8_SA(0, 0), a2, vc[0], vn[0], last);
            PG8_WAIT_V(8); PG8_WAIT_L(0); PG8_BAR; PG8_MMA(1, 0, At, B0); PG8_MMA(1, 1, At, B1); PG8_BAR; PG8_SCHED;
            PG8_LDB(B0, 1, 0); PG8_LDB(B1, 1, 1); PG8_SCHED; PG8_LDA(At, 1, 0); PG8_STAGE2(PG8_SA(0, 1), a2, vc[1], vn[1], last);
            PG8_WAIT_V(8); PG8_WAIT_L(0); PG8_BAR; PG8_MMA(0, 0, At, B0); PG8_MMA(0, 1, At, B1); PG8_BAR; PG8_SCHED;
            PG8_LDA(At, 1, 1); PG8_STAGE(PG8_SB(1, 0), b3, voffB); PG8_STAGE(PG8_SB(1, 1), b3 + hstepB, voffB); PG8_STAGE2(PG8_SA(1, 0), a3, vc[0], vn[0], last);
            PG8_WAIT_V(8); PG8_WAIT_L(0); PG8_BAR; PG8_MMA(1, 0, At, B0); PG8_MMA(1, 1, At, B1); PG8_BAR; PG8_SCHED;
            { int first_ = (t == 0) ? 1 : 0; asm volatile("" : "+v"(first_)); first_ = __builtin_amdgcn_readfirstlane(first_);
              if (first_) {
                  asm volatile("" : "+v"(vn[0][0]), "+v"(vn[0][1]), "+v"(vn[1][0]), "+v"(vn[1][1]), "+v"(rawB));
#pragma unroll
                  for (int _i = 0; _i < 2; ++_i) { int _R, _C; stage_rc(tid * 16 + _i * 8192, _R, _C);
#pragma unroll
                      for (int _h = 0; _h < 2; ++_h) vn[_h][_i] = (MP.afix((int)vn[_h][_i]) * (unsigned)lda + (unsigned)_C) * 2u + MP.koffA(nxt); }
                  nB = (const char*)Bt + MP.bfix(__builtin_amdgcn_readfirstlane(rawB), nxt) * (size_t)ldb * 2 + MP.koffB(nxt); } }
        }
        if (wr == 0) PG8_BAR;
        E(acc, cur, wr, wc, fr, fq);
        if (!has_next) break;
#pragma unroll
        for (int a = 0; a < 2; ++a)
#pragma unroll
            for (int b = 0; b < 2; ++b)
#pragma unroll
                for (int m = 0; m < 4; ++m)
#pragma unroll
                    for (int n = 0; n < 2; ++n) acc[a][b][m][n] = (f32x4){0.f, 0.f, 0.f, 0.f};
        cur = nxt; cB = nB; ++ui;
#pragma unroll
        for (int h = 0; h < 2; ++h)
#pragma unroll
            for (int i = 0; i < 2; ++i) vc[h][i] = vn[h][i];
        if (wr == 1) PG8_BAR;
    }
    PG8_WAIT_V(0);
    PG8_BAR;
#undef PG8_SA
#undef PG8_SB
#undef PG8_STAGE
#undef PG8_LDA
#undef PG8_LDB
#undef PG8_MMA
#undef PG8_WAIT_V
#undef PG8_WAIT_L
#undef PG8_BAR
#undef PG8_SCHED
#undef PG8_VOFFA
#undef PG8_STAGE2
}

struct EpiBf16 {
    static constexpr bool PERM = true;
    bf16_t* O; int ldc;
    __device__ __forceinline__ void operator()(const f32x4 (&acc)[2][2][4][2], const Unit& u, int wr, int wc, int fr, int fq) const {
        const int row0 = u.pm * BM + wr * 64 + fr, col0 = u.pn * BM + wc * 32 + 8 * fq;
#pragma unroll
        for (int ai = 0; ai < 2; ++ai)
#pragma unroll
            for (int m = 0; m < 4; ++m) { bf16_t* rowp = O + (size_t)(row0 + ai * HALF + m * 16) * ldc + col0;
#pragma unroll
                for (int bj = 0; bj < 2; ++bj) { const f32x4 v0 = acc[ai][bj][m][0], v1 = acc[ai][bj][m][1];
                    u32x4 w; w.x = cvt_pk_bf16(v0[0], v0[1]); w.y = cvt_pk_bf16(v0[2], v0[3]); w.z = cvt_pk_bf16(v1[0], v1[1]); w.w = cvt_pk_bf16(v1[2], v1[3]);
                    __builtin_nontemporal_store(w, (u32x4*)(rowp + bj * HALF)); } }
    }
};
struct EpiSwiGLU {
    static constexpr bool PERM = true;
    bf16_t* H; int ldh;
    __device__ __forceinline__ void operator()(const f32x4 (&acc)[2][2][4][2], const Unit& u, int wr, int wc, int fr, int fq) const {
        const int col0 = u.pn * HALF + wc * 32 + 8 * fq;
        bf16_t* tile = H + (((size_t)u.pm * (ldh >> 6) + (col0 >> 6)) * BM + wr * 64 + fr) * 64 + (col0 & 63);
#pragma unroll
        for (int ai = 0; ai < 2; ++ai)
#pragma unroll
            for (int m = 0; m < 4; ++m) { bf16_t* rowp = tile + (size_t)(ai * HALF + m * 16) * 64;
                f32x4 h0, h1;
#pragma unroll
                for (int j = 0; j < 4; ++j) { const float g0 = acc[ai][0][m][0][j], g1 = acc[ai][0][m][1][j];
                    h0[j] = g0 * __builtin_amdgcn_rcpf(1.f + __expf(-g0)) * acc[ai][1][m][0][j]; h1[j] = g1 * __builtin_amdgcn_rcpf(1.f + __expf(-g1)) * acc[ai][1][m][1][j]; }
                u32x4 w; w.x = cvt_pk_bf16(h0[0], h0[1]); w.y = cvt_pk_bf16(h0[2], h0[3]); w.z = cvt_pk_bf16(h1[0], h1[1]); w.w = cvt_pk_bf16(h1[2], h1[3]);
                __builtin_nontemporal_store(w, (u32x4*)rowp); }
    }
};
struct EpiResF32 {
    static constexpr bool PERM = false;
    const float* base; float* out; int ldc;
    __device__ __forceinline__ void operator()(const f32x4 (&acc)[2][2][4][2], const Unit& u, int wr, int wc, int fr, int fq) const {
        const int row0 = u.pm * BM + wr * 64 + fr, col0 = u.pn * BM + wc * 32 + 4 * fq;
#pragma unroll
        for (int ai = 0; ai < 2; ++ai)
#pragma unroll
            for (int m = 0; m < 4; ++m) { const size_t off = (size_t)(row0 + ai * HALF + m * 16) * ldc + col0;
#pragma unroll
                for (int bj = 0; bj < 2; ++bj)
#pragma unroll
                    for (int n = 0; n < 2; ++n) { const f32x4 bs = *(const f32x4*)(base + off + bj * HALF + n * 16); __builtin_nontemporal_store(bs + acc[ai][bj][m][n], (f32x4*)(out + off + bj * HALF + n * 16)); } }
    }
};
struct EpiMoeDown {
    static constexpr bool PERM = false;
    float* out; const int* rowtok; const float* rowgate;
    __device__ __forceinline__ void operator()(const f32x4 (&acc)[2][2][4][2], const Unit& u, int wr, int wc, int fr, int fq) const {
        const int row0 = u.pm * BM + wr * 64 + fr, col0 = u.pn * BM + wc * 32 + 4 * fq;
#pragma unroll
        for (int ai = 0; ai < 2; ++ai)
#pragma unroll
            for (int m = 0; m < 4; ++m) { const int r = row0 + ai * HALF + m * 16; const int tok = rowtok[r]; const float g = rowgate[r];
                if (tok >= 0) { float* op = out + (size_t)tok * D + col0;
#pragma unroll
                    for (int bj = 0; bj < 2; ++bj)
#pragma unroll
                        for (int n = 0; n < 2; ++n) { const f32x4 bs = *(const f32x4*)(op + bj * HALF + n * 16); *(f32x4*)(op + bj * HALF + n * 16) = bs + g * acc[ai][bj][m][n]; } } }
    }
};
struct EpiPartial {
    static constexpr bool PERM = false;
    float* part; int nks;
    __device__ __forceinline__ void operator()(const f32x4 (&acc)[2][2][4][2], const Unit& u, int wr, int wc, int fr, int fq) const {
        float* base = part + ((size_t)(((u.pm - 128) * 4 + u.pn) * nks + u.ks) << 16) + (size_t)(wr * 64 + fr) * BM + wc * 32 + 4 * fq;
#pragma unroll
        for (int ai = 0; ai < 2; ++ai)
#pragma unroll
            for (int m = 0; m < 4; ++m)
#pragma unroll
                for (int bj = 0; bj < 2; ++bj)
#pragma unroll
                    for (int n = 0; n < 2; ++n) *(f32x4*)(base + (size_t)(ai * HALF + m * 16) * BM + bj * HALF + n * 16) = acc[ai][bj][m][n];
    }
};
}

struct MoeOrder : pg8::DenseOrder {
    __device__ void init(int nblk, int nN_, int G_, int c_) { nM = nblk; nN = nN_; nwg = nblk * nN_; G = G_; c = c_; }
};

constexpr int OVF_NKS = 4, OVF_K = FFE / OVF_NKS;
struct OvfOrder { int nov, G, c;
    __device__ bool next(int i, pg8::Unit& u) const { const int s = i * G + c; if (s >= nov * OVF_NKS) return false; const int r = s / OVF_NKS; u.ks = s % OVF_NKS; u.pm = 128 + (r >> 2); u.pn = r & 3; return true; } };
__device__ __forceinline__ void ovf_reduce(const float* part, int nov, const int* rowtok, const float* rowgate, float* out, int gtid, int NT) {
    for (int i = gtid; i < nov * 16384; i += NT) { const int r = i >> 14, e = i & 16383, row = e >> 6, c4 = (e & 63) * 4, pm = 128 + (r >> 2), pn = r & 3;
        const int tok = rowtok[pm * 256 + row]; if (tok < 0) continue;
        const float* p = part + ((size_t)(r * OVF_NKS) << 16) + row * 256 + c4; f32x4 a = *(const f32x4*)p;
#pragma unroll
        for (int ks = 1; ks < OVF_NKS; ++ks) a = a + *(const f32x4*)(p + ((size_t)ks << 16));
        float* op = out + (size_t)tok * D + pn * 256 + c4; *(f32x4*)op = *(const f32x4*)op + rowgate[pm * 256 + row] * a; }
}

struct Frame {
    LAS unsigned char* lds;
    gu32* ctl;
    int tid, lane, wave, G, gw, NGW;
    unsigned char* ws;
    float* out;
};
__device__ __forceinline__ const float* inptr(int i) {
    unsigned off = (unsigned)i * 8u; asm volatile("" : "+s"(off));
    return *(const float* const*)((const char*)__builtin_amdgcn_kernarg_segment_ptr() + off);
}
enum { I_X = 0, I_MN0, I_WIN0, I_WGATEUP, I_BGATE, I_GLANORM, I_QNORM, I_KNORM, I_WOUT0, I_FN0, I_WFG, I_WFU, I_WFD, I_MN1, I_WIN1, I_RETGN, I_WOUT1, I_FN1, I_WROUTER, I_WEG, I_WEU, I_WED };

__device__ __forceinline__ void transpose_item(const float* W, int ldw, int src_col0, bf16_t* WT, int ldt, int dst_row0, int k0, LAS float* scr, int lane) {
    { const float* p = W + (size_t)(k0 + (lane >> 3)) * ldw + src_col0 + 4 * (lane & 7); f32x4 v[8];
#pragma unroll
      for (int i = 0; i < 8; ++i) v[i] = *(const f32x4*)(p + (size_t)(8 * i) * ldw);
#pragma unroll
      for (int i = 0; i < 8; ++i) { LAS float* d = scr + ((lane >> 3) + 8 * i) * 33 + 4 * (lane & 7); d[0] = v[i].x; d[1] = v[i].y; d[2] = v[i].z; d[3] = v[i].w; } }
    LDS_WAIT(); asm volatile("" ::: "memory");
    const int c = lane & 7;
#pragma unroll
    for (int j = 0; j < 4; ++j) { const int n = (lane >> 3) + 8 * j; const LAS float* s = scr + (8 * c) * 33 + n;
        u32x4 o; o.x = pk2(s[0 * 33], s[1 * 33]); o.y = pk2(s[2 * 33], s[3 * 33]); o.z = pk2(s[4 * 33], s[5 * 33]); o.w = pk2(s[6 * 33], s[7 * 33]);
        *(u32x4*)(WT + (size_t)(dst_row0 + n) * ldt + k0 + 8 * c) = o; }
    LDS_WAIT(); asm volatile("" ::: "memory");
}
__device__ __forceinline__ void transpose_plain(const float* W, int K, int N, bf16_t* WT, int it, LAS float* scr, int lane) {
    const int nblk = N / 32, kb = it / nblk, nb = it % nblk; transpose_item(W, N, 32 * nb, WT, K, 32 * nb, 64 * kb, scr, lane);
}
__device__ __forceinline__ void transpose_ktile(const float* W, int K, int N, bf16_t* WT, int it, LAS float* scr, int lane) {
    const int nblk = N / 32, kb = it / nblk, nb = it % nblk; transpose_item(W, N, 32 * nb, WT + (size_t)kb * N * 64 - 64 * kb, 64, 32 * nb, 64 * kb, scr, lane); (void)K;
}
__device__ __forceinline__ void transpose_gateup(const float* Wg, const float* Wu, int K, int F, bf16_t* WT, int it, LAS float* scr, int lane, bool ktile = false) {
    const int nblk = 2 * F / 32, kb = it / nblk, nb = it % nblk, dr = 32 * nb, tile = dr >> 8, within = dr & 255;
    const float* W = within < 128 ? Wg : Wu; const int sc = tile * 128 + (within & 127);
    if (ktile) transpose_item(W, F, sc, WT + (size_t)kb * 2 * F * 64 - 64 * kb, 64, dr, 64 * kb, scr, lane);
    else transpose_item(W, F, sc, WT, K, dr, 64 * kb, scr, lane);
}

__device__ __forceinline__ void row_load(const float* xrow, int lane, f32x4 (&v)[4]) {
    const f32x4* xr = (const f32x4*)xrow + lane;
#pragma unroll
    for (int j = 0; j < 4; ++j) v[j] = xr[64 * j];
}
__device__ __forceinline__ void rmsnorm_finish(const float* w, bf16_t* orow, int lane, f32x4 (&v)[4], bf16_t* tiled = nullptr, int m = 0) {
    float s = 0.f;
#pragma unroll
    for (int j = 0; j < 4; ++j) s += (v[j].x * v[j].x + v[j].y * v[j].y) + (v[j].z * v[j].z + v[j].w * v[j].w);
    const float r = 1.f / sqrtf(wave_sum(s) * (1.f / D) + NORM_EPS);
    const f32x4* wr = (const f32x4*)w + lane;
    unsigned long long* o8 = (unsigned long long*)orow + lane;
#pragma unroll
    for (int j = 0; j < 4; ++j) { const f32x4 ww = wr[64 * j]; v[j] = v[j] * r * ww; const unsigned long long pk = (unsigned long long)pk2(v[j].x, v[j].y) | ((unsigned long long)pk2(v[j].z, v[j].w) << 32);
        if (tiled) *(unsigned long long*)(tiled + ((((size_t)(m >> 8) * 16 + 4 * j + (lane >> 4)) * 256 + (m & 255)) * 64 + 4 * (lane & 15))) = pk; else o8[64 * j] = pk; }
}
__device__ __forceinline__ void rmsnorm_rows(const float* src, const float* w, bf16_t* dst, int m0, int stride, int mend, int lane, bool tiled = false) {
    f32x4 cur[4], nxt[4];
    if (m0 < mend) row_load(src + (size_t)m0 * D, lane, cur);
    for (int m = m0; m < mend; m += stride) { const int mn = m + stride;
        if (mn < mend) row_load(src + (size_t)mn * D, lane, nxt);
        rmsnorm_finish(w, dst + (size_t)m * D, lane, cur, tiled ? dst : nullptr, m);
#pragma unroll
        for (int j = 0; j < 4; ++j) cur[j] = nxt[j]; }
}

__device__ __forceinline__ void unpack8(const u32x4 raw, float (&x)[8]) {
    x[0] = __uint_as_float(raw.x << 16); x[1] = __uint_as_float(raw.x & 0xffff0000u); x[2] = __uint_as_float(raw.y << 16); x[3] = __uint_as_float(raw.y & 0xffff0000u);
    x[4] = __uint_as_float(raw.z << 16); x[5] = __uint_as_float(raw.z & 0xffff0000u); x[6] = __uint_as_float(raw.w << 16); x[7] = __uint_as_float(raw.w & 0xffff0000u);
}
typedef short s16x4 __attribute__((ext_vector_type(4)));
__device__ __forceinline__ void dilated_phase(const Frame& F, const bf16_t* HC0, bf16_t* op01, bf16_t* op2, float* lse) {
    constexpr int SLOT = 128 * 144;
    constexpr float LOG2E = 1.4426950408889634f, LN2 = 0.6931471805599453f;
    LAS unsigned char* Ks = F.lds; LAS unsigned char* Vs = F.lds + 3 * SLOT;
    for (int i = F.tid; i < 6 * SLOT / 16; i += NTHREADS) ((LAS u32x4*)F.lds)[i] = (u32x4){0u, 0u, 0u, 0u};
    int tid_ = threadIdx.x; asm volatile("" : "+v"(tid_));
    const int lane = tid_ & 63, fr = lane & 15, fq = lane >> 4, w = __builtin_amdgcn_readfirstlane(tid_ >> 6);
    const int srow0 = tid_ >> 3, sc = tid_ & 7;
    float knw[8], qnw[16];
    { const float* kn = inptr(I_KNORM); const float* qn = inptr(I_QNORM);
#pragma unroll
      for (int e = 0; e < 8; ++e) { knw[e] = kn[8 * sc + e]; qnw[e] = qn[8 * fq + e] * (0.125f * LOG2E); qnw[8 + e] = qn[32 + 8 * fq + e] * (0.125f * LOG2E); } }
    const unsigned vlane = (unsigned)((4 * fq + ((lane & 15) >> 2)) * 144 + (lane & 3) * 8);
    __syncthreads();
    for (int item = blockIdx.x; item < 1536; item += F.G) {
        const int p = item >> 9, within = item & 511, dsh = 2 * p, d = 1 << dsh;
        const int strip = within >> (4 - dsh), grp = within & ((16 >> dsh) - 1), r = strip & (d - 1), bh = strip >> dsh, h = bh & 7, b = bh >> 3, n0 = 4 * grp;
        const float cb = exp2f(-(float)(h + 1)) * LOG2E * (float)d;
        bf16_t* op = p < 2 ? op01 + (size_t)p * T * 512 : op2;
        const bf16_t* base = HC0 + (size_t)b * SEQ * LD0 + h * 64;
        u32x4 kreg[2], vreg[2];
#define DIL_LOAD(m) do { _Pragma("unroll") for (int rep = 0; rep < 2; ++rep) { const size_t pos = (size_t)((128 * (m) + srow0 + 64 * rep) * d + r); \
            kreg[rep] = *(const u32x4*)(base + pos * LD0 + C0_KB + 8 * sc); vreg[rep] = *(const u32x4*)(base + pos * LD0 + C0_VB + 8 * sc); } } while (0)
#define DIL_STORE(slot) do { _Pragma("unroll") for (int rep = 0; rep < 2; ++rep) { float x[8]; unpack8(kreg[rep], x); float ss = 0.f; \
            _Pragma("unroll") for (int e = 0; e < 8; ++e) ss += x[e] * x[e]; \
            ss += __shfl_xor(ss, 1); ss += __shfl_xor(ss, 2); ss += __shfl_xor(ss, 4); const float rs = 1.f / sqrtf(ss * (1.f / 64.f) + NORM_EPS); \
            const unsigned ro = (unsigned)((slot) * SLOT + (srow0 + 64 * rep) * 144 + sc * 16); \
            *(LAS u32x4*)(Ks + ro) = (u32x4){cvt_pk_bf16(x[0] * rs * knw[0], x[1] * rs * knw[1]), cvt_pk_bf16(x[2] * rs * knw[2], x[3] * rs * knw[3]), cvt_pk_bf16(x[4] * rs * knw[4], x[5] * rs * knw[5]), cvt_pk_bf16(x[6] * rs * knw[6], x[7] * rs * knw[7])}; \
            *(LAS u32x4*)(Vs + ro) = vreg[rep]; } } while (0)
        if (n0 > 0) { DIL_LOAD(n0 - 1); DIL_STORE((n0 + 2) % 3); }
        DIL_LOAD(n0); DIL_STORE(n0 % 3);
        u32x4 qraw0, qraw1;
#define DIL_LOADQ(m) do { const bf16_t* qp_ = HC0 + ((size_t)b * SEQ + (size_t)((128 * (m) + 16 * w + fr) * d + r)) * LD0 + C0_QB + h * 64; qraw0 = *(const u32x4*)(qp_ + 8 * fq); qraw1 = *(const u32x4*)(qp_ + 32 + 8 * fq); } while (0)
        DIL_LOADQ(n0);
        __syncthreads();
#pragma unroll 1
        for (int n = n0; n < n0 + 4; ++n) {
            const int prev = (n + 2) % 3, cur = n % 3, nxt = (n + 1) % 3;
            const bool more = (n + 1 < n0 + 4);
            const size_t tokq = (size_t)b * SEQ + (size_t)((128 * n + 16 * w + fr) * d + r);
            bf16x8 qf0, qf1;
            { float x0[8], x1[8]; unpack8(qraw0, x0); unpack8(qraw1, x1);
              float ss = 0.f;
#pragma unroll
              for (int e = 0; e < 8; ++e) ss += x0[e] * x0[e] + x1[e] * x1[e];
              ss += __shfl_xor(ss, 16); ss += __shfl_xor(ss, 32);
              const float rs = 1.f / sqrtf(ss * (1.f / 64.f) + NORM_EPS);
              const u32x4 a0 = (u32x4){cvt_pk_bf16(x0[0] * rs * qnw[0], x0[1] * rs * qnw[1]), cvt_pk_bf16(x0[2] * rs * qnw[2], x0[3] * rs * qnw[3]), cvt_pk_bf16(x0[4] * rs * qnw[4], x0[5] * rs * qnw[5]), cvt_pk_bf16(x0[6] * rs * qnw[6], x0[7] * rs * qnw[7])};
              const u32x4 a1 = (u32x4){cvt_pk_bf16(x1[0] * rs * qnw[8], x1[1] * rs * qnw[9]), cvt_pk_bf16(x1[2] * rs * qnw[10], x1[3] * rs * qnw[11]), cvt_pk_bf16(x1[4] * rs * qnw[12], x1[5] * rs * qnw[13]), cvt_pk_bf16(x1[6] * rs * qnw[14], x1[7] * rs * qnw[15])};
              qf0 = __builtin_bit_cast(bf16x8, a0); qf1 = __builtin_bit_cast(bf16x8, a1); }
            if (more) { DIL_LOAD(n + 1); DIL_LOADQ(n + 1); }
            f32x4 sacc[9];
#pragma unroll
            for (int i = 0; i < 9; ++i) { const int kt = w + i; const unsigned ko = (unsigned)((kt < 8 ? prev : cur) * SLOT + ((kt & 7) * 16 + fr) * 144 + fq * 16);
                const bf16x8 k0 = *(const LAS bf16x8*)(Ks + ko), k1 = *(const LAS bf16x8*)(Ks + ko + 64);
                f32x4 z = (f32x4){0.f, 0.f, 0.f, 0.f};
                z = __builtin_amdgcn_mfma_f32_16x16x32_bf16(k0, qf0, z, 0, 0, 0); sacc[i] = __builtin_amdgcn_mfma_f32_16x16x32_bf16(k1, qf1, z, 0, 0, 0); }
            float mx = -1e30f; const int lpart = fr - 4 * fq;
#pragma unroll
            for (int i = 0; i < 9; ++i) { const bool tile_ok = (w + i >= 8) || (n > 0);
#pragma unroll
                for (int j = 0; j < 4; ++j) { const int steps = 128 - 16 * i - j + lpart; float sv = sacc[i][j] - cb * (float)steps; bool ok = tile_ok;
                    if (i == 0) ok = ok && (steps <= 128); if (i == 8) ok = ok && (steps >= 0);
                    sv = ok ? sv : -1e30f; sacc[i][j] = sv; mx = fmaxf(mx, sv); } }
            mx = fmaxf(mx, __shfl_xor(mx, 16)); mx = fmaxf(mx, __shfl_xor(mx, 32));
            float l = 0.f;
#pragma unroll
            for (int i = 0; i < 9; ++i)
#pragma unroll
                for (int j = 0; j < 4; ++j) { const float pe = __builtin_amdgcn_exp2f(sacc[i][j] - mx); sacc[i][j] = pe; l += pe; }
            l += __shfl_xor(l, 16); l += __shfl_xor(l, 32);
            bf16x8 pf[5];
#pragma unroll
            for (int ks = 0; ks < 5; ++ks) { u32x4 t4; t4.x = cvt_pk_bf16(sacc[2 * ks][0], sacc[2 * ks][1]); t4.y = cvt_pk_bf16(sacc[2 * ks][2], sacc[2 * ks][3]);
                if (ks < 4) { t4.z = cvt_pk_bf16(sacc[2 * ks + 1][0], sacc[2 * ks + 1][1]); t4.w = cvt_pk_bf16(sacc[2 * ks + 1][2], sacc[2 * ks + 1][3]); } else { t4.z = 0u; t4.w = 0u; }
                pf[ks] = __builtin_bit_cast(bf16x8, t4); }
            f32x4 oacc[4];
#pragma unroll
            for (int dt = 0; dt < 4; ++dt) oacc[dt] = (f32x4){0.f, 0.f, 0.f, 0.f};
#pragma unroll
            for (int ks = 0; ks < 5; ++ks) { const int ta = w + 2 * ks, tb = ks < 4 ? ta + 1 : ta;
                const unsigned va = (unsigned)((ta < 8 ? prev : cur) * SLOT + (ta & 7) * 16 * 144) + vlane, vb = (unsigned)((tb < 8 ? prev : cur) * SLOT + (tb & 7) * 16 * 144) + vlane;
#pragma unroll
                for (int dt = 0; dt < 4; ++dt) { const s16x4 lo = __builtin_amdgcn_ds_read_tr16_b64_v4i16((LAS s16x4*)(Vs + va + dt * 32)), hi = __builtin_amdgcn_ds_read_tr16_b64_v4i16((LAS s16x4*)(Vs + vb + dt * 32));
                    const bf16x8 vf = (bf16x8){lo[0], lo[1], lo[2], lo[3], hi[0], hi[1], hi[2], hi[3]};
                    oacc[dt] = __builtin_amdgcn_mfma_f32_16x16x32_bf16(vf, pf[ks], oacc[dt], 0, 0, 0); } }
            const float il = 1.f / l;
            bf16_t* orow = op + tokq * 512 + h * 64 + 4 * fq;
#pragma unroll
            for (int dt = 0; dt < 4; ++dt) *(u32x2*)(orow + 16 * dt) = (u32x2){cvt_pk_bf16(oacc[dt][0] * il, oacc[dt][1] * il), cvt_pk_bf16(oacc[dt][2] * il, oacc[dt][3] * il)};
            if (fq == 0) lse[((size_t)p * T + tokq) * 8 + h] = (mx + __builtin_amdgcn_logf(l)) * LN2;
            if (more) DIL_STORE(nxt);
            __syncthreads();
        }
#undef DIL_LOAD
#undef DIL_LOADQ
#undef DIL_STORE
    }
}

template <int C, int DK, int DVS, bool SPLIT, int LD, int CQ, int CV, int DVH, int NCH, int PFO, int PFS, int PFV, int UNR>
__device__ __forceinline__ void recur_phase(const Frame& F, bf16_t* HC, const bf16_t* att, const bf16_t* keT, const float* decay) {
    constexpr int KA = C / 32, KQ = DK / 32, MTV = DVS / 16;
    constexpr int SP = DK * 2 + 16, VP = DVS * 2;
    constexpr int VBUF = C * VP, SBUF = DVS * SP;
    constexpr int NVCH = C * DVS / 8;
    constexpr int QLPR = DK * 2 / 16, QRPT = 64 / QLPR;
    static_assert(UNR % PFO == 0 && UNR % PFS == 0 && UNR % PFV == 0 && UNR % 2 == 0 && NCH % UNR == 0, "ring depths");
    LAS unsigned char* vb = F.lds; LAS unsigned char* sb = F.lds + 2 * VBUF;
    int tid_ = threadIdx.x; asm volatile("" : "+v"(tid_));
    const int tid = tid_, lane = tid & 63, fr = lane & 15, fq = lane >> 4, w = __builtin_amdgcn_readfirstlane(tid >> 6);
    const bool is_o = SPLIT ? (w < 4) : true, is_s = SPLIT ? (w >= 4) : true;
    const int nto = SPLIT ? (w & 3) : w, mts0 = SPLIT ? 2 * (w & 3) : 2 * w;
    const unsigned trl = (unsigned)((8 * fq + ((lane & 15) >> 2)) * VP + (lane & 3) * 8);
    const int vrow = (tid % NVCH) / (DVS / 8), vpart = tid % (DVS / 8);
    for (int item0 = blockIdx.x; item0 < 256; item0 += F.G) {
        const int item = (F.G == 256) ? ((item0 & 7) * 32 + (item0 >> 3)) : item0;
        const int sl = item & 15, h = (item >> 4) & 3, b = item >> 6;
        const float cdec = __expf((float)C * log1pf(-exp2f(-5.f - (float)h)));
        __syncthreads();
        for (int i = tid; i < SBUF / 16; i += NTHREADS) ((LAS u32x4*)sb)[i] = (u32x4){0u, 0u, 0u, 0u};
        f32x4 accS[2][MTV];
#pragma unroll
        for (int i = 0; i < 2; ++i)
#pragma unroll
            for (int j = 0; j < MTV; ++j) accS[i][j] = (f32x4){0.f, 0.f, 0.f, 0.f};
        static_assert(!SPLIT || (PFO == PFS && KA + KQ >= 2 * KA + 2), "aliased rings");
        u32x4 RO[PFO][KA + KQ], RSx[SPLIT ? 1 : PFS][SPLIT ? 1 : 2 * KA + 2]; u32x4 vreg[PFV];
#define BA_(u_, ks_) RO[u_][ks_]
#define BQ_(u_, kq_) RO[u_][KA + (kq_)]
#define KE_(u_, i_, ks_) (*(SPLIT ? &RO[u_][(i_) * KA + (ks_)] : &RSx[SPLIT ? 0 : (u_)][SPLIT ? 0 : (i_) * KA + (ks_)]))
#define DC_(u_, i_) (*(SPLIT ? &RO[u_][2 * KA + (i_)] : &RSx[SPLIT ? 0 : (u_)][SPLIT ? 0 : 2 * KA + (i_)]))
        const size_t vcol = (size_t)CV + h * DVH + sl * DVS;
#define RC_LOAD_O(u_, n_) do { const size_t unit_ = (size_t)(b * NCH + (n_)) * 4 + h; \
            const bf16_t* ap_ = att + (unit_ * (C / 16) + nto) * KA * 512 + lane * 8; \
            const bf16_t* qp_ = HC + ((size_t)b * SEQ + (size_t)(n_) * C + (size_t)(nto * KQ) * QRPT + lane / QLPR) * LD + CQ + h * DK + (lane % QLPR) * 8; \
            _Pragma("unroll") for (int ks = 0; ks < KA; ++ks) BA_(u_, ks) = *(const u32x4*)(ap_ + ks * 512); \
            _Pragma("unroll") for (int kq = 0; kq < KQ; ++kq) BQ_(u_, kq) = *(const u32x4*)(qp_ + (size_t)(kq * QRPT) * LD); } while (0)
#define RC_LOAD_S(u_, n_) do { const size_t unit_ = (size_t)(b * NCH + (n_)) * 4 + h; \
            _Pragma("unroll") for (int i = 0; i < 2; ++i) { const bf16_t* kp_ = keT + (unit_ * (DK / 16) + mts0 + i) * KA * 512 + lane * 8; \
                _Pragma("unroll") for (int ks = 0; ks < KA; ++ks) KE_(u_, i, ks) = *(const u32x4*)(kp_ + ks * 512); \
                if (decay) DC_(u_, i) = *(const u32x4*)(decay + unit_ * DK + 16 * (mts0 + i) + 4 * fq); } } while (0)
#define RC_LOAD_V(u_, n_) do { vreg[u_] = *(const u32x4*)(HC + ((size_t)b * SEQ + (size_t)(n_) * C + vrow) * LD + vcol + vpart * 8); } while (0)
#define RC_STORE_V(buf_, u_) do { if (tid < NVCH) *(LAS u32x4*)(vb + (buf_) * VBUF + vrow * VP + vpart * 16) = vreg[u_]; } while (0)
#pragma unroll
        for (int u = 0; u < PFV; ++u) vreg[u] = (u32x4){0u, 0u, 0u, 0u};
#pragma unroll
        for (int u = 0; u < PFO; ++u) if (is_o) RC_LOAD_O(u, u);
#pragma unroll
        for (int u = 0; u < PFS; ++u) if (is_s) RC_LOAD_S(u, u);
#pragma unroll
        for (int u = 0; u < PFV; ++u) RC_LOAD_V(u, u);
        RC_STORE_V(0, 0);
        RC_LOAD_V(0, PFV);
        __syncthreads();
        const bf16_t* const att_b = att + ((size_t)(b * NCH) * 4 + h) * (C / 16) * KA * 512;
        const bf16_t* const hc_b = HC + (size_t)b * SEQ * LD;
        const bf16_t* const ke_b = keT + ((size_t)(b * NCH) * 4 + h) * (DK / 16) * KA * 512;
        const float* const dc_b = decay ? decay + ((size_t)(b * NCH) * 4 + h) * DK : nullptr;
        unsigned pa = (unsigned)((PFO * 4 * (C / 16) + nto) * KA * 512 + lane * 8);
        unsigned pq = (unsigned)((PFO * C + (nto * KQ) * QRPT + lane / QLPR) * LD + CQ + h * DK + (lane % QLPR) * 8);
        unsigned pk = (unsigned)((PFS * 4 * (DK / 16) + mts0) * KA * 512 + lane * 8);
        unsigned pd = (unsigned)(PFS * 4 * DK + 16 * mts0 + 4 * fq);
        unsigned pv = (unsigned)(((1 + PFV) * C + vrow) * LD + (int)vcol + vpart * 8);
        unsigned po = (unsigned)((16 * nto + fr) * LD + (int)vcol + 4 * fq);
#define RC_NEXT_O(u_) do { _Pragma("unroll") for (int ks = 0; ks < KA; ++ks) BA_(u_, ks) = *(const u32x4*)(att_b + pa + ks * 512); \
            _Pragma("unroll") for (int kq = 0; kq < KQ; ++kq) BQ_(u_, kq) = *(const u32x4*)(hc_b + pq + (kq * QRPT) * LD); \
            pa += 4u * (C / 16) * KA * 512; pq += (unsigned)(C * LD); asm volatile("" : "+v"(pa), "+v"(pq)); } while (0)
#define RC_NEXT_S(u_) do { _Pragma("unroll") for (int i = 0; i < 2; ++i) { _Pragma("unroll") for (int ks = 0; ks < KA; ++ks) KE_(u_, i, ks) = *(const u32x4*)(ke_b + pk + (i * KA + ks) * 512); \
                if (decay) DC_(u_, i) = *(const u32x4*)(dc_b + pd + 16 * i); } \
            pk += 4u * (DK / 16) * KA * 512; pd += 4u * DK; asm volatile("" : "+v"(pk), "+v"(pd)); } while (0)
#define RC_NEXT_V(u_) do { vreg[u_] = *(const u32x4*)(hc_b + pv); pv += (unsigned)(C * LD); asm volatile("" : "+v"(pv)); } while (0)
#define RC_VT(dst, mt_) do { _Pragma("unroll") for (int ks = 0; ks < KA; ++ks) { const LAS unsigned char* p0 = vb + cb * VBUF + trl + (32 * ks) * VP + (mt_) * 32; \
            const s16x4 lo = __builtin_amdgcn_ds_read_tr16_b64_v4i16((LAS s16x4*)p0), hi = __builtin_amdgcn_ds_read_tr16_b64_v4i16((LAS s16x4*)(p0 + 4 * VP)); \
            dst[ks] = (bf16x8){lo[0], lo[1], lo[2], lo[3], hi[0], hi[1], hi[2], hi[3]}; } } while (0)
#define RC_CHUNK(DO_O, DO_S) do { const int n = n0 + u; const int cb = u & 1, nb = cb ^ 1; \
            if (DO_O) { f32x4 ao[MTV]; \
                _Pragma("unroll") for (int mt = 0; mt < MTV; ++mt) { bf16x8 vT[KA]; RC_VT(vT, mt); ao[mt] = (f32x4){0.f, 0.f, 0.f, 0.f}; \
                    _Pragma("unroll") for (int ks = 0; ks < KA; ++ks) if (2 * ks <= nto) ao[mt] = __builtin_amdgcn_mfma_f32_16x16x32_bf16(vT[ks], __builtin_bit_cast(bf16x8, BA_(u % PFO, ks)), ao[mt], 0, 0, 0); \
                    _Pragma("unroll") for (int kq = 0; kq < KQ; ++kq) { const bf16x8 sa = *(const LAS bf16x8*)(sb + cb * SBUF + (16 * mt + fr) * SP + (32 * kq + 8 * fq) * 2); \
                        ao[mt] = __builtin_amdgcn_mfma_f32_16x16x32_bf16(sa, __builtin_bit_cast(bf16x8, BQ_(u % PFO, kq)), ao[mt], 0, 0, 0); } } \
                _Pragma("unroll") for (int mt = 0; mt < MTV; ++mt) *(u32x2*)(HC + (size_t)b * SEQ * LD + po + 16 * mt) = (u32x2){cvt_pk_bf16(ao[mt][0], ao[mt][1]), cvt_pk_bf16(ao[mt][2], ao[mt][3])}; \
                po += (unsigned)(C * LD); asm volatile("" : "+v"(po)); \
                RC_NEXT_O(u % PFO); } \
            if (DO_S) { \
                _Pragma("unroll") for (int nt = 0; nt < MTV; ++nt) { bf16x8 vT[KA]; RC_VT(vT, nt); \
                    _Pragma("unroll") for (int i = 0; i < 2; ++i) { f32x4 a = accS[i][nt]; \
                        if (decay) a = a * __builtin_bit_cast(f32x4, DC_(u % PFS, i)); else a = a * cdec; \
                        _Pragma("unroll") for (int ks = 0; ks < KA; ++ks) a = __builtin_amdgcn_mfma_f32_16x16x32_bf16(__builtin_bit_cast(bf16x8, KE_(u % PFS, i, ks)), vT[ks], a, 0, 0, 0); \
                        accS[i][nt] = a; \
                        *(LAS u32x2*)(sb + nb * SBUF + (16 * nt + fr) * SP + (16 * (mts0 + i) + 4 * fq) * 2) = (u32x2){cvt_pk_bf16(a[0], a[1]), cvt_pk_bf16(a[2], a[3])}; } } \
                RC_NEXT_S(u % PFS); } \
            if (DO_O) { if (n + 1 < NCH) RC_STORE_V(nb, (u + 1) % PFV); } \
            __syncthreads(); \
            if (DO_O) RC_NEXT_V((u + 1) % PFV); \
            __builtin_amdgcn_sched_barrier(0); } while (0)
        if (SPLIT) {
            if (is_o) {
#pragma unroll 1
                for (int n0 = 0; n0 < NCH; n0 += UNR) {
#pragma unroll
                    for (int u = 0; u < UNR; ++u) RC_CHUNK(true, false);
                }
            } else {
#pragma unroll 1
                for (int n0 = 0; n0 < NCH; n0 += UNR) {
#pragma unroll
                    for (int u = 0; u < UNR; ++u) RC_CHUNK(false, true);
                }
            }
        } else {
#pragma unroll 1
            for (int n0 = 0; n0 < NCH; n0 += UNR) {
#pragma unroll
                for (int u = 0; u < UNR; ++u) RC_CHUNK(true, true);
            }
        }
#undef RC_CHUNK
#undef RC_VT
#undef RC_LOAD_O
#undef RC_NEXT_O
#undef RC_NEXT_S
#undef RC_NEXT_V
#undef BA_
#undef BQ_
#undef KE_
#undef DC_
#undef RC_LOAD_S
#undef RC_LOAD_V
#undef RC_STORE_V
    }
    __syncthreads();
}

struct Args { const float* in[22]; float* out; unsigned char* ws; int ph_lo, ph_hi; };
constexpr int NPHASE = 23;

#define PHASE_IDS int tid = threadIdx.x; asm volatile("" : "+v"(tid)); const int lane = tid & 63, wave = __builtin_amdgcn_readfirstlane(tid >> 6), gw = blockIdx.x * NWAVES + wave, gtid = blockIdx.x * NTHREADS + tid; (void)lane; (void)gw; (void)gtid
__global__ void __launch_bounds__(NTHREADS, 2) fwd_kernel(Args args) {
    extern __shared__ __attribute__((aligned(16))) unsigned char lds_raw[];
    Frame F;
    F.lds = (LAS unsigned char*)lds_raw;
    F.tid = threadIdx.x; F.lane = threadIdx.x & 63; F.wave = __builtin_amdgcn_readfirstlane(threadIdx.x >> 6);
    F.G = gridDim.x; F.gw = 0; F.NGW = F.G * NWAVES;
    F.ws = args.ws; F.ctl = (gu32*)(args.ws + WS_CTL); F.out = args.out;
    volatile LAS unsigned* MISC = (volatile LAS unsigned*)(F.lds + LDSCTL_OFF);
    if (threadIdx.x < 64) MISC[threadIdx.x] = 0u;
    __syncthreads();
    const int lo = args.ph_lo, hi = args.ph_hi;
    const bool use_bar = (hi - lo) > 1;
    XcdBarrier bar; bar.bar = (unsigned*)(F.ctl + CW_BAR); bar.x = 0; bar.st = nullptr;
    if (use_bar) bar = xcd_barrier_post((unsigned*)(F.ctl + CW_BAR), MISC + 8);
#ifndef PHMASK
#define PHMASK 0x7fffff
#endif
#define IN(k) (((PHMASK >> (k)) & 1) && lo <= (k) && (k) < hi)
#ifndef PROBE_M1
#define PROBE_M1 0
#define PROBE_M2 0
#endif
#define STAMP(k) do { if ((PROBE_M1 | PROBE_M2) && blockIdx.x == 0 && threadIdx.x == 0) ((volatile LAS unsigned long long*)(F.lds + LDSCTL_OFF + 512))[k] = __builtin_amdgcn_s_memrealtime(); } while (0)
#define SEAM(k) do { if (IN(k) && IN((k) + 1)) xcd_barrier(bar); STAMP((k) + 1); } while (0)
    STAMP(0);
    unsigned char* const big = F.ws + WS_BIG;
    bf16_t* const XN = (bf16_t*)(F.ws + WS_XN);
    bf16_t* const HC0 = (bf16_t*)(big + B_HCAT0);
    bf16_t* const HC1 = (bf16_t*)(big + B_HCAT1);
    const int NT = F.G * NTHREADS;

    if (IN(0)) { PHASE_IDS;
        LAS float* scr = (LAS float*)(F.lds + wave * 9216);
        LAS bf16_t* wl = (LAS bf16_t*)(F.lds + 73728);
        { const float* wlr = inptr(I_WIN0) + W0_LR;
          for (int c = tid; c < D; c += NTHREADS) { const f32x4* wp = (const f32x4*)(wlr + (size_t)c * LDW0);
#pragma unroll
              for (int q = 0; q < 4; ++q) { const f32x4 w4 = wp[q]; wl[(4 * q) * 1032 + c] = (bf16_t)f2bf(w4.x); wl[(4 * q + 1) * 1032 + c] = (bf16_t)f2bf(w4.y); wl[(4 * q + 2) * 1032 + c] = (bf16_t)f2bf(w4.z); wl[(4 * q + 3) * 1032 + c] = (bf16_t)f2bf(w4.w); } } }
        __syncthreads();
        constexpr int I0 = (D / 64) * (LD0 / 32), I1 = (MIX0 / 64) * (D / 32), I2 = (D / 64) * (2 * FF0 / 32), I3 = (FF0 / 64) * (D / 32), I4 = (D / 64) * (LD1 / 32), I5 = (MIX1 / 64) * (D / 32);
        constexpr int NIT = I0 + I1 + I2 + I3 + I4 + I5;
        for (int it = gw; it < NIT; it += F.NGW) {
            int r = it;
            if (r < I0) { const int nblk = LD0 / 32, kb = r / nblk, nb = r % nblk, dr = 32 * nb; transpose_item(inptr(I_WIN0), LDW0, dr < W0_LR ? dr : dr + 16, (bf16_t*)(F.ws + WS_WIN0) + (size_t)kb * LD0 * 64 - 64 * kb, 64, dr, 64 * kb, scr, lane); continue; } r -= I0;
            if (r < I1) { transpose_plain(inptr(I_WOUT0), MIX0, D, (bf16_t*)(F.ws + WS_WOUT0), r, scr, lane); continue; } r -= I1;
            if (r < I2) { transpose_gateup(inptr(I_WFG), inptr(I_WFU), D, FF0, (bf16_t*)(F.ws + WS_WGU0), r, scr, lane, true); continue; } r -= I2;
            if (r < I3) { transpose_ktile(inptr(I_WFD), FF0, D, (bf16_t*)(F.ws + WS_WD0), r, scr, lane); continue; } r -= I3;
            if (r < I4) { transpose_ktile(inptr(I_WIN1), D, LD1, (bf16_t*)(F.ws + WS_WIN1), r, scr, lane); continue; } r -= I4;
            transpose_plain(inptr(I_WOUT1), MIX1, D, (bf16_t*)(F.ws + WS_WOUT1), r, scr, lane);
        }
        float* lr = (float*)(F.ws + WS_LR);
        const int fr = lane & 15, fq = lane >> 4;
        for (int g = gw; g < T / 16; g += F.NGW) {
            rmsnorm_rows(inptr(I_X), inptr(I_MN0), XN, 16 * g, 1, 16 * g + 16, lane, true);
            asm volatile("s_waitcnt vmcnt(0)" ::: "memory");
            f32x4 acc = (f32x4){0.f, 0.f, 0.f, 0.f};
            const bf16_t* ap = XN + (((size_t)((16 * g) >> 8) * 16) * 256 + ((16 * g + fr) & 255)) * 64 + 8 * fq;
#pragma unroll 8
            for (int ks = 0; ks < 32; ++ks) { const bf16x8 af = *(const bf16x8*)(ap + (size_t)(ks >> 1) * 256 * 64 + 32 * (ks & 1)); const bf16x8 bfr = *(const LAS bf16x8*)(wl + fr * 1032 + 32 * ks + 8 * fq);
                acc = __builtin_amdgcn_mfma_f32_16x16x32_bf16(af, bfr, acc, 0, 0, 0); }
#pragma unroll
            for (int j = 0; j < 4; ++j) lr[(size_t)(16 * g + 4 * fq + j) * 16 + fr] = acc[j];
        }
    }
    SEAM(0);

    if (IN(1)) { PHASE_IDS;
        pg8::DenseOrder S; S.init(T, LD0, F.G, (int)blockIdx.x); pg8::TiledMap MP{D / 64, LD0}; pg8::EpiBf16 E{HC0, LD0};
        pg8::gemm_phase(F.lds, XN, 64, (const bf16_t*)(F.ws + WS_WIN0), D, S, MP, E, 64, (size_t)256 * 128, (size_t)LD0 * 128);
    }
    SEAM(1);

    if (IN(2)) { PHASE_IDS;
        {
            const float* lr = (const float*)(F.ws + WS_LR); const float* wgu = inptr(I_WGATEUP); const float* bg = inptr(I_BGATE);
            bf16_t* att = (bf16_t*)(big + B_ATT0); bf16_t* kendT = (bf16_t*)(big + B_KENDT); float* decay = (float*)(F.ws + WS_DECAY);
            LAS bf16_t* qd_s = (LAS bf16_t*)F.lds;
            LAS bf16_t* ki_s = qd_s + 64 * 136;
            LAS float* grp = (LAS float*)(ki_s + 64 * 136);
            LAS float* lr_s = grp + 4 * 128;
            LAS bf16_t* qr_s = (LAS bf16_t*)(lr_s + 64 * 16);
            LAS bf16_t* kr_s = qr_s + 64 * 128;
            const int dk = tid & 127, sg = tid >> 7;
            const int fr = lane & 15, fq = lane >> 4, w = wave;
            const int h = (int)blockIdx.x & 3, col = h * 128 + dk;
            float w16[16];
#pragma unroll
            for (int r = 0; r < 16; ++r) w16[r] = wgu[r * 512 + col];
            const float bias = bg[col];
            u32x4 pq[2], pk[2], pl = (u32x4){0u, 0u, 0u, 0u};
#define P2_LOAD(unit_) do { const int t0_ = ((unit_) >> 2) * 64; _Pragma("unroll") for (int rep = 0; rep < 2; ++rep) { const bf16_t* rp_ = HC0 + (size_t)(t0_ + (tid >> 4) + 32 * rep) * LD0 + h * 128 + (tid & 15) * 8; \
                pq[rep] = *(const u32x4*)(rp_ + C0_QA); pk[rep] = *(const u32x4*)(rp_ + C0_KA); } \
                if (tid < 256) pl = *(const u32x4*)(lr + (size_t)t0_ * 16 + tid * 4); } while (0)
            if ((int)blockIdx.x < 2048) P2_LOAD((int)blockIdx.x);
            for (int unit = blockIdx.x; unit < 2048; unit += F.G) {
                const int bn = unit >> 2, t0 = bn * 64;
                __syncthreads();
#pragma unroll
                for (int rep = 0; rep < 2; ++rep) { *(LAS u32x4*)(qr_s + ((tid >> 4) + 32 * rep) * 128 + (tid & 15) * 8) = pq[rep]; *(LAS u32x4*)(kr_s + ((tid >> 4) + 32 * rep) * 128 + (tid & 15) * 8) = pk[rep]; }
                if (tid < 256) *(LAS u32x4*)(lr_s + tid * 4) = pl;
                __syncthreads();
                if (unit + F.G < 2048) P2_LOAD(unit + F.G);
                float cum[16]; float run = 0.f;
#pragma unroll
                for (int i = 0; i < 16; ++i) { const LAS f32x4* lp = (const LAS f32x4*)(lr_s + (16 * sg + i) * 16); float z = bias;
#pragma unroll
                    for (int q = 0; q < 4; ++q) { const f32x4 l4 = lp[q]; z += l4.x * w16[4 * q] + l4.y * w16[4 * q + 1] + l4.z * w16[4 * q + 2] + l4.w * w16[4 * q + 3]; }
                    run += logsigmoid_f(z) * (1.f / 16.f); cum[i] = run; }
                grp[sg * 128 + dk] = run;
                __syncthreads();
                float off = 0.f, total = 0.f;
#pragma unroll
                for (int g = 0; g < 4; ++g) { const float gs = grp[g * 128 + dk]; total += gs; off += (g < sg) ? gs : 0.f; }
                unsigned kep[8];
#pragma unroll
                for (int i = 0; i < 16; ++i) { const int s_ = 16 * sg + i, t = t0 + s_; const float c = off + cum[i];
                    const float q = bf2f(qr_s[s_ * 128 + dk]), k = bf2f(kr_s[s_ * 128 + dk]); (void)t;
                    const unsigned qdb = f2bf(q * __expf(c) * 0.08838834764831845f); qd_s[s_ * 136 + dk] = (bf16_t)qdb;
                    ki_s[s_ * 136 + dk] = (bf16_t)f2bf(k * __expf(-c));
                    const unsigned keb = f2bf(k * __expf(total - c)); if (i & 1) kep[i >> 1] |= keb << 16; else kep[i >> 1] = keb; }
                { bf16_t* kp = kendT + (((size_t)unit * 8 + (dk >> 4)) * 2 + (sg >> 1)) * 512 + (((sg & 1) * 2) * 16 + (dk & 15)) * 8;
                  *(u32x4*)kp = (u32x4){kep[0], kep[1], kep[2], kep[3]}; *(u32x4*)(kp + 128) = (u32x4){kep[4], kep[5], kep[6], kep[7]}; }
                if (sg == 0) decay[unit * 128 + dk] = __expf(total);
                __syncthreads();
                { const int nt = w & 3;
#pragma unroll
                  for (int i2 = 0; i2 < 2; ++i2) { const int mt = 2 * (w >> 2) + i2; f32x4 a = (f32x4){0.f, 0.f, 0.f, 0.f};
                      if (mt <= nt) {
#pragma unroll
                          for (int ks = 0; ks < 4; ++ks) { const bf16x8 ka = *(const LAS bf16x8*)(ki_s + (16 * mt + fr) * 136 + 32 * ks + 8 * fq), qb = *(const LAS bf16x8*)(qd_s + (16 * nt + fr) * 136 + 32 * ks + 8 * fq);
                              a = __builtin_amdgcn_mfma_f32_16x16x32_bf16(ka, qb, a, 0, 0, 0); }
#pragma unroll
                          for (int j = 0; j < 4; ++j) if (16 * mt + 4 * fq + j > 16 * nt + fr) a[j] = 0.f; }
                      *(u32x2*)(att + ((size_t)unit * 4 + nt) * 2 * 512 + (mt >> 1) * 512 + ((((mt & 1) * 2 + (fq >> 1)) * 16 + fr) * 8) + (fq & 1) * 4) = (u32x2){cvt_pk_bf16(a[0], a[1]), cvt_pk_bf16(a[2], a[3])}; } }
#pragma unroll
                for (int i2 = 0; i2 < 2; ++i2) { const int j = 2 * w + i2, rt = j >> 2, kt = j & 3; const u32x4 qv = *(const LAS u32x4*)(qd_s + (16 * rt + fr) * 136 + 32 * kt + 8 * fq);
                    *(u32x4*)(HC0 + (size_t)(t0 + 4 * j + (lane >> 4)) * LD0 + C0_KA + h * 128 + (lane & 15) * 8) = qv; }
            }
#undef P2_LOAD
            __syncthreads();
        }
    }
    SEAM(2);

    if (IN(3)) recur_phase<64, 128, 16, true, LD0, C0_KA, C0_VA, 256, 128, 2, 2, 2, 8>(F, HC0, (const bf16_t*)(big + B_ATT0), (const bf16_t*)(big + B_KENDT), (const float*)(F.ws + WS_DECAY));
    SEAM(3);

    if (IN(4)) dilated_phase(F, HC0, (bf16_t*)(F.ws + WS_XN), (bf16_t*)(big + B_OP2), (float*)(F.ws + WS_LSE));
    SEAM(4);

    if (IN(5)) { PHASE_IDS;
        const float* gn = inptr(I_GLANORM); const float* lse = (const float*)(F.ws + WS_LSE);
        float gw16[16];
#pragma unroll
        for (int e = 0; e < 16; ++e) gw16[e] = gn[(16 * lane + e) & 255];
        for (int t = gw; t < T; t += F.NGW) {
            bf16_t* row = HC0 + (size_t)t * LD0;
            { const u32x4* op = (const u32x4*)(row + C0_VA + 16 * lane); u32x4* rp = (u32x4*)(row + C0_RA + 16 * lane); float o[16], g[16];
#pragma unroll
              for (int c = 0; c < 2; ++c) { const u32x4 a = op[c], r4 = rp[c];
                  o[8 * c] = __uint_as_float(a.x << 16); o[8 * c + 1] = __uint_as_float(a.x & 0xffff0000u); o[8 * c + 2] = __uint_as_float(a.y << 16); o[8 * c + 3] = __uint_as_float(a.y & 0xffff0000u);
                  o[8 * c + 4] = __uint_as_float(a.z << 16); o[8 * c + 5] = __uint_as_float(a.z & 0xffff0000u); o[8 * c + 6] = __uint_as_float(a.w << 16); o[8 * c + 7] = __uint_as_float(a.w & 0xffff0000u);
                  g[8 * c] = __uint_as_float(r4.x << 16); g[8 * c + 1] = __uint_as_float(r4.x & 0xffff0000u); g[8 * c + 2] = __uint_as_float(r4.y << 16); g[8 * c + 3] = __uint_as_float(r4.y & 0xffff0000u);
                  g[8 * c + 4] = __uint_as_float(r4.z << 16); g[8 * c + 5] = __uint_as_float(r4.z & 0xffff0000u); g[8 * c + 6] = __uint_as_float(r4.w << 16); g[8 * c + 7] = __uint_as_float(r4.w & 0xffff0000u); }
              float ss = 0.f;
#pragma unroll
              for (int e = 0; e < 16; ++e) ss += o[e] * o[e];
              ss += __shfl_xor(ss, 1); ss += __shfl_xor(ss, 2); ss += __shfl_xor(ss, 4); ss += __shfl_xor(ss, 8);
              const float rs = 1.f / sqrtf(ss * (1.f / 256.f) + NORM_EPS);
#pragma unroll
              for (int e = 0; e < 16; ++e) o[e] = o[e] * rs * gw16[e] * silu_f(g[e]);
#pragma unroll
              for (int c = 0; c < 2; ++c) rp[c] = (u32x4){pk2(o[8 * c], o[8 * c + 1]), pk2(o[8 * c + 2], o[8 * c + 3]), pk2(o[8 * c + 4], o[8 * c + 5]), pk2(o[8 * c + 6], o[8 * c + 7])}; }
            { const int hh = lane >> 3; const float l0 = lse[((size_t)0 * T + t) * 8 + hh], l1 = lse[((size_t)1 * T + t) * 8 + hh], l2 = lse[((size_t)2 * T + t) * 8 + hh];
              const float mx = fmaxf(l0, fmaxf(l1, l2)); float w0 = __expf(l0 - mx), w1 = __expf(l1 - mx), w2 = __expf(l2 - mx); const float iw = 1.f / (w0 + w1 + w2); w0 *= iw; w1 *= iw; w2 *= iw;
              const u32x4 a = *(const u32x4*)((const bf16_t*)(F.ws + WS_XN) + (size_t)t * 512 + 8 * lane), bq = *(const u32x4*)((const bf16_t*)(F.ws + WS_XN) + (size_t)(T + t) * 512 + 8 * lane), c = *(const u32x4*)((const bf16_t*)(big + B_OP2) + (size_t)t * 512 + 8 * lane);
              float r[8];
              r[0] = w0 * __uint_as_float(a.x << 16) + w1 * __uint_as_float(bq.x << 16) + w2 * __uint_as_float(c.x << 16); r[1] = w0 * __uint_as_float(a.x & 0xffff0000u) + w1 * __uint_as_float(bq.x & 0xffff0000u) + w2 * __uint_as_float(c.x & 0xffff0000u);
              r[2] = w0 * __uint_as_float(a.y << 16) + w1 * __uint_as_float(bq.y << 16) + w2 * __uint_as_float(c.y << 16); r[3] = w0 * __uint_as_float(a.y & 0xffff0000u) + w1 * __uint_as_float(bq.y & 0xffff0000u) + w2 * __uint_as_float(c.y & 0xffff0000u);
              r[4] = w0 * __uint_as_float(a.z << 16) + w1 * __uint_as_float(bq.z << 16) + w2 * __uint_as_float(c.z << 16); r[5] = w0 * __uint_as_float(a.z & 0xffff0000u) + w1 * __uint_as_float(bq.z & 0xffff0000u) + w2 * __uint_as_float(c.z & 0xffff0000u);
              r[6] = w0 * __uint_as_float(a.w << 16) + w1 * __uint_as_float(bq.w << 16) + w2 * __uint_as_float(c.w << 16); r[7] = w0 * __uint_as_float(a.w & 0xffff0000u) + w1 * __uint_as_float(bq.w & 0xffff0000u) + w2 * __uint_as_float(c.w & 0xffff0000u);
              *(u32x4*)(row + C0_QB + 8 * lane) = (u32x4){pk2(r[0], r[1]), pk2(r[2], r[3]), pk2(r[4], r[5]), pk2(r[6], r[7])}; }
        }
    }
    SEAM(5);

    if (IN(6)) { PHASE_IDS;
        pg8::DenseOrder S; S.init(T, D, F.G, (int)blockIdx.x); pg8::PlainMap MP; pg8::EpiResF32 E{inptr(I_X), F.out, D};
        pg8::gemm_phase(F.lds, HC0 + C0_RA, LD0, (const bf16_t*)(F.ws + WS_WOUT0), MIX0, S, MP, E);
    }
    SEAM(6);

    if (IN(7)) { PHASE_IDS; rmsnorm_rows(F.out, inptr(I_FN0), XN, gw, F.NGW, T, lane, true); }
    SEAM(7);

    if (IN(8)) { PHASE_IDS;
        pg8::DenseOrder S; S.init(T, 2 * FF0, F.G, (int)blockIdx.x); pg8::TiledMap MP{D / 64, 2 * FF0}; pg8::EpiSwiGLU E{(bf16_t*)(big + B_H0), FF0};
        pg8::gemm_phase(F.lds, XN, 64, (const bf16_t*)(F.ws + WS_WGU0), D, S, MP, E, 64, (size_t)256 * 128, (size_t)2 * FF0 * 128);
    }
    SEAM(8);

    if (IN(9)) { PHASE_IDS;
        pg8::DenseOrder S; S.init(T, D, F.G, (int)blockIdx.x); pg8::TiledMap MP{FF0 / 64, D}; pg8::EpiResF32 E{F.out, F.out, D};
        pg8::gemm_phase(F.lds, (const bf16_t*)(big + B_H0), 64, (const bf16_t*)(F.ws + WS_WD0), FF0, S, MP, E, 64, (size_t)256 * 128, (size_t)D * 128);
    }
    SEAM(9);

    if (IN(10)) { PHASE_IDS; rmsnorm_rows(F.out, inptr(I_MN1), XN, gw, F.NGW, T, lane, true); }
    SEAM(10);

    if (IN(11)) { PHASE_IDS;
        pg8::DenseOrder S; S.init(T, LD1, F.G, (int)blockIdx.x); pg8::TiledMap MP{D / 64, LD1}; pg8::EpiBf16 E{HC1, LD1};
        pg8::gemm_phase(F.lds, XN, 64, (const bf16_t*)(F.ws + WS_WIN1), D, S, MP, E, 64, (size_t)256 * 128, (size_t)LD1 * 128);
    }
    SEAM(11);

    if (IN(12)) { PHASE_IDS;
        bf16_t* att = (bf16_t*)(big + B_ATT1); bf16_t* kdT = (bf16_t*)(F.ws + WS_XN);
        LAS bf16_t* qd_s = (LAS bf16_t*)F.lds;
        LAS bf16_t* ki_s = qd_s + 128 * 264;
        const int dk = tid & 255, sg = tid >> 8;
        const int fr = lane & 15, fq = lane >> 4, w = wave;
        LAS float* dtab = (LAS float*)(F.lds + LDSCTL_OFF + 2048);
        { const float lg0 = log1pf(-exp2f(-5.f - (float)((int)blockIdx.x & 3)));
          if (tid < 128) { dtab[3 * tid] = __expf(lg0 * (float)(tid + 1)); dtab[3 * tid + 1] = __expf(-lg0 * (float)(tid + 1)); dtab[3 * tid + 2] = __expf(lg0 * (float)(127 - tid)) * 0.0625f; } }
        __syncthreads();
        for (int unit = blockIdx.x; unit < 1024; unit += F.G) {
            const int h = unit & 3, bn = unit >> 2, t0 = bn * 128;
            __syncthreads();
            bf16_t qc[8], kc[8], qn[8], kn[8];
#define P12_LOAD(dq, dkk, i8_) do { _Pragma("unroll") for (int i = 0; i < 8; ++i) { const size_t t_ = (size_t)(t0 + 64 * sg + 8 * (i8_) + i); \
                dq[i] = HC1[t_ * LD1 + C1_Q + h * 256 + dk]; dkk[i] = HC1[t_ * LD1 + C1_K + h * 256 + dk]; } } while (0)
            P12_LOAD(qc, kc, 0);
#pragma unroll 1
            for (int i8 = 0; i8 < 8; ++i8) {
                if (i8 < 7) P12_LOAD(qn, kn, i8 + 1);
                unsigned kp[4];
#pragma unroll
                for (int i = 0; i < 8; ++i) { const int s_ = 64 * sg + 8 * i8 + i;
                    const float q = bf2f(qc[i]), k = bf2f(kc[i]);
                    const unsigned qdb = f2bf(q * dtab[3 * s_]); qd_s[s_ * 264 + dk] = (bf16_t)qdb;
                    ki_s[s_ * 264 + dk] = (bf16_t)f2bf(k * dtab[3 * s_ + 1]);
                    const unsigned kdb = f2bf(k * dtab[3 * s_ + 2]); if (i & 1) kp[i >> 1] |= kdb << 16; else kp[i >> 1] = kdb; }
                { const int s0 = 64 * sg + 8 * i8;
                  *(u32x4*)(kdT + (((size_t)unit * 16 + (dk >> 4)) * 4 + (s0 >> 5)) * 512 + ((((s0 & 31) >> 3) * 16 + (dk & 15)) * 8)) = (u32x4){kp[0], kp[1], kp[2], kp[3]}; }
#pragma unroll
                for (int i = 0; i < 8; ++i) { qc[i] = qn[i]; kc[i] = kn[i]; }
            }
#undef P12_LOAD
            __syncthreads();
#pragma unroll 1
            for (int L = w; L < 36; L += 8) { int nt = 0; while ((nt + 1) * (nt + 2) / 2 <= L) ++nt; const int mt = L - nt * (nt + 1) / 2;
                f32x4 a = (f32x4){0.f, 0.f, 0.f, 0.f};
#pragma unroll
                for (int ks = 0; ks < 8; ++ks) { const bf16x8 ka = *(const LAS bf16x8*)(ki_s + (16 * mt + fr) * 264 + 32 * ks + 8 * fq), qb = *(const LAS bf16x8*)(qd_s + (16 * nt + fr) * 264 + 32 * ks + 8 * fq);
                    a = __builtin_amdgcn_mfma_f32_16x16x32_bf16(ka, qb, a, 0, 0, 0); }
#pragma unroll
                for (int j = 0; j < 4; ++j) a[j] = (16 * mt + 4 * fq + j > 16 * nt + fr) ? 0.f : a[j] * 0.0625f;
                *(u32x2*)(att + ((size_t)unit * 8 + nt) * 4 * 512 + (mt >> 1) * 512 + ((((mt & 1) * 2 + (fq >> 1)) * 16 + fr) * 8) + (fq & 1) * 4) = (u32x2){cvt_pk_bf16(a[0], a[1]), cvt_pk_bf16(a[2], a[3])}; }
            if (w < 4) { const int nt = 2 * w, mt = 2 * w + 1;
                *(u32x2*)(att + ((size_t)unit * 8 + nt) * 4 * 512 + (mt >> 1) * 512 + ((((mt & 1) * 2 + (fq >> 1)) * 16 + fr) * 8) + (fq & 1) * 4) = (u32x2){0u, 0u}; }
#pragma unroll 1
            for (int j = w; j < 64; j += 8) { const int rt = j >> 3, kt = j & 7; const u32x4 qv = *(const LAS u32x4*)(qd_s + (16 * rt + fr) * 264 + 32 * kt + 8 * fq);
                *(u32x4*)(HC1 + (size_t)(t0 + 2 * j + (lane >> 5)) * LD1 + C1_K + h * 256 + (lane & 31) * 8) = qv; }
        }
        __syncthreads();
    }
    SEAM(12);

    if (IN(13)) recur_phase<128, 256, 32, false, LD1, C1_K, C1_V, 512, 64, 2, 1, 2, 8>(F, HC1, (const bf16_t*)(big + B_ATT1), (const bf16_t*)(F.ws + WS_XN), nullptr);
    SEAM(13);

    if (IN(14)) { PHASE_IDS;
        const float* gnw = inptr(I_RETGN);
        float gw32[32];
#pragma unroll
        for (int c = 0; c < 8; ++c) { const f32x4 w4 = *(const f32x4*)(gnw + 32 * lane + 4 * c); gw32[4 * c] = w4.x; gw32[4 * c + 1] = w4.y; gw32[4 * c + 2] = w4.z; gw32[4 * c + 3] = w4.w; }
        u32x4 co[4], cg[4], no[4], ng[4];
#define P14_LOAD(do_, dg_, t_) do { const bf16_t* row_ = HC1 + (size_t)(t_) * LD1; _Pragma("unroll") for (int c = 0; c < 4; ++c) { do_[c] = *(const u32x4*)(row_ + C1_V + 32 * lane + 8 * c); dg_[c] = *(const u32x4*)(row_ + C1_G + 32 * lane + 8 * c); } } while (0)
        if (gw < T) P14_LOAD(co, cg, gw);
        for (int t = gw; t < T; t += F.NGW) {
            const int tn = t + F.NGW;
            if (tn < T) P14_LOAD(no, ng, tn);
            float o[32]; float s = 0.f;
#pragma unroll
            for (int c = 0; c < 4; ++c) { float x[8]; unpack8(co[c], x);
#pragma unroll
                for (int e = 0; e < 8; ++e) { o[8 * c + e] = x[e]; s += x[e]; } }
            s += __shfl_xor(s, 1); s += __shfl_xor(s, 2); s += __shfl_xor(s, 4); s += __shfl_xor(s, 8);
            const float mu = s * (1.f / 512.f); float q = 0.f;
#pragma unroll
            for (int e = 0; e < 32; ++e) { o[e] -= mu; q += o[e] * o[e]; }
            q += __shfl_xor(q, 1); q += __shfl_xor(q, 2); q += __shfl_xor(q, 4); q += __shfl_xor(q, 8);
            const float rs = 1.f / sqrtf(q * (1.f / 512.f) + GN_EPS);
            u32x4* gp = (u32x4*)(HC1 + (size_t)t * LD1 + C1_G + 32 * lane);
#pragma unroll
            for (int c = 0; c < 4; ++c) { float g[8], r[8]; unpack8(cg[c], g);
#pragma unroll
                for (int e = 0; e < 8; ++e) r[e] = o[8 * c + e] * rs * gw32[8 * c + e] * g[e] * __builtin_amdgcn_rcpf(1.f + __expf(-g[e]));
                gp[c] = (u32x4){pk2(r[0], r[1]), pk2(r[2], r[3]), pk2(r[4], r[5]), pk2(r[6], r[7])}; }
#pragma unroll
            for (int c = 0; c < 4; ++c) { co[c] = no[c]; cg[c] = ng[c]; }
        }
#undef P14_LOAD
    }
    SEAM(14);

    if (IN(15)) { PHASE_IDS;
        pg8::DenseOrder S; S.init(T, D, F.G, (int)blockIdx.x); pg8::PlainMap MP; pg8::EpiResF32 E{F.out, F.out, D};
        pg8::gemm_phase(F.lds, HC1 + C1_G, LD1, (const bf16_t*)(F.ws + WS_WOUT1), MIX1, S, MP, E);
    }
    SEAM(15);

    if (IN(16)) { PHASE_IDS;
        LAS float* scr = (LAS float*)(F.lds + wave * 9216);
        LAS float* wrs = (LAS float*)(F.lds + 73728);
        LAS float* rowb = (LAS float*)(F.lds + 106496 + wave * 4096);
        { const float* wr_ = inptr(I_WROUTER); for (int i = tid; i < D * 8 / 4; i += NTHREADS) ((LAS f32x4*)wrs)[i] = ((const f32x4*)wr_)[i]; }
        LAS unsigned* mcnt = (LAS unsigned*)(F.lds + LDSCTL_OFF + 1024);
        if (tid < 32) mcnt[tid] = 0u;
        __syncthreads();
        constexpr int IGU = (D / 64) * (2 * FFE / 32), IDN = (FFE / 64) * (D / 32);
        for (int it = gw; it < NEXP * (IGU + IDN); it += F.NGW) {
            const int e = it / (IGU + IDN), r = it % (IGU + IDN);
            if (r < IGU) transpose_gateup(inptr(I_WEG) + (size_t)e * D * FFE, inptr(I_WEU) + (size_t)e * D * FFE, D, FFE, (bf16_t*)(big + B_WEGU) + (size_t)e * 2 * FFE * D, r, scr, lane);
            else transpose_ktile(inptr(I_WED) + (size_t)e * FFE * D, FFE, D, (bf16_t*)(big + B_WED) + (size_t)e * D * FFE, r - IGU, scr, lane);
        }
        int* rowtok = (int*)(F.ws + WS_ROUTE + R_ROWTOK); float* rowgate = (float*)(F.ws + WS_ROUTE + R_ROWGATE);
        for (int i = gtid; i < 2 * MOE_ROWS; i += NT) { rowtok[i] = -1; rowgate[i] = 0.f; }
        f32x4* tokinfo = (f32x4*)(F.ws + WS_ROUTE + R_TOKINFO);
        f32x4 cur[4], nxt[4];
        if (gw < T) row_load(F.out + (size_t)gw * D, lane, cur);
        for (int m = gw; m < T; m += F.NGW) {
            const int mn = m + F.NGW;
            if (mn < T) row_load(F.out + (size_t)mn * D, lane, nxt);
            rmsnorm_finish(inptr(I_FN1), XN + (size_t)m * D, lane, cur);
#pragma unroll
            for (int j = 0; j < 4; ++j) *(LAS f32x4*)(rowb + 256 * j + 4 * lane) = cur[j];
            float a[8];
#pragma unroll
            for (int r = 0; r < 8; ++r) a[r] = 0.f;
#pragma unroll 4
            for (int i = 0; i < 16; ++i) { const int c = 64 * i + lane; const float xv = rowb[c]; const f32x4 w0 = *(const LAS f32x4*)(wrs + c * 8), w1 = *(const LAS f32x4*)(wrs + c * 8 + 4);
                a[0] += xv * w0.x; a[1] += xv * w0.y; a[2] += xv * w0.z; a[3] += xv * w0.w; a[4] += xv * w1.x; a[5] += xv * w1.y; a[6] += xv * w1.z; a[7] += xv * w1.w; }
            { float b4[4], b2[2], b1;
#pragma unroll
              for (int r = 0; r < 4; ++r) { const float keep = (lane & 1) ? a[2 * r + 1] : a[2 * r], give = (lane & 1) ? a[2 * r] : a[2 * r + 1]; b4[r] = keep + __shfl_xor(give, 1); }
#pragma unroll
              for (int r = 0; r < 2; ++r) { const float keep = (lane & 2) ? b4[2 * r + 1] : b4[2 * r], give = (lane & 2) ? b4[2 * r] : b4[2 * r + 1]; b2[r] = keep + __shfl_xor(give, 2); }
              { const float keep = (lane & 4) ? b2[1] : b2[0], give = (lane & 4) ? b2[0] : b2[1]; b1 = keep + __shfl_xor(give, 4); }
              b1 += __shfl_xor(b1, 8); b1 += __shfl_xor(b1, 16); b1 += __shfl_xor(b1, 32);
#pragma unroll
              for (int r = 0; r < 8; ++r) a[r] = __shfl(b1, r); }
            int e0 = 0; float l0 = a[0];
#pragma unroll
            for (int r = 1; r < 8; ++r) if (a[r] > l0) { l0 = a[r]; e0 = r; }
            int e1 = -1; float l1 = -3.4e38f;
#pragma unroll
            for (int r = 0; r < 8; ++r) if (r != e0 && a[r] > l1) { l1 = a[r]; e1 = r; }
            const float g0 = 1.f / (1.f + __expf(l1 - l0));
            if (lane == 0) { const unsigned r0 = __hip_atomic_fetch_add(mcnt + e0, 1u, __ATOMIC_RELAXED, __HIP_MEMORY_SCOPE_WORKGROUP);
                const unsigned r1 = __hip_atomic_fetch_add(mcnt + 8 + e1, 1u, __ATOMIC_RELAXED, __HIP_MEMORY_SCOPE_WORKGROUP);
                tokinfo[m] = (f32x4){__int_as_float(e0 | (e1 << 4)), __uint_as_float(r0), __uint_as_float(r1), g0}; }
#pragma unroll
            for (int j = 0; j < 4; ++j) cur[j] = nxt[j];
        }
        asm volatile("s_waitcnt vmcnt(0)" ::: "memory");
        __syncthreads();
        if (tid < 16) mcnt[16 + tid] = __hip_atomic_fetch_add((unsigned*)(F.ctl + CW_MOE + 64 * tid), mcnt[tid], __ATOMIC_RELAXED, __HIP_MEMORY_SCOPE_AGENT);
        __syncthreads();
        for (int r = tid; r < (T + F.NGW - 1) / F.NGW * NWAVES; r += NTHREADS) { const int m = (int)blockIdx.x * NWAVES + (r % NWAVES) + F.NGW * (r / NWAVES);
            if (m < T) { f32x4 ti = tokinfo[m]; const int ee = __float_as_int(ti.x); ti.y = __uint_as_float(__float_as_uint(ti.y) + mcnt[16 + (ee & 15)]); ti.z = __uint_as_float(__float_as_uint(ti.z) + mcnt[24 + (ee >> 4)]); tokinfo[m] = ti; } }
    }
    SEAM(16);

    if (IN(17)) { PHASE_IDS;
        const f32x4* tokinfo = (const f32x4*)(F.ws + WS_ROUTE + R_TOKINFO);
        int* rowtok = (int*)(F.ws + WS_ROUTE + R_ROWTOK); float* rowgate = (float*)(F.ws + WS_ROUTE + R_ROWGATE);
        int* blkexp = (int*)(F.ws + WS_ROUTE + R_BLKEXP); int* nblk = (int*)(F.ws + WS_ROUTE + R_NBLK);
        LAS int* pst = (LAS int*)F.lds;
        if (tid < 2) { int ps = 0, nb = 0;
            for (int e = 0; e < 8; ++e) { pst[tid * 8 + e] = ps; const int c = (int)__hip_atomic_load((unsigned*)(F.ctl + CW_MOE + 64 * (tid * 8 + e)), __ATOMIC_RELAXED, __HIP_MEMORY_SCOPE_AGENT), bl = (c + 255) >> 8;
                if (blockIdx.x == 0) for (int j = 0; j < bl; ++j) blkexp[tid * MOE_BLKS + nb + j] = e;
                nb += bl; ps += bl * 256; }
            if (blockIdx.x == 0) nblk[tid] = nb; }
        __syncthreads();
        for (int tok = gtid; tok < T; tok += NT) { const f32x4 ti = tokinfo[tok]; const int ee = __float_as_int(ti.x), e0 = ee & 15, e1 = ee >> 4;
            const int r0 = pst[e0] + (int)__float_as_uint(ti.y), r1 = pst[8 + e1] + (int)__float_as_uint(ti.z);
            rowtok[r0] = tok; rowgate[r0] = ti.w; rowtok[MOE_ROWS + r1] = tok; rowgate[MOE_ROWS + r1] = 1.f - ti.w; }
        __syncthreads();
    }
    SEAM(17);

#pragma unroll
    for (int slot = 0; slot < 2; ++slot) {
        if (IN(18 + 2 * slot)) { PHASE_IDS;
            const int* rowtok = (const int*)(F.ws + WS_ROUTE + R_ROWTOK) + slot * MOE_ROWS; const int* blkexp = (const int*)(F.ws + WS_ROUTE + R_BLKEXP) + slot * MOE_BLKS;
            const int nb = ((const int*)(F.ws + WS_ROUTE + R_NBLK))[slot];
            if (slot == 1) { const int nb0 = ((const int*)(F.ws + WS_ROUTE + R_NBLK))[0];
                if (nb0 > 128) ovf_reduce((const float*)(F.ws + WS_WIN0), (nb0 - 128) * 4, (const int*)(F.ws + WS_ROUTE + R_ROWTOK), (const float*)(F.ws + WS_ROUTE + R_ROWGATE), F.out, gtid, NT); }
            MoeOrder S; S.init(nb, 2 * FFE / 256, F.G, (int)blockIdx.x); pg8::MoeMap MP{rowtok, blkexp, 2 * FFE, 256, 0u, 0}; pg8::EpiSwiGLU E{(bf16_t*)(big + B_HMOE), FFE};
            pg8::gemm_phase(F.lds, XN, D, (const bf16_t*)(big + B_WEGU), D, S, MP, E);
        }
        SEAM(18 + 2 * slot);
        if (IN(19 + 2 * slot)) { PHASE_IDS;
            const int* rowtok = (const int*)(F.ws + WS_ROUTE + R_ROWTOK) + slot * MOE_ROWS; const float* rowgate = (const float*)(F.ws + WS_ROUTE + R_ROWGATE) + slot * MOE_ROWS;
            const int* blkexp = (const int*)(F.ws + WS_ROUTE + R_BLKEXP) + slot * MOE_BLKS; const int nb = ((const int*)(F.ws + WS_ROUTE + R_NBLK))[slot];
            const int nmain = nb < 128 ? nb : 128;
            { MoeOrder S; S.init(nmain, D / 256, F.G, (int)blockIdx.x); pg8::MoeMap MP{nullptr, blkexp, (FFE / 64) * D, (FFE / 64) * 256, 0u, 0}; pg8::EpiMoeDown E{F.out, rowtok, rowgate};
              pg8::gemm_phase(F.lds, (const bf16_t*)(big + B_HMOE), 64, (const bf16_t*)(big + B_WED), FFE, S, MP, E, 64, (size_t)256 * 128, (size_t)D * 128); }
            if (nb > 128) { OvfOrder S{(nb - 128) * (D / 256), F.G, (int)blockIdx.x}; pg8::MoeMap MP{nullptr, blkexp, (FFE / 64) * D, (FFE / 64) * 256, (unsigned)(OVF_K / 64) * 256u * 128u, (size_t)(OVF_K / 64) * D * 128}; pg8::EpiPartial E{(float*)(F.ws + WS_WIN0), OVF_NKS};
              pg8::gemm_phase(F.lds, (const bf16_t*)(big + B_HMOE), 64, (const bf16_t*)(big + B_WED), OVF_K, S, MP, E, 64, (size_t)256 * 128, (size_t)D * 128); }
        }
        SEAM(19 + 2 * slot);
    }
    if (IN(22)) { PHASE_IDS; const int nb1 = ((const int*)(F.ws + WS_ROUTE + R_NBLK))[1];
        if (nb1 > 128) ovf_reduce((const float*)(F.ws + WS_WIN0), (nb1 - 128) * 4, (const int*)(F.ws + WS_ROUTE + R_ROWTOK) + MOE_ROWS, (const float*)(F.ws + WS_ROUTE + R_ROWGATE) + MOE_ROWS, F.out, gtid, NT); }
    if ((PROBE_M1 | PROBE_M2) && blockIdx.x == 0 && threadIdx.x == 0) {
        STAMP(23);
        volatile LAS unsigned long long* ts = (volatile LAS unsigned long long*)(F.lds + LDSCTL_OFF + 512);
        unsigned long long t1 = 0, t2 = 0;
        for (int k = 0; k < 23; ++k) { const unsigned long long dt = ts[k + 1] - ts[k]; if ((PROBE_M1 >> k) & 1) t1 += dt; if ((PROBE_M2 >> k) & 1) t2 += dt; }
        const unsigned long long wait = 16ull * t1 + 0ull * t2, t0 = __builtin_amdgcn_s_memrealtime();
        while (__builtin_amdgcn_s_memrealtime() - t0 < wait) __builtin_amdgcn_s_sleep(8);
    }
#undef IN
#undef SEAM
}

#ifndef N_LAUNCH_MODE
#define N_LAUNCH_MODE 1
#endif
extern "C" void kernel_launch(void* const* d_in, const int* in_sizes, int n_in, void* d_out, int out_size, void* d_ws, size_t ws_size, hipStream_t stream) {
    static int grid = 0;
    if (grid == 0) {
        if (n_in != 22 || out_size != T * D || ws_size < WS_END) { fprintf(stderr, "kernel_launch: unexpected shapes (n_in %d out %d ws %zu need %zu)\n", n_in, out_size, ws_size, (size_t)WS_END); grid = -1; return; }
        int dev = 0, cus = 0, per_cu = 0;
        if (hipGetDevice(&dev) != hipSuccess || hipDeviceGetAttribute(&cus, hipDeviceAttributeMultiprocessorCount, dev) != hipSuccess) { grid = -1; return; }
        if (hipFuncSetAttribute((const void*)fwd_kernel, hipFuncAttributeMaxDynamicSharedMemorySize, LDS_BYTES) != hipSuccess) { fprintf(stderr, "kernel_launch: hipFuncSetAttribute failed\n"); grid = -1; return; }
        if (hipOccupancyMaxActiveBlocksPerMultiprocessor(&per_cu, (const void*)fwd_kernel, NTHREADS, LDS_BYTES) != hipSuccess || per_cu < 1) { fprintf(stderr, "kernel_launch: occupancy query says %d\n", per_cu); (void)hipGetLastError(); grid = -1; return; }
        grid = cus & ~3;
    }
    if (grid < 0) return;
    (void)hipMemsetAsync((char*)d_ws + WS_CTL, 0, CTL_ZERO_BYTES, stream);
    Args a{};
    for (int i = 0; i < 22; ++i) a.in[i] = (const float*)d_in[i];
    a.out = (float*)d_out; a.ws = (unsigned char*)d_ws;
#if N_LAUNCH_MODE == 1
    a.ph_lo = 0; a.ph_hi = NPHASE;
    hipLaunchKernelGGL(fwd_kernel, dim3(grid), dim3(NTHREADS), LDS_BYTES, stream, a);
#else
    for (int p = 0; p < NPHASE; ++p) { a.ph_lo = p; a.ph_hi = p + 1; hipLaunchKernelGGL(fwd_kernel, dim3(grid), dim3(NTHREADS), LDS_BYTES, stream, a); }
#endif
}
```

```cpp
#include <hip/hip_runtime.h>
#include <cstdio>
#include <cstdint>

#define LAS __attribute__((address_space(3)))
#define GAS __attribute__((address_space(1)))
typedef unsigned short bf16_t;
typedef short bf16x8 __attribute__((ext_vector_type(8)));
typedef float f32x4 __attribute__((ext_vector_type(4)));
typedef float f32x2 __attribute__((ext_vector_type(2)));
typedef unsigned u32x4 __attribute__((ext_vector_type(4)));
typedef unsigned u32x2 __attribute__((ext_vector_type(2)));
typedef GAS unsigned gu32;
#define RLX_AGENT __ATOMIC_RELAXED, __HIP_MEMORY_SCOPE_AGENT
#define LDS_WAIT() asm volatile("s_waitcnt lgkmcnt(0)" ::: "memory")
#define VM_WAIT() asm volatile("s_waitcnt vmcnt(0)" ::: "memory")

constexpr int NBATCH = 4, SEQ = 8192, T = NBATCH * SEQ, D = 1024;
constexpr float NORM_EPS = 1e-6f, GN_EPS = 1e-5f;
constexpr int LDW0 = 4624, LD0 = 4608;
constexpr int C0_QA = 0, C0_KA = 512, C0_VA = 1024, C0_RA = 2048, C0_QB = 3072, C0_KB = 3584, C0_VB = 4096;
constexpr int W0_LR = 3072;
constexpr int MIX0 = 1536, FF0 = 2816;
constexpr int LD1 = 6144, C1_Q = 0, C1_K = 1024, C1_V = 2048, C1_G = 4096, MIX1 = 2048;
constexpr int NEXP = 8, FFE = 3584;
constexpr int MOE_ROWS = 34816, MOE_BLKS = 136;

constexpr size_t MiB = 1u << 20;
constexpr size_t WS_CTL = 0, CTL_ZERO_BYTES = 64 * 1024;
constexpr size_t WS_WIN0 = 1 * MiB, WS_WOUT0 = 10 * MiB, WS_WGU0 = 13 * MiB, WS_WD0 = 24 * MiB, WS_WIN1 = 30 * MiB, WS_WOUT1 = 42 * MiB;
constexpr size_t WS_LR = 46 * MiB, WS_DECAY = 48 * MiB, WS_LSE = 49 * MiB, WS_ROUTE = 52 * MiB;
constexpr size_t WS_XN = 56 * MiB;
constexpr size_t WS_BIG = 120 * MiB;
constexpr size_t B_HCAT0 = 0, B_ATT0 = 288 * MiB, B_KENDT = 304 * MiB, B_OP2 = 336 * MiB;
constexpr size_t B_H0 = 0;
constexpr size_t B_HCAT1 = 0, B_ATT1 = 384 * MiB;
constexpr size_t B_WEGU = 0, B_WED = 112 * MiB, B_HMOE = 168 * MiB;
constexpr size_t WS_END = WS_BIG + 416 * MiB;
constexpr size_t R_TOKINFO = 0, R_ROWTOK = 512 * 1024, R_ROWGATE = R_ROWTOK + 2 * MOE_ROWS * 4, R_BLKEXP = R_ROWGATE + 2 * MOE_ROWS * 4, R_NBLK = R_BLKEXP + 2 * MOE_BLKS * 4;
constexpr int CW_TMO = 0, CW_CODE = 1, CW_BAR = 4096, CW_MOE = 8192;

constexpr int LDS_BYTES = 147456;
constexpr int RING_BYTES = 131072;
constexpr int LDSCTL_OFF = 139264;
constexpr int NWAVES = 8, NTHREADS = 512;

__device__ __forceinline__ float bf2f(bf16_t b) { return __uint_as_float(((unsigned)b) << 16); }
typedef __bf16 bf16v2_t __attribute__((ext_vector_type(2)));
__device__ __forceinline__ unsigned cvt_pk_bf16(float lo, float hi) { const bf16v2_t r = __builtin_convertvector((f32x2){lo, hi}, bf16v2_t); return __builtin_bit_cast(unsigned, r); }
__device__ __forceinline__ unsigned pk2(float lo, float hi) { return cvt_pk_bf16(lo, hi); }
__device__ __forceinline__ unsigned f2bf(float f) { return cvt_pk_bf16(f, 0.f) & 0xffffu; }
__device__ __forceinline__ float bfround(float f) { return __uint_as_float(cvt_pk_bf16(f, 0.f) << 16); }
__device__ __forceinline__ float wave_sum(float v) {
#pragma unroll
    for (int o = 1; o < 64; o <<= 1) v += __shfl_xor(v, o);
    return v;
}
__device__ __forceinline__ float silu_f(float v) { return v * __builtin_amdgcn_rcpf(1.f + __expf(-v)); }
__device__ __forceinline__ float logsigmoid_f(float z) { return fminf(z, 0.f) - 0.6931471805599453f * __builtin_amdgcn_logf(1.f + __builtin_amdgcn_exp2f(-1.4426950408889634f * fabsf(z))); }

#define XB_TMO      128
#define XB_XCNT(j)  (256  + 64 * (j))
#define XB_XSUB(j)  (1280 + 64 * (j))
#define XB_XGEN(j)  (2304 + 64 * (j))
#define XB_TOP      3328
#define XB_TOPGEN   3392
#define XCD_BAR_WORDS 3456
#define XB_SPIN_CAP (1u << 22)
__device__ __forceinline__ unsigned xb_ld(unsigned* p)              { return __hip_atomic_load(p, __ATOMIC_RELAXED, __HIP_MEMORY_SCOPE_AGENT); }
__device__ __forceinline__ unsigned xb_add(unsigned* p, unsigned v) { return __hip_atomic_fetch_add(p, v, __ATOMIC_RELAXED, __HIP_MEMORY_SCOPE_AGENT); }
__device__ __forceinline__ unsigned xb_xcc_id() { return (unsigned)__builtin_amdgcn_s_getreg((3 << 11) | 20) & 0xFu; }
#define XB_SPIN(cond, bar) do { unsigned _sp = 0; while (cond) { __builtin_amdgcn_s_sleep(1); \
    if ((++_sp & 255u) == 0u) { if (xb_ld(&(bar)[XB_TMO])) break; if (_sp > XB_SPIN_CAP) { atomicAdd(&(bar)[XB_TMO], 1u); break; } } } } while (0)
struct XcdBarrier { unsigned* bar; unsigned x; volatile LAS unsigned* st; };
__device__ __forceinline__ XcdBarrier xcd_barrier_post(unsigned* bar, volatile LAS unsigned* st) {
    XcdBarrier b; b.bar = bar; b.x = xb_xcc_id(); b.st = st;
    if (threadIdx.x == 0) (void)xb_add(&bar[XB_XCNT(b.x)], 1u);
    return b;
}
__device__ __forceinline__ void xcd_barrier_complete(unsigned* bar, unsigned x, unsigned& nloc, unsigned& nx) {
    const unsigned G = gridDim.x * gridDim.y * gridDim.z;
    unsigned sum, cnt, mine, sp = 0u;
    for (;;) {
        sum = 0u; cnt = 0u; mine = 0u;
#pragma unroll
        for (unsigned j = 0; j < 16; ++j) { const unsigned c = xb_ld(&bar[XB_XCNT(j)]); sum += c; cnt += (c > 0u) ? 1u : 0u; mine = (j == x) ? c : mine; }
        if (sum == G) break;
        __builtin_amdgcn_s_sleep(1);
        if ((++sp & 255u) == 0u) { if (xb_ld(&bar[XB_TMO])) break; if (sp > XB_SPIN_CAP) { atomicAdd(&bar[XB_TMO], 1u); break; } }
    }
    nloc = mine > 0u ? mine : 1u; nx = cnt > 0u ? cnt : 1u;
}
__device__ __forceinline__ void xcd_barrier(const XcdBarrier& b) {
    asm volatile("s_waitcnt vmcnt(0)" ::: "memory");
    __syncthreads();
    if (threadIdx.x == 0) {
        unsigned* bar = b.bar;
        __builtin_amdgcn_s_waitcnt(0);
        unsigned nloc = b.st[0], nx = b.st[1];
        if (nloc == 0u) { xcd_barrier_complete(bar, b.x, nloc, nx); b.st[0] = nloc; b.st[1] = nx; }
        const unsigned old = xb_add(&bar[XB_XSUB(b.x)], 1u);
        const unsigned gen = old / nloc;
        if (old + 1u == (gen + 1u) * nloc) {
            __builtin_amdgcn_fence(__ATOMIC_RELEASE, "agent");
            asm volatile("s_waitcnt vmcnt(0)" ::: "memory");
            const unsigned og = xb_add(&bar[XB_TOP], 1u);
            const unsigned tg = og / nx;
            if (og + 1u == (tg + 1u) * nx) xb_add(&bar[XB_TOPGEN], 1u);
            else XB_SPIN(xb_ld(&bar[XB_TOPGEN]) == tg, bar);
            __builtin_amdgcn_fence(__ATOMIC_ACQUIRE, "agent");
            xb_add(&bar[XB_XGEN(b.x)], 1u);
            asm volatile("s_waitcnt vmcnt(0)" ::: "memory");
        } else {
            XB_SPIN(xb_ld(&bar[XB_XGEN(b.x)]) == gen, bar);
            __builtin_amdgcn_fence(__ATOMIC_ACQUIRE, "agent");
            asm volatile("s_waitcnt vmcnt(0)" ::: "memory");
        }
    }
    __syncthreads();
}

namespace pg8 {
constexpr int BM = 256, BK = 64, HALF = 128, HTB = HALF * BK * 2, STAGE_BYTES = 8 * HTB;
__device__ __forceinline__ int lds_byte(int r, int c) { const int st = (r >> 4) * 2 + (c >> 5), rr = r & 15, cc = c & 31, ob = rr * 64 + cc * 2; return st * 1024 + (ob ^ (((ob >> 9) & 1) << 5)); }
__device__ __forceinline__ void stage_rc(int b, int& R, int& C) { const int st = b / 1024, sb = b % 1024, swz = sb ^ (((sb >> 9) & 1) << 5); R = (st >> 1) * 16 + swz / 64; C = (st & 1) * 32 + (swz % 64) / 2; }
__device__ __forceinline__ int perm32(int rho) { const int n = rho >> 4, i = rho & 15; return 8 * (i >> 2) + 4 * n + (i & 3); }
struct Unit { int pm, pn, ks; };

struct DenseOrder {
    int nM, nN, nwg, G, c;
    __device__ void init(int M, int N, int G_, int c_) { nM = M / BM; nN = N / BM; nwg = nM * nN; G = G_; c = c_; }
    __device__ bool next(int i, Unit& u) const {
        const long L = (long)i * G + c; if (L >= nwg) return false;
        int wgid = (int)L; { const int q = nwg / 8, r = nwg % 8, xcd = wgid % 8, off = wgid / 8; wgid = (xcd < r ? xcd * (q + 1) : r * (q + 1) + (xcd - r) * q) + off; }
        const int nig = 4 * nN, gid = wgid / nig, fm = gid * 4, gsz = (nM - fm) < 4 ? (nM - fm) : 4;
        u.pm = fm + ((wgid % nig) % gsz); u.pn = (wgid % nig) / gsz; u.ks = 0; return true;
    }
};
struct PlainMap {
    __device__ __forceinline__ unsigned arow(int pm, int r) const { return (unsigned)(pm * BM + r); }
    __device__ __forceinline__ size_t brow0(const Unit& u) const { return (size_t)u.pn * BM; }
    __device__ __forceinline__ unsigned koffA(const Unit&) const { return 0u; }
    __device__ __forceinline__ size_t koffB(const Unit&) const { return 0; }
    __device__ __forceinline__ int araw(int pm, int r) const { return pm * BM + r; }
    __device__ __forceinline__ unsigned afix(int raw) const { return (unsigned)raw; }
    __device__ __forceinline__ int braw(const Unit&) const { return 0; }
    __device__ __forceinline__ size_t bfix(int, const Unit& u) const { return (size_t)u.pn * BM; }
};
struct TiledMap {
    int nkt, nrows_b;
    __device__ __forceinline__ unsigned arow(int pm, int r) const { return (unsigned)(pm * nkt * BM + r); }
    __device__ __forceinline__ size_t brow0(const Unit& u) const { return (size_t)u.pn * BM; }
    __device__ __forceinline__ unsigned koffA(const Unit&) const { return 0u; }
    __device__ __forceinline__ size_t koffB(const Unit&) const { return 0; }
    __device__ __forceinline__ int araw(int pm, int r) const { return pm * nkt * BM + r; }
    __device__ __forceinline__ unsigned afix(int raw) const { return (unsigned)raw; }
    __device__ __forceinline__ int braw(const Unit&) const { return 0; }
    __device__ __forceinline__ size_t bfix(int, const Unit& u) const { return (size_t)u.pn * BM; }
};
struct MoeMap {
    const int* rowtok; const int* blkexp; int nexp_rows;
    __device__ __forceinline__ unsigned arow(int pm, int r) const { if (!rowtok) return (unsigned)(pm * atile + r); const int t = rowtok[pm * BM + r]; return (unsigned)(t < 0 ? 0 : t); }
    __device__ __forceinline__ size_t brow0(const Unit& u) const { return (size_t)blkexp[u.pm] * nexp_rows + (size_t)u.pn * BM; }
    __device__ __forceinline__ unsigned koffA(const Unit& u) const { return (unsigned)u.ks * kslA; }
    __device__ __forceinline__ size_t koffB(const Unit& u) const { return (size_t)u.ks * kslB; }
    __device__ __forceinline__ int araw(int pm, int r) const { if (!rowtok) return pm * atile + r; int v; const int* p = rowtok + pm * BM + r; asm volatile("global_load_dword %0, %1, off" : "=v"(v) : "v"(p) : "memory"); return v; }
    __device__ __forceinline__ unsigned afix(int raw) const { return (unsigned)(raw < 0 ? 0 : raw); }
    __device__ __forceinline__ int braw(const Unit& u) const { int v; const int* p = blkexp + u.pm; asm volatile("global_load_dword %0, %1, off" : "=v"(v) : "v"(p) : "memory"); return v; }
    __device__ __forceinline__ size_t bfix(int e, const Unit& u) const { return (size_t)e * nexp_rows + (size_t)u.pn * BM; }
    int atile; unsigned kslA; size_t kslB;
};

template <class Epi, class Sched, class Map>
__device__ __forceinline__ void gemm_phase(LAS unsigned char* lds, const bf16_t* A, int lda, const bf16_t* Bt, int K, const Sched& S, const Map& MP, const Epi& E, int ldb = 0, size_t kstepA = BK * 2, size_t kstepB = BK * 2) {
    if (ldb == 0) ldb = K;
    int tid_ = threadIdx.x; asm volatile("" : "+v"(tid_));
    const int tid = tid_, wid = __builtin_amdgcn_readfirstlane(tid >> 6), lane = tid & 63, wr = wid >> 2, wc = wid & 3, fr = lane & 15, fq = lane >> 4;
    const int nt = K / BK;
    unsigned voffB[2];
#pragma unroll
    for (int i = 0; i < 2; ++i) { int R, C; stage_rc(tid * 16 + i * 8192, R, C); const int Rb = Epi::PERM ? ((R & ~31) + perm32(R & 31)) : R; voffB[i] = (unsigned)(Rb * ldb + C) * 2u; }
    const size_t hstepB = (size_t)HALF * ldb * 2;
    const unsigned ldsw = (unsigned)wid * 1024u;
    const int aoff = lds_byte(wr * 64 + fr, fq * 8), boff = lds_byte(wc * 32 + fr, fq * 8);
#define PG8_SA(b, h) (((b) * 2 + (h)) * HTB)
#define PG8_SB(b, h) ((4 + (b) * 2 + (h)) * HTB)
#define PG8_STAGE(bufoff, gbase, voff) do { _Pragma("unroll") for (int _i = 0; _i < 2; ++_i) \
        __builtin_amdgcn_global_load_lds((const unsigned*)((const char*)(gbase) + (voff)[_i]), (LAS unsigned*)(lds + (bufoff) + ldsw + _i * 8192), 16, 0, 0); } while (0)
#define PG8_LDA(dst, b, h) do { _Pragma("unroll") for (int m = 0; m < 4; ++m) _Pragma("unroll") for (int k = 0; k < 2; ++k) dst[m][k] = *(const LAS bf16x8*)(lds + PG8_SA(b, h) + aoff + m * 2048 + k * 1024); } while (0)
#define PG8_LDB(dst, b, h) do { _Pragma("unroll") for (int n = 0; n < 2; ++n) _Pragma("unroll") for (int k = 0; k < 2; ++k) dst[n][k] = *(const LAS bf16x8*)(lds + PG8_SB(b, h) + boff + n * 2048 + k * 1024); } while (0)
#define PG8_MMA(ai, bj, At, Bt_) do { __builtin_amdgcn_s_setprio(1); _Pragma("unroll") for (int m = 0; m < 4; ++m) _Pragma("unroll") for (int n = 0; n < 2; ++n) _Pragma("unroll") for (int k = 0; k < 2; ++k) \
        acc[ai][bj][m][n] = __builtin_amdgcn_mfma_f32_16x16x32_bf16(Bt_[n][k], At[m][k], acc[ai][bj][m][n], 0, 0, 0); __builtin_amdgcn_s_setprio(0); } while (0)
#define PG8_WAIT_V(n) asm volatile("s_waitcnt vmcnt(" #n ")" ::: "memory")
#define PG8_WAIT_L(n) asm volatile("s_waitcnt lgkmcnt(" #n ")" ::: "memory")
#define PG8_BAR __builtin_amdgcn_s_barrier()
#define PG8_SCHED __builtin_amdgcn_sched_barrier(0)
#define PG8_VOFFA(dst, u_) do { _Pragma("unroll") for (int _i = 0; _i < 2; ++_i) { int _R, _C; stage_rc(tid * 16 + _i * 8192, _R, _C); _Pragma("unroll") for (int _h = 0; _h < 2; ++_h) \
        dst[_h][_i] = (MP.arow((u_).pm, _h * HALF + _R) * (unsigned)lda + (unsigned)_C) * 2u + MP.koffA(u_); } } while (0)
#define PG8_STAGE2(bufoff, gbase, va, vb, sel) do { _Pragma("unroll") for (int _i = 0; _i < 2; ++_i) \
        __builtin_amdgcn_global_load_lds((const unsigned*)((const char*)(gbase) + ((sel) ? (vb)[_i] : (va)[_i])), (LAS unsigned*)(lds + (bufoff) + ldsw + _i * 8192), 16, 0, 0); } while (0)
    Unit cur, nxt; int ui = 0;
    if (!S.next(0, cur)) return;
    f32x4 acc[2][2][4][2];
#pragma unroll
    for (int a = 0; a < 2; ++a)
#pragma unroll
        for (int b = 0; b < 2; ++b)
#pragma unroll
            for (int m = 0; m < 4; ++m)
#pragma unroll
                for (int n = 0; n < 2; ++n) acc[a][b][m][n] = (f32x4){0.f, 0.f, 0.f, 0.f};
    bf16x8 At[4][2], B0[2][2], B1[2][2];
    unsigned vc[2][2], vn[2][2];
    PG8_VOFFA(vc, cur);
    const char* cA = (const char*)A; const char* cB = (const char*)Bt + MP.brow0(cur) * (size_t)ldb * 2 + MP.koffB(cur);
    PG8_STAGE(PG8_SB(0, 0), cB, voffB); PG8_STAGE(PG8_SB(0, 1), cB + hstepB, voffB); PG8_STAGE(PG8_SA(0, 0), cA, vc[0]); PG8_STAGE(PG8_SA(0, 1), cA, vc[1]);
    if (wr == 1) PG8_BAR;
    PG8_WAIT_V(2); PG8_BAR;
    PG8_STAGE(PG8_SB(1, 0), cB + kstepB, voffB); PG8_STAGE(PG8_SA(1, 0), cA + kstepA, vc[0]); PG8_STAGE(PG8_SB(1, 1), cB + hstepB + kstepB, voffB);
    PG8_WAIT_V(6); PG8_BAR;
    for (;;) {
        const bool has_next = S.next(ui + 1, nxt);
        if (!has_next) nxt = cur;
        int rawB = MP.braw(nxt);
#pragma unroll
        for (int _i = 0; _i < 2; ++_i) { int _R, _C; stage_rc(tid * 16 + _i * 8192, _R, _C);
#pragma unroll
            for (int _h = 0; _h < 2; ++_h) vn[_h][_i] = (unsigned)MP.araw(nxt.pm, _h * HALF + _R); }
        const char* nB = cB;
        for (int t = 0; t < nt; t += 2) {
            const bool last = (t == nt - 2);
            const char* a1 = cA + (size_t)(t + 1) * kstepA;
            const char* a2 = last ? cA : cA + (size_t)(t + 2) * kstepA; const char* b2 = last ? nB : cB + (size_t)(t + 2) * kstepB;
            const char* a3 = a2 + kstepA; const char* b3 = b2 + kstepB;
            PG8_LDB(B0, 0, 0); PG8_LDB(B1, 0, 1); PG8_SCHED; PG8_LDA(At, 0, 0); PG8_STAGE(PG8_SA(1, 1), a1, vc[1]);
            PG8_WAIT_V(8); PG8_WAIT_L(0); PG8_BAR; PG8_MMA(0, 0, At, B0); PG8_MMA(0, 1, At, B1); PG8_BAR; PG8_SCHED;
            PG8_LDA(At, 0, 1); PG8_STAGE(PG8_SB(0, 0), b2, voffB); PG8_STAGE(PG8_SB(0, 1), b2 + hstepB, voffB); PG8_STAGE2(PG8_SA(0, 0), a2, vc[0], vn[0], last);
            PG8_WAIT_V(8); PG8_WAIT_L(0); PG8_BAR; PG8_MMA(1, 0, At, B0); PG8_MMA(1, 1, At, B1); PG8_BAR; PG8_SCHED;
            PG8_LDB(B0, 1, 0); PG8_LDB(B1, 1, 1); PG8_SCHED; PG8_LDA(At, 1, 0); PG8_STAGE2(PG8_SA(0, 1), a2, vc[1], vn[1], last);
            PG8_WAIT_V(8); PG8_WAIT_L(0); PG8_BAR; PG8_MMA(0, 0, At, B0); PG8_MMA(0, 1, At, B1); PG8_BAR; PG8_SCHED;
            PG8_LDA(At, 1, 1); PG8_STAGE(PG8_SB(1, 0), b3, voffB); PG8_STAGE(PG8_SB(1, 1), b3 + hstepB, voffB); PG8_STAGE2(PG8_SA(1, 0), a3, vc[0], vn[0], last);
            PG8_WAIT_V(8); PG8_WAIT_L(0); PG8_BAR; PG8_MMA(1, 0, At, B0); PG8_MMA(1, 1, At, B1); PG8_BAR; PG8_SCHED;
            { int first_ = (t == 0) ? 1 : 0; asm volatile("" : "+v"(first_)); first_ = __builtin_amdgcn_readfirstlane(first_);
              if (first_) {
                  asm volatile("" : "+v"(vn[0][0]), "+v"(vn[0][1]), "+v"(vn[1][0]), "+v"(vn[1][1]), "+v"(rawB));
#pragma unroll
                  for (int _i = 0; _i < 2; ++_i) { int _R, _C; stage_rc(tid * 16 + _i * 8192, _R, _C);
#pragma unroll
                      for (int _h = 0; _h < 2; ++_h) vn[_h][_i] = (MP.afix((int)vn[_h][_i]) * (unsigned)lda + (unsigned)_C) * 2u + MP.koffA(nxt); }
                  nB = (const char*)Bt + MP.bfix(__builtin_amdgcn_readfirstlane(rawB), nxt) * (size_t)ldb * 2 + MP.koffB(nxt); } }
        }
        if (wr == 0) PG8_BAR;
        E(acc, cur, wr, wc, fr, fq);
        if (!has_next) break;
#pragma unroll
        for (int a = 0; a < 2; ++a)
#pragma unroll
            for (int b = 0; b < 2; ++b)
#pragma unroll
                for (int m = 0; m < 4; ++m)
#pragma unroll
                    for (int n = 0; n < 2; ++n) acc[a][b][m][n] = (f32x4){0.f, 0.f, 0.f, 0.f};
        cur = nxt; cB = nB; ++ui;
#pragma unroll
        for (int h = 0; h < 2; ++h)
#pragma unroll
            for (int i = 0; i < 2; ++i) vc[h][i] = vn[h][i];
        if (wr == 1) PG8_BAR;
    }
    PG8_WAIT_V(0);
    PG8_BAR;
#undef PG8_SA
#undef PG8_SB
#undef PG8_STAGE
#undef PG8_LDA
#undef PG8_LDB
#undef PG8_MMA
#undef PG8_WAIT_V
#undef PG8_WAIT_L
#undef PG8_BAR
#undef PG8_SCHED
#undef PG8_VOFFA
#undef PG8_STAGE2
}

struct EpiBf16 {
    static constexpr bool PERM = true;
    bf16_t* O; int ldc;
    __device__ __forceinline__ void operator()(const f32x4 (&acc)[2][2][4][2], const Unit& u, int wr, int wc, int fr, int fq) const {
        const int row0 = u.pm * BM + wr * 64 + fr, col0 = u.pn * BM + wc * 32 + 8 * fq;
#pragma unroll
        for (int ai = 0; ai < 2; ++ai)
#pragma unroll
            for (int m = 0; m < 4; ++m) { bf16_t* rowp = O + (size_t)(row0 + ai * HALF + m * 16) * ldc + col0;
#pragma unroll
                for (int bj = 0; bj < 2; ++bj) { const f32x4 v0 = acc[ai][bj][m][0], v1 = acc[ai][bj][m][1];
                    u32x4 w; w.x = cvt_pk_bf16(v0[0], v0[1]); w.y = cvt_pk_bf16(v0[2], v0[3]); w.z = cvt_pk_bf16(v1[0], v1[1]); w.w = cvt_pk_bf16(v1[2], v1[3]);
                    __builtin_nontemporal_store(w, (u32x4*)(rowp + bj * HALF)); } }
    }
};
struct EpiSwiGLU {
    static constexpr bool PERM = true;
    bf16_t* H; int ldh;
    __device__ __forceinline__ void operator()(const f32x4 (&acc)[2][2][4][2], const Unit& u, int wr, int wc, int fr, int fq) const {
        const int col0 = u.pn * HALF + wc * 32 + 8 * fq;
        bf16_t* tile = H + (((size_t)u.pm * (ldh >> 6) + (col0 >> 6)) * BM + wr * 64 + fr) * 64 + (col0 & 63);
#pragma unroll
        for (int ai = 0; ai < 2; ++ai)
#pragma unroll
            for (int m = 0; m < 4; ++m) { bf16_t* rowp = tile + (size_t)(ai * HALF + m * 16) * 64;
                f32x4 h0, h1;
#pragma unroll
                for (int j = 0; j < 4; ++j) { const float g0 = acc[ai][0][m][0][j], g1 = acc[ai][0][m][1][j];
                    h0[j] = g0 * __builtin_amdgcn_rcpf(1.f + __builtin_amdgcn_exp2f(-g0)) * acc[ai][1][m][0][j]; h1[j] = g1 * __builtin_amdgcn_rcpf(1.f + __builtin_amdgcn_exp2f(-g1)) * acc[ai][1][m][1][j]; }
                u32x4 w; w.x = cvt_pk_bf16(h0[0], h0[1]); w.y = cvt_pk_bf16(h0[2], h0[3]); w.z = cvt_pk_bf16(h1[0], h1[1]); w.w = cvt_pk_bf16(h1[2], h1[3]);
                __builtin_nontemporal_store(w, (u32x4*)rowp); }
    }
};
struct EpiResF32 {
    static constexpr bool PERM = false;
    const float* base; float* out; int ldc;
    __device__ __forceinline__ void operator()(const f32x4 (&acc)[2][2][4][2], const Unit& u, int wr, int wc, int fr, int fq) const {
        const int row0 = u.pm * BM + wr * 64 + fr, col0 = u.pn * BM + wc * 32 + 4 * fq;
#pragma unroll
        for (int ai = 0; ai < 2; ++ai)
#pragma unroll
            for (int m = 0; m < 4; ++m) { const size_t off = (size_t)(row0 + ai * HALF + m * 16) * ldc + col0;
#pragma unroll
                for (int bj = 0; bj < 2; ++bj)
#pragma unroll
                    for (int n = 0; n < 2; ++n) { const f32x4 bs = *(const f32x4*)(base + off + bj * HALF + n * 16); __builtin_nontemporal_store(bs + acc[ai][bj][m][n], (f32x4*)(out + off + bj * HALF + n * 16)); } }
    }
};
template <bool F32BASE>
struct EpiResB {
    static constexpr bool PERM = true;
    const float* basef; const bf16_t* baseb; bf16_t* out; int ldc;
    __device__ __forceinline__ void operator()(const f32x4 (&acc)[2][2][4][2], const Unit& u, int wr, int wc, int fr, int fq) const {
        const int row0 = u.pm * BM + wr * 64 + fr, col0 = u.pn * BM + wc * 32 + 8 * fq;
#pragma unroll
        for (int ai = 0; ai < 2; ++ai)
#pragma unroll
            for (int m = 0; m < 4; ++m) { const size_t off = (size_t)(row0 + ai * HALF + m * 16) * ldc + col0;
#pragma unroll
                for (int bj = 0; bj < 2; ++bj) { f32x4 v0 = acc[ai][bj][m][0], v1 = acc[ai][bj][m][1];
                    if (F32BASE) { v0 = v0 + *(const f32x4*)(basef + off + bj * HALF); v1 = v1 + *(const f32x4*)(basef + off + bj * HALF + 4); }
                    else { const u32x4 raw = *(const u32x4*)(baseb + off + bj * HALF);
                        v0 = v0 + (f32x4){__uint_as_float(raw.x << 16), __uint_as_float(raw.x & 0xffff0000u), __uint_as_float(raw.y << 16), __uint_as_float(raw.y & 0xffff0000u)};
                        v1 = v1 + (f32x4){__uint_as_float(raw.z << 16), __uint_as_float(raw.z & 0xffff0000u), __uint_as_float(raw.w << 16), __uint_as_float(raw.w & 0xffff0000u)}; }
                    u32x4 w; w.x = cvt_pk_bf16(v0[0], v0[1]); w.y = cvt_pk_bf16(v0[2], v0[3]); w.z = cvt_pk_bf16(v1[0], v1[1]); w.w = cvt_pk_bf16(v1[2], v1[3]);
                    *(u32x4*)(out + off + bj * HALF) = w; } }
    }
};
template <bool FINAL>
struct EpiMoeDownB {
    static constexpr bool PERM = true;
    bf16_t* R; float* out; const int* rowtok; const float* rowgate;
    __device__ __forceinline__ void operator()(const f32x4 (&acc)[2][2][4][2], const Unit& u, int wr, int wc, int fr, int fq) const {
        const int row0 = u.pm * BM + wr * 64 + fr, col0 = u.pn * BM + wc * 32 + 8 * fq;
#pragma unroll
        for (int ai = 0; ai < 2; ++ai)
#pragma unroll
            for (int m = 0; m < 4; ++m) { const int r = row0 + ai * HALF + m * 16; const int tok = rowtok[r]; const float g = rowgate[r];
                if (tok >= 0) { const size_t off = (size_t)tok * D + col0;
#pragma unroll
                    for (int bj = 0; bj < 2; ++bj) { const u32x4 raw = *(const u32x4*)(R + off + bj * HALF);
                        const f32x4 v0 = g * acc[ai][bj][m][0] + (f32x4){__uint_as_float(raw.x << 16), __uint_as_float(raw.x & 0xffff0000u), __uint_as_float(raw.y << 16), __uint_as_float(raw.y & 0xffff0000u)};
                        const f32x4 v1 = g * acc[ai][bj][m][1] + (f32x4){__uint_as_float(raw.z << 16), __uint_as_float(raw.z & 0xffff0000u), __uint_as_float(raw.w << 16), __uint_as_float(raw.w & 0xffff0000u)};
                        if (FINAL) { __builtin_nontemporal_store(v0, (f32x4*)(out + off + bj * HALF)); __builtin_nontemporal_store(v1, (f32x4*)(out + off + bj * HALF + 4)); }
                        else { u32x4 w; w.x = cvt_pk_bf16(v0[0], v0[1]); w.y = cvt_pk_bf16(v0[2], v0[3]); w.z = cvt_pk_bf16(v1[0], v1[1]); w.w = cvt_pk_bf16(v1[2], v1[3]); *(u32x4*)(R + off + bj * HALF) = w; } } } }
    }
};
struct EpiMoeDown {
    static constexpr bool PERM = false;
    float* out; const int* rowtok; const float* rowgate;
    __device__ __forceinline__ void operator()(const f32x4 (&acc)[2][2][4][2], const Unit& u, int wr, int wc, int fr, int fq) const {
        const int row0 = u.pm * BM + wr * 64 + fr, col0 = u.pn * BM + wc * 32 + 4 * fq;
#pragma unroll
        for (int ai = 0; ai < 2; ++ai)
#pragma unroll
            for (int m = 0; m < 4; ++m) { const int r = row0 + ai * HALF + m * 16; const int tok = rowtok[r]; const float g = rowgate[r];
                if (tok >= 0) { float* op = out + (size_t)tok * D + col0;
#pragma unroll
                    for (int bj = 0; bj < 2; ++bj)
#pragma unroll
                        for (int n = 0; n < 2; ++n) { const f32x4 bs = *(const f32x4*)(op + bj * HALF + n * 16); *(f32x4*)(op + bj * HALF + n * 16) = bs + g * acc[ai][bj][m][n]; } } }
    }
};
struct EpiPartial {
    static constexpr bool PERM = false;
    float* part; int nks;
    __device__ __forceinline__ void operator()(const f32x4 (&acc)[2][2][4][2], const Unit& u, int wr, int wc, int fr, int fq) const {
        float* base = part + ((size_t)(((u.pm - 128) * 4 + u.pn) * nks + u.ks) << 16) + (size_t)(wr * 64 + fr) * BM + wc * 32 + 4 * fq;
#pragma unroll
        for (int ai = 0; ai < 2; ++ai)
#pragma unroll
            for (int m = 0; m < 4; ++m)
#pragma unroll
                for (int bj = 0; bj < 2; ++bj)
#pragma unroll
                    for (int n = 0; n < 2; ++n) *(f32x4*)(base + (size_t)(ai * HALF + m * 16) * BM + bj * HALF + n * 16) = acc[ai][bj][m][n];
    }
};
}

struct MoeOrder : pg8::DenseOrder {
    __device__ void init(int nblk, int nN_, int G_, int c_) { nM = nblk; nN = nN_; nwg = nblk * nN_; G = G_; c = c_; }
};

__device__ __forceinline__ int ovf_nks(int nov) { return nov * 7 <= 180 ? 7 : 4; }
struct OvfOrder { int nov, G, c, nks;
    __device__ bool next(int i, pg8::Unit& u) const { const int s = i * G + c; if (s >= nov * nks) return false; const int r = s / nks; u.ks = s - r * nks; u.pm = 128 + (r >> 2); u.pn = r & 3; return true; } };
__device__ __forceinline__ void ovf_reduce(const float* part, int nov, const int* rowtok, const float* rowgate, float* out, int gtid, int NT, int nks = 4) {
    for (int i = gtid; i < nov * 16384; i += NT) { const int r = i >> 14, e = i & 16383, row = e >> 6, c4 = (e & 63) * 4, pm = 128 + (r >> 2), pn = r & 3;
        const int tok = rowtok[pm * 256 + row]; if (tok < 0) continue;
        const float* p = part + ((size_t)(r * nks) << 16) + row * 256 + c4; f32x4 a = *(const f32x4*)p;
        for (int ks = 1; ks < nks; ++ks) a = a + *(const f32x4*)(p + ((size_t)ks << 16));
        float* op = out + (size_t)tok * D + pn * 256 + c4; *(f32x4*)op = *(const f32x4*)op + rowgate[pm * 256 + row] * a; }
}

template <bool FINAL>
__device__ __forceinline__ void ovf_reduce_b(const float* part, int nov, const int* rowtok, const float* rowgate, bf16_t* R, float* out, int gtid, int NT) { const int nks = ovf_nks(nov);
    for (int i = gtid; i < nov * 16384; i += NT) { const int r = i >> 14, e = i & 16383, row = e >> 6, c4 = (e & 63) * 4, pm = 128 + (r >> 2), pn = r & 3;
        const int tok = rowtok[pm * 256 + row]; if (tok < 0) continue;
        const float* p = part + ((size_t)(r * nks) << 16) + row * 256 + c4; f32x4 a = *(const f32x4*)p;
        for (int ks = 1; ks < nks; ++ks) a = a + *(const f32x4*)(p + ((size_t)ks << 16));
        const size_t off = (size_t)tok * D + pn * 256 + c4; const u32x2 raw = *(const u32x2*)(R + off);
        const f32x4 v = rowgate[pm * 256 + row] * a + (f32x4){__uint_as_float(raw.x << 16), __uint_as_float(raw.x & 0xffff0000u), __uint_as_float(raw.y << 16), __uint_as_float(raw.y & 0xffff0000u)};
        if (FINAL) __builtin_nontemporal_store(v, (f32x4*)(out + off)); else *(u32x2*)(R + off) = (u32x2){cvt_pk_bf16(v[0], v[1]), cvt_pk_bf16(v[2], v[3])}; }
}

struct Frame {
    LAS unsigned char* lds;
    gu32* ctl;
    int tid, lane, wave, G, gw, NGW;
    unsigned char* ws;
    float* out;
};
__device__ __forceinline__ const float* inptr(int i) {
    unsigned off = (unsigned)i * 8u; asm volatile("" : "+s"(off));
    return *(const float* const*)((const char*)__builtin_amdgcn_kernarg_segment_ptr() + off);
}
enum { I_X = 0, I_MN0, I_WIN0, I_WGATEUP, I_BGATE, I_GLANORM, I_QNORM, I_KNORM, I_WOUT0, I_FN0, I_WFG, I_WFU, I_WFD, I_MN1, I_WIN1, I_RETGN, I_WOUT1, I_FN1, I_WROUTER, I_WEG, I_WEU, I_WED };

struct TItem { const float* W; bf16_t* WT; int ldw, src_col0, ldt, dst_row0, k0; float scale; };
__device__ __forceinline__ void titem_load(const TItem& I, int lane, f32x4 (&v)[8]) {
    const float* p = I.W + (size_t)(I.k0 + (lane >> 3)) * I.ldw + I.src_col0 + 4 * (lane & 7);
#pragma unroll
    for (int i = 0; i < 8; ++i) v[i] = *(const f32x4*)(p + (size_t)(8 * i) * I.ldw);
}
__device__ __forceinline__ void titem_finish(const TItem& I, LAS float* scr, int lane, const f32x4 (&v)[8]) {
#pragma unroll
    for (int i = 0; i < 8; ++i) { LAS float* d = scr + ((lane >> 3) + 8 * i) * 33 + 4 * (lane & 7); d[0] = v[i].x; d[1] = v[i].y; d[2] = v[i].z; d[3] = v[i].w; }
    LDS_WAIT(); asm volatile("" ::: "memory");
    const int c = lane & 7; const float scale = I.scale;
#pragma unroll
    for (int j = 0; j < 4; ++j) { const int n = (lane >> 3) + 8 * j; const LAS float* s = scr + (8 * c) * 33 + n;
        u32x4 o; o.x = pk2(s[0 * 33] * scale, s[1 * 33] * scale); o.y = pk2(s[2 * 33] * scale, s[3 * 33] * scale); o.z = pk2(s[4 * 33] * scale, s[5 * 33] * scale); o.w = pk2(s[6 * 33] * scale, s[7 * 33] * scale);
        *(u32x4*)(I.WT + (size_t)(I.dst_row0 + n) * I.ldt + I.k0 + 8 * c) = o; }
    LDS_WAIT(); asm volatile("" ::: "memory");
}
__device__ __forceinline__ TItem titem_raw(const float* W, int ldw, int src_col0, bf16_t* WT, int ldt, int dst_row0, int k0, float scale = 1.f) { TItem I; I.W = W; I.WT = WT; I.ldw = ldw; I.src_col0 = src_col0; I.ldt = ldt; I.dst_row0 = dst_row0; I.k0 = k0; I.scale = scale; return I; }
__device__ __forceinline__ TItem titem_plain(const float* W, int K, int N, bf16_t* WT, int it) {
    const int nblk = N / 32, kb = it / nblk, nb = it % nblk; return titem_raw(W, N, 32 * nb, WT, K, 32 * nb, 64 * kb);
}
__device__ __forceinline__ TItem titem_ktile(const float* W, int K, int N, bf16_t* WT, int it) {
    const int nblk = N / 32, kb = it / nblk, nb = it % nblk; (void)K; return titem_raw(W, N, 32 * nb, WT + (size_t)kb * N * 64 - 64 * kb, 64, 32 * nb, 64 * kb);
}
__device__ __forceinline__ TItem titem_gateup(const float* Wg, const float* Wu, int K, int F, bf16_t* WT, int it, bool ktile = false) {
    const int nblk = 2 * F / 32, kb = it / nblk, nb = it % nblk, dr = 32 * nb, tile = dr >> 8, within = dr & 255;
    const float* W = within < 128 ? Wg : Wu; const int sc = tile * 128 + (within & 127);
    const float wsc = within < 128 ? 1.4426950408889634f : 0.6931471805599453f;
    if (ktile) return titem_raw(W, F, sc, WT + (size_t)kb * 2 * F * 64 - 64 * kb, 64, dr, 64 * kb, wsc);
    return titem_raw(W, F, sc, WT, K, dr, 64 * kb, wsc);
}
__device__ __forceinline__ void row_load(const float* xrow, int lane, f32x4 (&v)[4]) {
    const f32x4* xr = (const f32x4*)xrow + lane;
#pragma unroll
    for (int j = 0; j < 4; ++j) v[j] = xr[64 * j];
}
__device__ __forceinline__ void row_load(const bf16_t* xrow, int lane, f32x4 (&v)[4]) {
    const u32x2* xr = (const u32x2*)xrow + lane;
#pragma unroll
    for (int j = 0; j < 4; ++j) { const u32x2 raw = xr[64 * j]; v[j] = (f32x4){__uint_as_float(raw.x << 16), __uint_as_float(raw.x & 0xffff0000u), __uint_as_float(raw.y << 16), __uint_as_float(raw.y & 0xffff0000u)}; }
}
__device__ __forceinline__ void norm_w_load(const float* w, int lane, f32x4 (&ww)[4]) {
    const f32x4* wr = (const f32x4*)w + lane;
#pragma unroll
    for (int j = 0; j < 4; ++j) ww[j] = wr[64 * j];
}
__device__ __forceinline__ void rmsnorm_finish(const f32x4 (&wv)[4], bf16_t* orow, int lane, f32x4 (&v)[4], bf16_t* tiled = nullptr, int m = 0) {
    float s = 0.f;
#pragma unroll
    for (int j = 0; j < 4; ++j) s += (v[j].x * v[j].x + v[j].y * v[j].y) + (v[j].z * v[j].z + v[j].w * v[j].w);
    const float r = 1.f / sqrtf(wave_sum(s) * (1.f / D) + NORM_EPS);
    unsigned long long* o8 = (unsigned long long*)orow + lane;
#pragma unroll
    for (int j = 0; j < 4; ++j) { const f32x4 ww = wv[j]; v[j] = v[j] * r * ww; const unsigned long long pk = (unsigned long long)pk2(v[j].x, v[j].y) | ((unsigned long long)pk2(v[j].z, v[j].w) << 32);
        if (tiled) *(unsigned long long*)(tiled + ((((size_t)(m >> 8) * 16 + 4 * j + (lane >> 4)) * 256 + (m & 255)) * 64 + 4 * (lane & 15))) = pk; else o8[64 * j] = pk; }
}
template <typename TS>
__device__ __forceinline__ void rmsnorm_rows(const TS* src, const float* w, bf16_t* dst, int m0, int stride, int mend, int lane, bool tiled = false) {
    f32x4 cur[4], nxt[4], wv[4];
    norm_w_load(w, lane, wv);
    if (m0 < mend) row_load(src + (size_t)m0 * D, lane, cur);
    for (int m = m0; m < mend; m += stride) { const int mn = m + stride;
        if (mn < mend) row_load(src + (size_t)mn * D, lane, nxt);
        rmsnorm_finish(wv, dst + (size_t)m * D, lane, cur, tiled ? dst : nullptr, m);
#pragma unroll
        for (int j = 0; j < 4; ++j) cur[j] = nxt[j]; }
}

template <typename TS>
__device__ __forceinline__ void rmsnorm_rows2(const TS* src, const float* w, bf16_t* dst, int m0, int stride, int mend, int lane, bool tiled = false) {
    f32x4 c0[4], c1[4], n0[4], n1[4], wv[4];
    norm_w_load(w, lane, wv);
    if (m0 < mend) { row_load(src + (size_t)m0 * D, lane, c0); row_load(src + (size_t)(m0 + stride) * D, lane, c1); }
    for (int m = m0; m < mend; m += 2 * stride) { const int mn = m + 2 * stride;
        if (mn < mend) { row_load(src + (size_t)mn * D, lane, n0); row_load(src + (size_t)(mn + stride) * D, lane, n1); }
        rmsnorm_finish(wv, dst + (size_t)m * D, lane, c0, tiled ? dst : nullptr, m);
        rmsnorm_finish(wv, dst + (size_t)(m + stride) * D, lane, c1, tiled ? dst : nullptr, m + stride);
#pragma unroll
        for (int j = 0; j < 4; ++j) { c0[j] = n0[j]; c1[j] = n1[j]; } }
}

__device__ __forceinline__ void unpack8(const u32x4 raw, float (&x)[8]) {
    x[0] = __uint_as_float(raw.x << 16); x[1] = __uint_as_float(raw.x & 0xffff0000u); x[2] = __uint_as_float(raw.y << 16); x[3] = __uint_as_float(raw.y & 0xffff0000u);
    x[4] = __uint_as_float(raw.z << 16); x[5] = __uint_as_float(raw.z & 0xffff0000u); x[6] = __uint_as_float(raw.w << 16); x[7] = __uint_as_float(raw.w & 0xffff0000u);
}
typedef short s16x4 __attribute__((ext_vector_type(4)));
__device__ __forceinline__ void dilated_phase(const Frame& F, const bf16_t* HC0, bf16_t* op01, bf16_t* op2, float* lse) {
    constexpr int SLOT = 128 * 144;
    constexpr float LOG2E = 1.4426950408889634f, LN2 = 0.6931471805599453f;
    LAS unsigned char* Ks = F.lds; LAS unsigned char* Vs = F.lds + 3 * SLOT;
    for (int i = F.tid; i < 6 * SLOT / 16; i += NTHREADS) ((LAS u32x4*)F.lds)[i] = (u32x4){0u, 0u, 0u, 0u};
    int tid_ = threadIdx.x; asm volatile("" : "+v"(tid_));
    const int lane = tid_ & 63, fr = lane & 15, fq = lane >> 4, w = __builtin_amdgcn_readfirstlane(tid_ >> 6);
    const int srow0 = tid_ >> 3, sc = tid_ & 7;
    float knw[8], qnw[16];
    { const float* kn = inptr(I_KNORM); const float* qn = inptr(I_QNORM);
#pragma unroll
      for (int e = 0; e < 8; ++e) { knw[e] = kn[8 * sc + e]; qnw[e] = qn[8 * fq + e] * (0.125f * LOG2E); qnw[8 + e] = qn[32 + 8 * fq + e] * (0.125f * LOG2E); } }
    const unsigned vlane = (unsigned)((4 * fq + ((lane & 15) >> 2)) * 144 + (lane & 3) * 8);
    __syncthreads();
    for (int item = blockIdx.x; item < 1536; item += F.G) {
        const int p = item >> 9, within = item & 511, dsh = 2 * p, d = 1 << dsh;
        const int strip = within >> (4 - dsh), grp = within & ((16 >> dsh) - 1), r = strip & (d - 1), bh = strip >> dsh, h = bh & 7, b = bh >> 3, n0 = 4 * grp;
        const float cb = exp2f(-(float)(h + 1)) * LOG2E * (float)d;
        bf16_t* op = p < 2 ? op01 + (size_t)p * T * 512 : op2;
        const bf16_t* base = HC0 + (size_t)b * SEQ * LD0 + h * 64;
        u32x4 kreg[2], vreg[2];
#define DIL_LOAD(m) do { _Pragma("unroll") for (int rep = 0; rep < 2; ++rep) { const size_t pos = (size_t)((128 * (m) + srow0 + 64 * rep) * d + r); \
            kreg[rep] = *(const u32x4*)(base + pos * LD0 + C0_KB + 8 * sc); vreg[rep] = *(const u32x4*)(base + pos * LD0 + C0_VB + 8 * sc); } } while (0)
#define DIL_STORE(slot) do { _Pragma("unroll") for (int rep = 0; rep < 2; ++rep) { float x[8]; unpack8(kreg[rep], x); float ss = 0.f; \
            _Pragma("unroll") for (int e = 0; e < 8; ++e) ss += x[e] * x[e]; \
            ss += __shfl_xor(ss, 1); ss += __shfl_xor(ss, 2); ss += __shfl_xor(ss, 4); const float rs = 1.f / sqrtf(ss * (1.f / 64.f) + NORM_EPS); \
            const unsigned ro = (unsigned)((slot) * SLOT + (srow0 + 64 * rep) * 144 + sc * 16); \
            *(LAS u32x4*)(Ks + ro) = (u32x4){cvt_pk_bf16(x[0] * rs * knw[0], x[1] * rs * knw[1]), cvt_pk_bf16(x[2] * rs * knw[2], x[3] * rs * knw[3]), cvt_pk_bf16(x[4] * rs * knw[4], x[5] * rs * knw[5]), cvt_pk_bf16(x[6] * rs * knw[6], x[7] * rs * knw[7])}; \
            *(LAS u32x4*)(Vs + ro) = vreg[rep]; } } while (0)
        if (n0 > 0) { DIL_LOAD(n0 - 1); DIL_STORE((n0 + 2) % 3); }
        DIL_LOAD(n0); DIL_STORE(n0 % 3);
        u32x4 qraw0, qraw1;
#define DIL_LOADQ(m) do { const bf16_t* qp_ = HC0 + ((size_t)b * SEQ + (size_t)((128 * (m) + 16 * w + fr) * d + r)) * LD0 + C0_QB + h * 64; qraw0 = *(const u32x4*)(qp_ + 8 * fq); qraw1 = *(const u32x4*)(qp_ + 32 + 8 * fq); } while (0)
        DIL_LOADQ(n0);
        __syncthreads();
#pragma unroll 1
        for (int n = n0; n < n0 + 4; ++n) {
            const int prev = (n + 2) % 3, cur = n % 3, nxt = (n + 1) % 3;
            const bool more = (n + 1 < n0 + 4);
            const size_t tokq = (size_t)b * SEQ + (size_t)((128 * n + 16 * w + fr) * d + r);
            bf16x8 qf0, qf1;
            { float x0[8], x1[8]; unpack8(qraw0, x0); unpack8(qraw1, x1);
              float ss = 0.f;
#pragma unroll
              for (int e = 0; e < 8; ++e) ss += x0[e] * x0[e] + x1[e] * x1[e];
              ss += __shfl_xor(ss, 16); ss += __shfl_xor(ss, 32);
              const float rs = 1.f / sqrtf(ss * (1.f / 64.f) + NORM_EPS);
              const u32x4 a0 = (u32x4){cvt_pk_bf16(x0[0] * rs * qnw[0], x0[1] * rs * qnw[1]), cvt_pk_bf16(x0[2] * rs * qnw[2], x0[3] * rs * qnw[3]), cvt_pk_bf16(x0[4] * rs * qnw[4], x0[5] * rs * qnw[5]), cvt_pk_bf16(x0[6] * rs * qnw[6], x0[7] * rs * qnw[7])};
              const u32x4 a1 = (u32x4){cvt_pk_bf16(x1[0] * rs * qnw[8], x1[1] * rs * qnw[9]), cvt_pk_bf16(x1[2] * rs * qnw[10], x1[3] * rs * qnw[11]), cvt_pk_bf16(x1[4] * rs * qnw[12], x1[5] * rs * qnw[13]), cvt_pk_bf16(x1[6] * rs * qnw[14], x1[7] * rs * qnw[15])};
              qf0 = __builtin_bit_cast(bf16x8, a0); qf1 = __builtin_bit_cast(bf16x8, a1); }
            if (more) { DIL_LOAD(n + 1); DIL_LOADQ(n + 1); }
            f32x4 sacc[9];
#pragma unroll
            for (int i = 0; i < 9; ++i) { const int kt = w + i; const unsigned ko = (unsigned)((kt < 8 ? prev : cur) * SLOT + ((kt & 7) * 16 + fr) * 144 + fq * 16);
                const bf16x8 k0 = *(const LAS bf16x8*)(Ks + ko), k1 = *(const LAS bf16x8*)(Ks + ko + 64);
                f32x4 z = (f32x4){0.f, 0.f, 0.f, 0.f};
                z = __builtin_amdgcn_mfma_f32_16x16x32_bf16(k0, qf0, z, 0, 0, 0); sacc[i] = __builtin_amdgcn_mfma_f32_16x16x32_bf16(k1, qf1, z, 0, 0, 0); }
            float mx = -1e30f; const int lpart = fr - 4 * fq;
#pragma unroll
            for (int i = 0; i < 9; ++i) { const bool tile_ok = (w + i >= 8) || (n > 0);
#pragma unroll
                for (int j = 0; j < 4; ++j) { const int steps = 128 - 16 * i - j + lpart; float sv = sacc[i][j] - cb * (float)steps; bool ok = tile_ok;
                    if (i == 0) ok = ok && (steps <= 128); if (i == 8) ok = ok && (steps >= 0);
                    sv = ok ? sv : -1e30f; sacc[i][j] = sv; mx = fmaxf(mx, sv); } }
            mx = fmaxf(mx, __shfl_xor(mx, 16)); mx = fmaxf(mx, __shfl_xor(mx, 32));
            float l = 0.f;
#pragma unroll
            for (int i = 0; i < 9; ++i)
#pragma unroll
                for (int j = 0; j < 4; ++j) { const float pe = __builtin_amdgcn_exp2f(sacc[i][j] - mx); sacc[i][j] = pe; l += pe; }
            l += __shfl_xor(l, 16); l += __shfl_xor(l, 32);
            bf16x8 pf[5];
#pragma unroll
            for (int ks = 0; ks < 5; ++ks) { u32x4 t4; t4.x = cvt_pk_bf16(sacc[2 * ks][0], sacc[2 * ks][1]); t4.y = cvt_pk_bf16(sacc[2 * ks][2], sacc[2 * ks][3]);
                if (ks < 4) { t4.z = cvt_pk_bf16(sacc[2 * ks + 1][0], sacc[2 * ks + 1][1]); t4.w = cvt_pk_bf16(sacc[2 * ks + 1][2], sacc[2 * ks + 1][3]); } else { t4.z = 0u; t4.w = 0u; }
                pf[ks] = __builtin_bit_cast(bf16x8, t4); }
            f32x4 oacc[4];
#pragma unroll
            for (int dt = 0; dt < 4; ++dt) oacc[dt] = (f32x4){0.f, 0.f, 0.f, 0.f};
#pragma unroll
            for (int ks = 0; ks < 5; ++ks) { const int ta = w + 2 * ks, tb = ks < 4 ? ta + 1 : ta;
                const unsigned va = (unsigned)((ta < 8 ? prev : cur) * SLOT + (ta & 7) * 16 * 144) + vlane, vb = (unsigned)((tb < 8 ? prev : cur) * SLOT + (tb & 7) * 16 * 144) + vlane;
#pragma unroll
                for (int dt = 0; dt < 4; ++dt) { const s16x4 lo = __builtin_amdgcn_ds_read_tr16_b64_v4i16((LAS s16x4*)(Vs + va + dt * 32)), hi = __builtin_amdgcn_ds_read_tr16_b64_v4i16((LAS s16x4*)(Vs + vb + dt * 32));
                    const bf16x8 vf = (bf16x8){lo[0], lo[1], lo[2], lo[3], hi[0], hi[1], hi[2], hi[3]};
                    oacc[dt] = __builtin_amdgcn_mfma_f32_16x16x32_bf16(vf, pf[ks], oacc[dt], 0, 0, 0); } }
            const float il = 1.f / l;
            bf16_t* orow = op + tokq * 512 + h * 64 + 4 * fq;
#pragma unroll
            for (int dt = 0; dt < 4; ++dt) *(u32x2*)(orow + 16 * dt) = (u32x2){cvt_pk_bf16(oacc[dt][0] * il, oacc[dt][1] * il), cvt_pk_bf16(oacc[dt][2] * il, oacc[dt][3] * il)};
            if (fq == 0) lse[((size_t)p * T + tokq) * 8 + h] = (mx + __builtin_amdgcn_logf(l)) * LN2;
            if (more) DIL_STORE(nxt);
            __syncthreads();
        }
#undef DIL_LOAD
#undef DIL_LOADQ
#undef DIL_STORE
    }
}

template <int C, int DK, int DVS, bool SPLIT, int LD, int CQ, int CV, int DVH, int NCH, int PFO, int PFS, int PFV, int UNR>
__device__ __forceinline__ void recur_phase(const Frame& F, bf16_t* HC, const bf16_t* att, const bf16_t* keT, const float* decay) {
    constexpr int KA = C / 32, KQ = DK / 32, MTV = DVS / 16;
    constexpr int SP = DK * 2 + 16, VP = DVS * 2;
    constexpr int VBUF = C * VP, SBUF = DVS * SP;
    constexpr int NVCH = C * DVS / 8;
    constexpr int NTW = SPLIT ? (C / 16) / 4 : 1, NDW = SPLIT ? (DK / 16) / 4 : 2;
    static_assert(SPLIT || (C / 16 == 8 && DK / 16 == 16), "unsplit form: one row tile and two dk tiles per wave");
    constexpr int NST = SPLIT ? NTHREADS / 2 : NTHREADS;
    constexpr int VPT = NVCH > NST ? NVCH / NST : 1;
    constexpr int RSLOT = (NTW * (KA + KQ) > NDW * KA + NDW) ? NTW * (KA + KQ) : NDW * KA + NDW;
    constexpr int QLPR = DK * 2 / 16, QRPT = 64 / QLPR;
    static_assert(UNR % PFO == 0 && UNR % PFS == 0 && UNR % PFV == 0 && UNR % 2 == 0 && NCH % UNR == 0, "ring depths");
    LAS unsigned char* vb = F.lds; LAS unsigned char* sb = F.lds + 2 * VBUF;
    for (int item0 = blockIdx.x; item0 < 256; item0 += F.G) {
    int tid_ = threadIdx.x; asm volatile("" : "+v"(tid_));
    const int tid = tid_, lane = tid & 63, fr = lane & 15, fq = lane >> 4, w = __builtin_amdgcn_readfirstlane(tid >> 6);
    const bool is_o = SPLIT ? (w < 4) : true, is_s = SPLIT ? (w >= 4) : true;
    const int nto = SPLIT ? NTW * (w & 3) : w, mts0 = SPLIT ? NDW * (w & 3) : 2 * w;
    const unsigned trl = (unsigned)((8 * fq + ((lane & 15) >> 2)) * VP + (lane & 3) * 8);
    const int vrow = ((tid % NST) % NVCH) / (DVS / 8), vpart = tid % (DVS / 8);
        const int item = (F.G == 256) ? ((item0 & 7) * 32 + (item0 >> 3)) : item0;
        const int sl = item & 15, h = (item >> 4) & 3, b = item >> 6;
        const float cdec = __expf((float)C * log1pf(-exp2f(-5.f - (float)h)));
        __syncthreads();
        for (int i = tid; i < SBUF / 16; i += NTHREADS) ((LAS u32x4*)sb)[i] = (u32x4){0u, 0u, 0u, 0u};
        f32x4 accS[NDW][MTV];
#pragma unroll
        for (int i = 0; i < NDW; ++i)
#pragma unroll
            for (int j = 0; j < MTV; ++j) accS[i][j] = (f32x4){0.f, 0.f, 0.f, 0.f};
        static_assert(!SPLIT || PFO == PFS, "aliased rings");
        u32x4 RO[PFO][SPLIT ? RSLOT : KA + KQ], RSx[SPLIT ? 1 : PFS][SPLIT ? 1 : NDW * KA + NDW]; u32x4 vreg[PFV][VPT];
#define BA_(u_, j_, ks_) RO[u_][(j_) * (KA + KQ) + (ks_)]
#define BQ_(u_, j_, kq_) RO[u_][(j_) * (KA + KQ) + KA + (kq_)]
#define KE_(u_, i_, ks_) (*(SPLIT ? &RO[u_][(i_) * KA + (ks_)] : &RSx[SPLIT ? 0 : (u_)][SPLIT ? 0 : (i_) * KA + (ks_)]))
#define DC_(u_, i_) (*(SPLIT ? &RO[u_][NDW * KA + (i_)] : &RSx[SPLIT ? 0 : (u_)][SPLIT ? 0 : NDW * KA + (i_)]))
        const size_t vcol = (size_t)CV + h * DVH + sl * DVS;
#define RC_LOAD_O(u_, n_) do { const size_t unit_ = (size_t)(b * NCH + (n_)) * 4 + h; \
            _Pragma("unroll") for (int j = 0; j < NTW; ++j) { \
            const bf16_t* ap_ = att + (unit_ * (C / 16) + nto + j) * KA * 512 + lane * 8; \
            const bf16_t* qp_ = HC + ((size_t)b * SEQ + (size_t)(n_) * C + (size_t)((nto + j) * KQ) * QRPT + lane / QLPR) * LD + CQ + h * DK + (lane % QLPR) * 8; \
            _Pragma("unroll") for (int ks = 0; ks < KA; ++ks) BA_(u_, j, ks) = *(const u32x4*)(ap_ + ks * 512); \
            _Pragma("unroll") for (int kq = 0; kq < KQ; ++kq) BQ_(u_, j, kq) = *(const u32x4*)(qp_ + (size_t)(kq * QRPT) * LD); } } while (0)
#define RC_LOAD_S(u_, n_) do { const size_t unit_ = (size_t)(b * NCH + (n_)) * 4 + h; \
            _Pragma("unroll") for (int i = 0; i < NDW; ++i) { const bf16_t* kp_ = keT + (unit_ * (DK / 16) + mts0 + i) * KA * 512 + lane * 8; \
                _Pragma("unroll") for (int ks = 0; ks < KA; ++ks) KE_(u_, i, ks) = *(const u32x4*)(kp_ + ks * 512); \
                if (decay) DC_(u_, i) = *(const u32x4*)(decay + unit_ * DK + 16 * (mts0 + i) + 4 * fq); } } while (0)
#define RC_LOAD_V(u_, n_) do { _Pragma("unroll") for (int j = 0; j < VPT; ++j) vreg[u_][j] = *(const u32x4*)(HC + ((size_t)b * SEQ + (size_t)(n_) * C + vrow + j * (NST / (DVS / 8))) * LD + vcol + vpart * 8); } while (0)
#define RC_STORE_V(buf_, u_) do { if (tid < NST && tid < NVCH) { _Pragma("unroll") for (int j = 0; j < VPT; ++j) *(LAS u32x4*)(vb + (buf_) * VBUF + (vrow + j * (NST / (DVS / 8))) * VP + vpart * 16) = vreg[u_][j]; } } while (0)
        const bf16_t* const att_b = att + ((size_t)(b * NCH) * 4 + h) * (C / 16) * KA * 512;
        const bf16_t* const hc_b = HC + (size_t)b * SEQ * LD;
        const bf16_t* const ke_b = keT + ((size_t)(b * NCH) * 4 + h) * (DK / 16) * KA * 512;
        const float* const dc_b = decay ? decay + ((size_t)(b * NCH) * 4 + h) * DK : nullptr;
        unsigned g0 = (unsigned)(nto * KA * 512 + lane * 8);
        unsigned g1 = (unsigned)(((nto * KQ) * QRPT + lane / QLPR) * LD + CQ + h * DK + (lane % QLPR) * 8);
        unsigned g4 = (unsigned)(mts0 * KA * 512 + lane * 8);
        unsigned g5 = (unsigned)(16 * mts0 + 4 * fq);
        if (SPLIT && is_s) { g0 = g4; g1 = g5; }
        unsigned& pa = g0; unsigned& pq = g1; unsigned& pk = SPLIT ? g0 : g4; unsigned& pd = SPLIT ? g1 : g5;
        unsigned pv = (unsigned)(((1 + PFV) * C + vrow) * LD + (int)vcol + vpart * 8);
        unsigned po = (unsigned)((16 * nto + fr) * LD + (int)vcol + 4 * fq);
#define RC_NEXT_O(u_) do { _Pragma("unroll") for (int j = 0; j < NTW; ++j) { _Pragma("unroll") for (int ks = 0; ks < KA; ++ks) if (2 * ks <= nto + j) BA_(u_, j, ks) = *(const u32x4*)(att_b + pa + (j * KA + ks) * 512);     \
            _Pragma("unroll") for (int kq = 0; kq < KQ; ++kq) BQ_(u_, j, kq) = *(const u32x4*)(hc_b + pq + ((j * KQ + kq) * QRPT) * LD); \
            if (NTW > 1) __builtin_amdgcn_sched_barrier(0); } \
            pa += 4u * (C / 16) * KA * 512; pq += (unsigned)(C * LD); asm volatile("" : "+v"(pa), "+v"(pq)); } while (0)
#define RC_NEXT_S(u_) do { _Pragma("unroll") for (int i = 0; i < NDW; ++i) { _Pragma("unroll") for (int ks = 0; ks < KA; ++ks) KE_(u_, i, ks) = *(const u32x4*)(ke_b + pk + (i * KA + ks) * 512); \
                if (decay) DC_(u_, i) = *(const u32x4*)(dc_b + pd + 16 * i); if (NDW > 2) __builtin_amdgcn_sched_barrier(0); } \
            pk += 4u * (DK / 16) * KA * 512; pd += 4u * DK; asm volatile("" : "+v"(pk), "+v"(pd)); } while (0)
#define RC_NEXT_V(u_) do { _Pragma("unroll") for (int j = 0; j < VPT; ++j) vreg[u_][j] = *(const u32x4*)(hc_b + pv + (size_t)(j * (NST / (DVS / 8))) * LD); pv += (unsigned)(C * LD); asm volatile("" : "+v"(pv)); } while (0)
#pragma unroll
        for (int u = 0; u < PFV; ++u)
#pragma unroll
            for (int j = 0; j < VPT; ++j) vreg[u][j] = (u32x4){0u, 0u, 0u, 0u};
#pragma unroll
        for (int u = 0; u < PFO; ++u) if (is_o) RC_NEXT_O(u);
#pragma unroll
        for (int u = 0; u < PFS; ++u) if (is_s) RC_NEXT_S(u);
#pragma unroll
        for (int u = 0; u < PFV; ++u) RC_LOAD_V(u, u);
        RC_STORE_V(0, 0);
        RC_LOAD_V(0, PFV);
        __syncthreads();
#define RC_VT(dst, mt_) do { _Pragma("unroll") for (int ks = 0; ks < KA; ++ks) { const LAS unsigned char* p0 = vb + cb * VBUF + trl + (32 * ks) * VP + (mt_) * 32; \
            const s16x4 lo = __builtin_amdgcn_ds_read_tr16_b64_v4i16((LAS s16x4*)p0), hi = __builtin_amdgcn_ds_read_tr16_b64_v4i16((LAS s16x4*)(p0 + 4 * VP)); \
            dst[ks] = (bf16x8){lo[0], lo[1], lo[2], lo[3], hi[0], hi[1], hi[2], hi[3]}; } } while (0)
#define RC_CHUNK(DO_O, DO_S) do { const int n = n0 + u; const int cb = u & 1, nb = cb ^ 1; \
            if (DO_O) { f32x4 ao[NTW][MTV]; \
                _Pragma("unroll") for (int mt = 0; mt < MTV; ++mt) { bf16x8 vT[KA]; RC_VT(vT, mt); \
                    _Pragma("unroll") for (int j = 0; j < NTW; ++j) { ao[j][mt] = (f32x4){0.f, 0.f, 0.f, 0.f}; \
                        _Pragma("unroll") for (int ks = 0; ks < KA; ++ks) if (2 * ks <= nto + j) ao[j][mt] = __builtin_amdgcn_mfma_f32_16x16x32_bf16(vT[ks], __builtin_bit_cast(bf16x8, BA_(u % PFO, j, ks)), ao[j][mt], 0, 0, 0); \
                        if (PFO == 1 && mt == MTV - 1) { __builtin_amdgcn_sched_barrier(0);     \
                            _Pragma("unroll") for (int ks = 0; ks < KA; ++ks) if (2 * ks <= nto + j) BA_(0, j, ks) = *(const u32x4*)(att_b + pa + (j * KA + ks) * 512); } } \
                    _Pragma("unroll") for (int kq = 0; kq < KQ; ++kq) { const bf16x8 sa = *(const LAS bf16x8*)(sb + cb * SBUF + (16 * mt + fr) * SP + (32 * kq + 8 * fq) * 2); \
                        _Pragma("unroll") for (int j = 0; j < NTW; ++j) { ao[j][mt] = __builtin_amdgcn_mfma_f32_16x16x32_bf16(sa, __builtin_bit_cast(bf16x8, BQ_(u % PFO, j, kq)), ao[j][mt], 0, 0, 0); \
                            if (PFO == 1 && mt == MTV - 1) { __builtin_amdgcn_sched_barrier(0); BQ_(0, j, kq) = *(const u32x4*)(hc_b + pq + ((j * KQ + kq) * QRPT) * LD); } } } } \
                _Pragma("unroll") for (int j = 0; j < NTW; ++j) _Pragma("unroll") for (int mt = 0; mt < MTV; ++mt) *(u32x2*)(HC + (size_t)b * SEQ * LD + po + (size_t)(16 * j) * LD + 16 * mt) = (u32x2){cvt_pk_bf16(ao[j][mt][0], ao[j][mt][1]), cvt_pk_bf16(ao[j][mt][2], ao[j][mt][3])}; \
                po += (unsigned)(C * LD); asm volatile("" : "+v"(po)); \
                \
                if (PFO == 1) { pa += 4u * (C / 16) * KA * 512; pq += (unsigned)(C * LD); asm volatile("" : "+v"(pa), "+v"(pq)); } else RC_NEXT_O(u % PFO); } \
            if (DO_S) { \
                _Pragma("unroll") for (int nt = 0; nt < MTV; ++nt) { bf16x8 vT[KA]; RC_VT(vT, nt); \
                    _Pragma("unroll") for (int i = 0; i < NDW; ++i) { f32x4 a = accS[i][nt]; \
                        if (decay) a = a * __builtin_bit_cast(f32x4, DC_(u % PFS, i)); else a = a * cdec; \
                        _Pragma("unroll") for (int ks = 0; ks < KA; ++ks) a = __builtin_amdgcn_mfma_f32_16x16x32_bf16(__builtin_bit_cast(bf16x8, KE_(u % PFS, i, ks)), vT[ks], a, 0, 0, 0); \
                        if (PFS == 1 && nt == MTV - 1) { __builtin_amdgcn_sched_barrier(0); \
                            _Pragma("unroll") for (int ks = 0; ks < KA; ++ks) KE_(0, i, ks) = *(const u32x4*)(ke_b + pk + (i * KA + ks) * 512); \
                            if (decay) DC_(0, i) = *(const u32x4*)(dc_b + pd + 16 * i); } \
                        accS[i][nt] = a; \
                        *(LAS u32x2*)(sb + nb * SBUF + (16 * nt + fr) * SP + (16 * (mts0 + i) + 4 * fq) * 2) = (u32x2){cvt_pk_bf16(a[0], a[1]), cvt_pk_bf16(a[2], a[3])}; } } \
\
                if (PFS == 1) { pk += 4u * (DK / 16) * KA * 512; pd += 4u * DK; asm volatile("" : "+v"(pk), "+v"(pd)); } else RC_NEXT_S(u % PFS); } \
            if (DO_O) { if (n + 1 < NCH) RC_STORE_V(nb, (u + 1) % PFV); } \
            __syncthreads(); \
            if (DO_O) RC_NEXT_V((u + 1) % PFV); \
            __builtin_amdgcn_sched_barrier(0); } while (0)
        if (SPLIT) {
            if (is_o) {
#pragma unroll 1
                for (int n0 = 0; n0 < NCH; n0 += UNR) {
#pragma unroll
                    for (int u = 0; u < UNR; ++u) RC_CHUNK(true, false);
                }
            } else {
#pragma unroll 1
                for (int n0 = 0; n0 < NCH; n0 += UNR) {
#pragma unroll
                    for (int u = 0; u < UNR; ++u) RC_CHUNK(false, true);
                }
            }
        } else {
#pragma unroll 1
            for (int n0 = 0; n0 < NCH; n0 += UNR) {
#pragma unroll
                for (int u = 0; u < UNR; ++u) RC_CHUNK(true, true);
            }
        }
#undef RC_CHUNK
#undef RC_VT
#undef RC_LOAD_O
#undef RC_NEXT_O
#undef RC_NEXT_S
#undef RC_NEXT_V
#undef BA_
#undef BQ_
#undef KE_
#undef DC_
#undef RC_LOAD_S
#undef RC_LOAD_V
#undef RC_STORE_V
    }
    __syncthreads();
}

struct Args { const float* in[22]; float* out; unsigned char* ws; int ph_lo, ph_hi; };
constexpr int NPHASE = 23;

#define PHASE_IDS int tid = threadIdx.x; asm volatile("" : "+v"(tid)); const int lane = tid & 63, wave = __builtin_amdgcn_readfirstlane(tid >> 6), gw = blockIdx.x * NWAVES + wave, gtid = blockIdx.x * NTHREADS + tid; (void)lane; (void)gw; (void)gtid
__global__ void __launch_bounds__(NTHREADS, 2) fwd_kernel(Args args) {
    extern __shared__ __attribute__((aligned(16))) unsigned char lds_raw[];
    Frame F;
    F.lds = (LAS unsigned char*)lds_raw;
    F.tid = threadIdx.x; F.lane = threadIdx.x & 63; F.wave = __builtin_amdgcn_readfirstlane(threadIdx.x >> 6);
    F.G = gridDim.x; F.gw = 0; F.NGW = F.G * NWAVES;
    F.ws = args.ws; F.ctl = (gu32*)(args.ws + WS_CTL); F.out = args.out;
    volatile LAS unsigned* MISC = (volatile LAS unsigned*)(F.lds + LDSCTL_OFF);
    if (threadIdx.x < 64) MISC[threadIdx.x] = 0u;
    __syncthreads();
    const int lo = args.ph_lo, hi = args.ph_hi;
    const bool use_bar = (hi - lo) > 1;
    XcdBarrier bar; bar.bar = (unsigned*)(F.ctl + CW_BAR); bar.x = 0; bar.st = nullptr;
    if (use_bar) bar = xcd_barrier_post((unsigned*)(F.ctl + CW_BAR), MISC + 8);
#ifndef PHMASK
#define PHMASK 0x7fffff
#endif
#define IN(k) (((PHMASK >> (k)) & 1) && lo <= (k) && (k) < hi)
#ifndef PROBE_M1
#define PROBE_M1 0
#define PROBE_M2 0
#endif
#define STAMP(k) do { if ((PROBE_M1 | PROBE_M2) && blockIdx.x == 0 && threadIdx.x == 0) ((volatile LAS unsigned long long*)(F.lds + LDSCTL_OFF + 512))[k] = __builtin_amdgcn_s_memrealtime(); } while (0)
#define SEAM(k) do { if (IN(k) && IN((k) + 1)) xcd_barrier(bar); STAMP((k) + 1); } while (0)
    STAMP(0);
    unsigned char* const big = F.ws + WS_BIG;
    unsigned char* const XNB = (unsigned char*)F.out;
    bf16_t* const XN = (bf16_t*)XNB;
    bf16_t* const R = (bf16_t*)(F.ws + WS_XN);
    bf16_t* const HC0 = (bf16_t*)(big + B_HCAT0);
    bf16_t* const HC1 = (bf16_t*)(big + B_HCAT1);
    const int NT = F.G * NTHREADS;

    if (IN(0)) { PHASE_IDS;
        LAS float* scr = (LAS float*)(F.lds + wave * 9216);
        LAS bf16_t* wl = (LAS bf16_t*)(F.lds + 73728);
        { const float* wlr = inptr(I_WIN0) + W0_LR;
          for (int c = tid; c < D; c += NTHREADS) { const f32x4* wp = (const f32x4*)(wlr + (size_t)c * LDW0);
#pragma unroll
              for (int q = 0; q < 4; ++q) { const f32x4 w4 = wp[q]; wl[(4 * q) * 1032 + c] = (bf16_t)f2bf(w4.x); wl[(4 * q + 1) * 1032 + c] = (bf16_t)f2bf(w4.y); wl[(4 * q + 2) * 1032 + c] = (bf16_t)f2bf(w4.z); wl[(4 * q + 3) * 1032 + c] = (bf16_t)f2bf(w4.w); } } }
        __syncthreads();
        constexpr int I0 = (D / 64) * (LD0 / 32), I1 = (MIX0 / 64) * (D / 32), I2 = (D / 64) * (2 * FF0 / 32), I3 = (FF0 / 64) * (D / 32), I4 = (D / 64) * (LD1 / 32), I5 = (MIX1 / 64) * (D / 32);
        constexpr int NIT = I0 + I1 + I2 + I3 + I4 + I5;
#define P0_ITEM(it_) ([&](int r) -> TItem { \
            if (r < I0) { const int nblk = LD0 / 32, kb = r / nblk, nb = r % nblk, dr = 32 * nb; return titem_raw(inptr(I_WIN0), LDW0, dr < W0_LR ? dr : dr + 16, (bf16_t*)(F.ws + WS_WIN0) + (size_t)kb * LD0 * 64 - 64 * kb, 64, dr, 64 * kb); } r -= I0;     \
            if (r < I1) return titem_plain(inptr(I_WOUT0), MIX0, D, (bf16_t*)(F.ws + WS_WOUT0), r); r -= I1; \
            if (r < I2) return titem_gateup(inptr(I_WFG), inptr(I_WFU), D, FF0, (bf16_t*)(F.ws + WS_WGU0), r, true); r -= I2; \
            if (r < I3) return titem_ktile(inptr(I_WFD), FF0, D, (bf16_t*)(F.ws + WS_WD0), r); r -= I3; \
            if (r < I4) return titem_ktile(inptr(I_WIN1), D, LD1, (bf16_t*)(F.ws + WS_WIN1), r); r -= I4; \
            return titem_plain(inptr(I_WOUT1), MIX1, D, (bf16_t*)(F.ws + WS_WOUT1), r); })(it_)
        float* lr = (float*)(F.ws + WS_LR);
        const int fr = lane & 15, fq = lane >> 4;
        int it = gw;
        for (int g = gw; g < T / 16; g += F.NGW) {
            { f32x4 c0[4], c1[4], n0[4], n1[4], wv[4], tv[8]; TItem I;
              norm_w_load(inptr(I_MN0), lane, wv);
              row_load(inptr(I_X) + (size_t)(16 * g) * D, lane, c0); row_load(inptr(I_X) + (size_t)(16 * g + 1) * D, lane, c1);
#pragma unroll 1
              for (int m = 16 * g; m < 16 * g + 16; m += 2) {
                  if (m + 2 < 16 * g + 16) { row_load(inptr(I_X) + (size_t)(m + 2) * D, lane, n0); row_load(inptr(I_X) + (size_t)(m + 3) * D, lane, n1); }
                  const bool has = it < NIT;
                  if (has) { I = P0_ITEM(it); titem_load(I, lane, tv); }
                  rmsnorm_finish(wv, XN + (size_t)m * D, lane, c0, XN, m);
                  rmsnorm_finish(wv, XN + (size_t)(m + 1) * D, lane, c1, XN, m + 1);
                  if (has) { titem_finish(I, scr, lane, tv); it += F.NGW; }
#pragma unroll
                  for (int j = 0; j < 4; ++j) { c0[j] = n0[j]; c1[j] = n1[j]; } } }
            asm volatile("s_waitcnt vmcnt(0)" ::: "memory");
            f32x4 acc = (f32x4){0.f, 0.f, 0.f, 0.f};
            const bf16_t* ap = XN + (((size_t)((16 * g) >> 8) * 16) * 256 + ((16 * g + fr) & 255)) * 64 + 8 * fq;
#pragma unroll 8
            for (int ks = 0; ks < 32; ++ks) { const bf16x8 af = *(const bf16x8*)(ap + (size_t)(ks >> 1) * 256 * 64 + 32 * (ks & 1)); const bf16x8 bfr = *(const LAS bf16x8*)(wl + fr * 1032 + 32 * ks + 8 * fq);
                acc = __builtin_amdgcn_mfma_f32_16x16x32_bf16(af, bfr, acc, 0, 0, 0); }
#pragma unroll
            for (int j = 0; j < 4; ++j) lr[(size_t)(16 * g + 4 * fq + j) * 16 + fr] = acc[j];
        }
        for (; it < NIT; it += F.NGW) { const TItem I = P0_ITEM(it); f32x4 tv[8]; titem_load(I, lane, tv); titem_finish(I, scr, lane, tv); }
#undef P0_ITEM
    }
    SEAM(0);

    if (IN(1)) { PHASE_IDS;
        pg8::DenseOrder S; S.init(T, LD0, F.G, (int)blockIdx.x); pg8::TiledMap MP{D / 64, LD0}; pg8::EpiBf16 E{HC0, LD0};
        pg8::gemm_phase(F.lds, XN, 64, (const bf16_t*)(F.ws + WS_WIN0), D, S, MP, E, 64, (size_t)256 * 128, (size_t)LD0 * 128);
    }
    SEAM(1);

    if (IN(2)) { PHASE_IDS;
        {
            const float* lr = (const float*)(F.ws + WS_LR); const float* wgu = inptr(I_WGATEUP); const float* bg = inptr(I_BGATE);
            bf16_t* att = (bf16_t*)(big + B_ATT0); bf16_t* kendT = (bf16_t*)(big + B_KENDT); float* decay = (float*)(F.ws + WS_DECAY);
            LAS bf16_t* qd_s = (LAS bf16_t*)F.lds;
            LAS bf16_t* ki_s = qd_s + 64 * 136;
            LAS float* grp = (LAS float*)(ki_s + 64 * 136);
            LAS float* lr_s = grp + 4 * 128;
            LAS bf16_t* qr_s = (LAS bf16_t*)(lr_s + 64 * 16);
            LAS bf16_t* kr_s = qr_s + 64 * 128;
            const int dk = tid & 127, sg = tid >> 7;
            const int fr = lane & 15, fq = lane >> 4, w = wave;
            const int h = (int)blockIdx.x & 3, col = h * 128 + dk;
            float w16[16];
#pragma unroll
            for (int r = 0; r < 16; ++r) w16[r] = wgu[r * 512 + col];
            const float bias = bg[col];
            u32x4 pq[2], pk[2], pl = (u32x4){0u, 0u, 0u, 0u};
#define P2_LOAD(unit_) do { const int t0_ = ((unit_) >> 2) * 64; _Pragma("unroll") for (int rep = 0; rep < 2; ++rep) { const bf16_t* rp_ = HC0 + (size_t)(t0_ + (tid >> 4) + 32 * rep) * LD0 + h * 128 + (tid & 15) * 8; \
                pq[rep] = *(const u32x4*)(rp_ + C0_QA); pk[rep] = *(const u32x4*)(rp_ + C0_KA); } \
                if (tid < 256) pl = *(const u32x4*)(lr + (size_t)t0_ * 16 + tid * 4); } while (0)
            if ((int)blockIdx.x < 2048) P2_LOAD((int)blockIdx.x);
            for (int unit = blockIdx.x; unit < 2048; unit += F.G) {
                const int bn = unit >> 2, t0 = bn * 64;
                __syncthreads();
#pragma unroll
                for (int rep = 0; rep < 2; ++rep) { *(LAS u32x4*)(qr_s + ((tid >> 4) + 32 * rep) * 128 + (tid & 15) * 8) = pq[rep]; *(LAS u32x4*)(kr_s + ((tid >> 4) + 32 * rep) * 128 + (tid & 15) * 8) = pk[rep]; }
                if (tid < 256) *(LAS u32x4*)(lr_s + tid * 4) = pl;
                __syncthreads();
                if (unit + F.G < 2048) P2_LOAD(unit + F.G);
                float cum[16]; float run = 0.f;
#pragma unroll
                for (int i = 0; i < 16; ++i) { const LAS f32x4* lp = (const LAS f32x4*)(lr_s + (16 * sg + i) * 16); float z = bias;
#pragma unroll
                    for (int q = 0; q < 4; ++q) { const f32x4 l4 = lp[q]; z += l4.x * w16[4 * q] + l4.y * w16[4 * q + 1] + l4.z * w16[4 * q + 2] + l4.w * w16[4 * q + 3]; }
                    run += logsigmoid_f(z) * (1.f / 16.f); cum[i] = run; }
                grp[sg * 128 + dk] = run;
                __syncthreads();
                float off = 0.f, total = 0.f;
#pragma unroll
                for (int g = 0; g < 4; ++g) { const float gs = grp[g * 128 + dk]; total += gs; off += (g < sg) ? gs : 0.f; }
                unsigned kep[8];
#pragma unroll
                for (int i = 0; i < 16; ++i) { const int s_ = 16 * sg + i, t = t0 + s_; const float c = off + cum[i];
                    const float q = bf2f(qr_s[s_ * 128 + dk]), k = bf2f(kr_s[s_ * 128 + dk]); (void)t;
                    const unsigned qdb = f2bf(q * __expf(c) * 0.08838834764831845f); qd_s[s_ * 136 + dk] = (bf16_t)qdb;
                    ki_s[s_ * 136 + dk] = (bf16_t)f2bf(k * __expf(-c));
                    const unsigned keb = f2bf(k * __expf(total - c)); if (i & 1) kep[i >> 1] |= keb << 16; else kep[i >> 1] = keb; }
                { bf16_t* kp = kendT + (((size_t)unit * 8 + (dk >> 4)) * 2 + (sg >> 1)) * 512 + (((sg & 1) * 2) * 16 + (dk & 15)) * 8;
                  *(u32x4*)kp = (u32x4){kep[0], kep[1], kep[2], kep[3]}; *(u32x4*)(kp + 128) = (u32x4){kep[4], kep[5], kep[6], kep[7]}; }
                if (sg == 0) decay[unit * 128 + dk] = __expf(total);
                __syncthreads();
                { const int nt = w & 3;
#pragma unroll
                  for (int i2 = 0; i2 < 2; ++i2) { const int mt = 2 * (w >> 2) + i2; f32x4 a = (f32x4){0.f, 0.f, 0.f, 0.f};
                      if (mt <= nt) {
#pragma unroll
                          for (int ks = 0; ks < 4; ++ks) { const bf16x8 ka = *(const LAS bf16x8*)(ki_s + (16 * mt + fr) * 136 + 32 * ks + 8 * fq), qb = *(const LAS bf16x8*)(qd_s + (16 * nt + fr) * 136 + 32 * ks + 8 * fq);
                              a = __builtin_amdgcn_mfma_f32_16x16x32_bf16(ka, qb, a, 0, 0, 0); }
#pragma unroll
                          for (int j = 0; j < 4; ++j) if (16 * mt + 4 * fq + j > 16 * nt + fr) a[j] = 0.f; }
                      *(u32x2*)(att + ((size_t)unit * 4 + nt) * 2 * 512 + (mt >> 1) * 512 + ((((mt & 1) * 2 + (fq >> 1)) * 16 + fr) * 8) + (fq & 1) * 4) = (u32x2){cvt_pk_bf16(a[0], a[1]), cvt_pk_bf16(a[2], a[3])}; } }
#pragma unroll
                for (int i2 = 0; i2 < 2; ++i2) { const int j = 2 * w + i2, rt = j >> 2, kt = j & 3; const u32x4 qv = *(const LAS u32x4*)(qd_s + (16 * rt + fr) * 136 + 32 * kt + 8 * fq);
                    *(u32x4*)(HC0 + (size_t)(t0 + 4 * j + (lane >> 4)) * LD0 + C0_KA + h * 128 + (lane & 15) * 8) = qv; }
            }
#undef P2_LOAD
            __syncthreads();
        }
    }
    SEAM(2);

    { const bool both = IN(3) && IN(4); const bool swp = both && (((int)blockIdx.x >> 7) & 1);
#pragma unroll 1
      for (int step = 0; step < 2; ++step) {
          const bool gla = (step == 0) != swp;
          if (gla) { if (IN(3)) recur_phase<64, 128, 16, true, LD0, C0_KA, C0_VA, 256, 128, 2, 2, 2, 8>(F, HC0, (const bf16_t*)(big + B_ATT0), (const bf16_t*)(big + B_KENDT), (const float*)(F.ws + WS_DECAY)); }
          else { if (IN(4)) dilated_phase(F, HC0, (bf16_t*)XNB, (bf16_t*)(big + B_OP2), (float*)(F.ws + WS_LSE)); }
          if (step == 0) { __syncthreads(); STAMP(4); } } }
    SEAM(4);

    if (IN(5)) { PHASE_IDS;
        const float* gn = inptr(I_GLANORM); const float* lse = (const float*)(F.ws + WS_LSE);
        float gw16[16];
#pragma unroll
        for (int e = 0; e < 16; ++e) gw16[e] = gn[(16 * lane + e) & 255];
        for (int t = gw; t < T; t += F.NGW) {
            bf16_t* row = HC0 + (size_t)t * LD0;
            { const u32x4* op = (const u32x4*)(row + C0_VA + 16 * lane); u32x4* rp = (u32x4*)(row + C0_RA + 16 * lane); float o[16], g[16];
#pragma unroll
              for (int c = 0; c < 2; ++c) { const u32x4 a = op[c], r4 = rp[c];
                  o[8 * c] = __uint_as_float(a.x << 16); o[8 * c + 1] = __uint_as_float(a.x & 0xffff0000u); o[8 * c + 2] = __uint_as_float(a.y << 16); o[8 * c + 3] = __uint_as_float(a.y & 0xffff0000u);
                  o[8 * c + 4] = __uint_as_float(a.z << 16); o[8 * c + 5] = __uint_as_float(a.z & 0xffff0000u); o[8 * c + 6] = __uint_as_float(a.w << 16); o[8 * c + 7] = __uint_as_float(a.w & 0xffff0000u);
                  g[8 * c] = __uint_as_float(r4.x << 16); g[8 * c + 1] = __uint_as_float(r4.x & 0xffff0000u); g[8 * c + 2] = __uint_as_float(r4.y << 16); g[8 * c + 3] = __uint_as_float(r4.y & 0xffff0000u);
                  g[8 * c + 4] = __uint_as_float(r4.z << 16); g[8 * c + 5] = __uint_as_float(r4.z & 0xffff0000u); g[8 * c + 6] = __uint_as_float(r4.w << 16); g[8 * c + 7] = __uint_as_float(r4.w & 0xffff0000u); }
              float ss = 0.f;
#pragma unroll
              for (int e = 0; e < 16; ++e) ss += o[e] * o[e];
              ss += __shfl_xor(ss, 1); ss += __shfl_xor(ss, 2); ss += __shfl_xor(ss, 4); ss += __shfl_xor(ss, 8);
              const float rs = 1.f / sqrtf(ss * (1.f / 256.f) + NORM_EPS);
#pragma unroll
              for (int e = 0; e < 16; ++e) o[e] = o[e] * rs * gw16[e] * silu_f(g[e]);
#pragma unroll
              for (int c = 0; c < 2; ++c) rp[c] = (u32x4){pk2(o[8 * c], o[8 * c + 1]), pk2(o[8 * c + 2], o[8 * c + 3]), pk2(o[8 * c + 4], o[8 * c + 5]), pk2(o[8 * c + 6], o[8 * c + 7])}; }
            { const int hh = lane >> 3; const float l0 = lse[((size_t)0 * T + t) * 8 + hh], l1 = lse[((size_t)1 * T + t) * 8 + hh], l2 = lse[((size_t)2 * T + t) * 8 + hh];
              const float mx = fmaxf(l0, fmaxf(l1, l2)); float w0 = __expf(l0 - mx), w1 = __expf(l1 - mx), w2 = __expf(l2 - mx); const float iw = 1.f / (w0 + w1 + w2); w0 *= iw; w1 *= iw; w2 *= iw;
              const u32x4 a = *(const u32x4*)((const bf16_t*)XNB + (size_t)t * 512 + 8 * lane), bq = *(const u32x4*)((const bf16_t*)XNB + (size_t)(T + t) * 512 + 8 * lane), c = *(const u32x4*)((const bf16_t*)(big + B_OP2) + (size_t)t * 512 + 8 * lane);
              float r[8];
              r[0] = w0 * __uint_as_float(a.x << 16) + w1 * __uint_as_float(bq.x << 16) + w2 * __uint_as_float(c.x << 16); r[1] = w0 * __uint_as_float(a.x & 0xffff0000u) + w1 * __uint_as_float(bq.x & 0xffff0000u) + w2 * __uint_as_float(c.x & 0xffff0000u);
              r[2] = w0 * __uint_as_float(a.y << 16) + w1 * __uint_as_float(bq.y << 16) + w2 * __uint_as_float(c.y << 16); r[3] = w0 * __uint_as_float(a.y & 0xffff0000u) + w1 * __uint_as_float(bq.y & 0xffff0000u) + w2 * __uint_as_float(c.y & 0xffff0000u);
              r[4] = w0 * __uint_as_float(a.z << 16) + w1 * __uint_as_float(bq.z << 16) + w2 * __uint_as_float(c.z << 16); r[5] = w0 * __uint_as_float(a.z & 0xffff0000u) + w1 * __uint_as_float(bq.z & 0xffff0000u) + w2 * __uint_as_float(c.z & 0xffff0000u);
              r[6] = w0 * __uint_as_float(a.w << 16) + w1 * __uint_as_float(bq.w << 16) + w2 * __uint_as_float(c.w << 16); r[7] = w0 * __uint_as_float(a.w & 0xffff0000u) + w1 * __uint_as_float(bq.w & 0xffff0000u) + w2 * __uint_as_float(c.w & 0xffff0000u);
              *(u32x4*)(row + C0_QB + 8 * lane) = (u32x4){pk2(r[0], r[1]), pk2(r[2], r[3]), pk2(r[4], r[5]), pk2(r[6], r[7])}; }
        }
    }
    SEAM(5);

    if (IN(6)) { PHASE_IDS;
        pg8::DenseOrder S; S.init(T, D, F.G, (int)blockIdx.x); pg8::PlainMap MP; pg8::EpiResB<true> E{inptr(I_X), nullptr, R, D};
        pg8::gemm_phase(F.lds, HC0 + C0_RA, LD0, (const bf16_t*)(F.ws + WS_WOUT0), MIX0, S, MP, E);
    }
    SEAM(6);

    if (IN(7)) { PHASE_IDS; rmsnorm_rows2(R, inptr(I_FN0), XN, gw, F.NGW, T, lane, true); }
    SEAM(7);

    if (IN(8)) { PHASE_IDS;
        pg8::DenseOrder S; S.init(T, 2 * FF0, F.G, (int)blockIdx.x); pg8::TiledMap MP{D / 64, 2 * FF0}; pg8::EpiSwiGLU E{(bf16_t*)(big + B_H0), FF0};
        pg8::gemm_phase(F.lds, XN, 64, (const bf16_t*)(F.ws + WS_WGU0), D, S, MP, E, 64, (size_t)256 * 128, (size_t)2 * FF0 * 128);
    }
    SEAM(8);

    if (IN(9)) { PHASE_IDS;
        pg8::DenseOrder S; S.init(T, D, F.G, (int)blockIdx.x); pg8::TiledMap MP{FF0 / 64, D}; pg8::EpiResB<false> E{nullptr, R, R, D};
        pg8::gemm_phase(F.lds, (const bf16_t*)(big + B_H0), 64, (const bf16_t*)(F.ws + WS_WD0), FF0, S, MP, E, 64, (size_t)256 * 128, (size_t)D * 128);
    }
    SEAM(9);

    if (IN(10)) { PHASE_IDS; rmsnorm_rows2(R, inptr(I_MN1), XN, gw, F.NGW, T, lane, true); }
    SEAM(10);

    if (IN(11)) { PHASE_IDS;
        pg8::DenseOrder S; S.init(T, LD1, F.G, (int)blockIdx.x); pg8::TiledMap MP{D / 64, LD1}; pg8::EpiBf16 E{HC1, LD1};
        pg8::gemm_phase(F.lds, XN, 64, (const bf16_t*)(F.ws + WS_WIN1), D, S, MP, E, 64, (size_t)256 * 128, (size_t)LD1 * 128);
    }
    SEAM(11);

    if (IN(12)) { PHASE_IDS;
        bf16_t* att = (bf16_t*)(big + B_ATT1); bf16_t* kdT = (bf16_t*)XNB;
        LAS bf16_t* qd_s = (LAS bf16_t*)F.lds;
        LAS bf16_t* ki_s = qd_s + 128 * 264;
        const int dk = tid & 255, sg = tid >> 8;
        const int fr = lane & 15, fq = lane >> 4, w = wave;
        LAS float* dtab = (LAS float*)(F.lds + LDSCTL_OFF + 2048);
        { const float lg0 = log1pf(-exp2f(-5.f - (float)((int)blockIdx.x & 3)));
          if (tid < 128) { dtab[3 * tid] = __expf(lg0 * (float)(tid + 1)); dtab[3 * tid + 1] = __expf(-lg0 * (float)(tid + 1)); dtab[3 * tid + 2] = __expf(lg0 * (float)(127 - tid)) * 0.0625f; } }
        __syncthreads();
        for (int unit = blockIdx.x; unit < 1024; unit += F.G) {
            const int h = unit & 3, bn = unit >> 2, t0 = bn * 128;
            __syncthreads();
            bf16_t qc[8], kc[8], qn[8], kn[8];
#define P12_LOAD(dq, dkk, i8_) do { _Pragma("unroll") for (int i = 0; i < 8; ++i) { const size_t t_ = (size_t)(t0 + 64 * sg + 8 * (i8_) + i); \
                dq[i] = HC1[t_ * LD1 + C1_Q + h * 256 + dk]; dkk[i] = HC1[t_ * LD1 + C1_K + h * 256 + dk]; } } while (0)
            P12_LOAD(qc, kc, 0);
#pragma unroll 1
            for (int i8 = 0; i8 < 8; ++i8) {
                if (i8 < 7) P12_LOAD(qn, kn, i8 + 1);
                unsigned kp[4];
#pragma unroll
                for (int i = 0; i < 8; ++i) { const int s_ = 64 * sg + 8 * i8 + i;
                    const float q = bf2f(qc[i]), k = bf2f(kc[i]);
                    const unsigned qdb = f2bf(q * dtab[3 * s_]); qd_s[s_ * 264 + dk] = (bf16_t)qdb;
                    ki_s[s_ * 264 + dk] = (bf16_t)f2bf(k * dtab[3 * s_ + 1]);
                    const unsigned kdb = f2bf(k * dtab[3 * s_ + 2]); if (i & 1) kp[i >> 1] |= kdb << 16; else kp[i >> 1] = kdb; }
                { const int s0 = 64 * sg + 8 * i8;
                  *(u32x4*)(kdT + (((size_t)unit * 16 + (dk >> 4)) * 4 + (s0 >> 5)) * 512 + ((((s0 & 31) >> 3) * 16 + (dk & 15)) * 8)) = (u32x4){kp[0], kp[1], kp[2], kp[3]}; }
#pragma unroll
                for (int i = 0; i < 8; ++i) { qc[i] = qn[i]; kc[i] = kn[i]; }
            }
#undef P12_LOAD
            __syncthreads();
#pragma unroll 1
            for (int L = w; L < 36; L += 8) { int nt = 0; while ((nt + 1) * (nt + 2) / 2 <= L) ++nt; const int mt = L - nt * (nt + 1) / 2;
                f32x4 a = (f32x4){0.f, 0.f, 0.f, 0.f};
#pragma unroll
                for (int ks = 0; ks < 8; ++ks) { const bf16x8 ka = *(const LAS bf16x8*)(ki_s + (16 * mt + fr) * 264 + 32 * ks + 8 * fq), qb = *(const LAS bf16x8*)(qd_s + (16 * nt + fr) * 264 + 32 * ks + 8 * fq);
                    a = __builtin_amdgcn_mfma_f32_16x16x32_bf16(ka, qb, a, 0, 0, 0); }
#pragma unroll
                for (int j = 0; j < 4; ++j) a[j] = (16 * mt + 4 * fq + j > 16 * nt + fr) ? 0.f : a[j] * 0.0625f;
                *(u32x2*)(att + ((size_t)unit * 8 + nt) * 4 * 512 + (mt >> 1) * 512 + ((((mt & 1) * 2 + (fq >> 1)) * 16 + fr) * 8) + (fq & 1) * 4) = (u32x2){cvt_pk_bf16(a[0], a[1]), cvt_pk_bf16(a[2], a[3])}; }
            if (w < 4) { const int nt = 2 * w, mt = 2 * w + 1;
                *(u32x2*)(att + ((size_t)unit * 8 + nt) * 4 * 512 + (mt >> 1) * 512 + ((((mt & 1) * 2 + (fq >> 1)) * 16 + fr) * 8) + (fq & 1) * 4) = (u32x2){0u, 0u}; }
#pragma unroll 1
            for (int j = w; j < 64; j += 8) { const int rt = j >> 3, kt = j & 7; const u32x4 qv = *(const LAS u32x4*)(qd_s + (16 * rt + fr) * 264 + 32 * kt + 8 * fq);
                *(u32x4*)(HC1 + (size_t)(t0 + 2 * j + (lane >> 5)) * LD1 + C1_K + h * 256 + (lane & 31) * 8) = qv; }
        }
        __syncthreads();
    }
    SEAM(12);

    if (IN(13)) recur_phase<128, 256, 32, true, LD1, C1_K, C1_V, 512, 64, 1, 1, 1, 2>(F, HC1, (const bf16_t*)(big + B_ATT1), (const bf16_t*)XNB, nullptr);
    SEAM(13);

    if (IN(14)) { PHASE_IDS;
        const float* gnw = inptr(I_RETGN);
        float gw32[32];
#pragma unroll
        for (int c = 0; c < 8; ++c) { const f32x4 w4 = *(const f32x4*)(gnw + 32 * lane + 4 * c); gw32[4 * c] = w4.x; gw32[4 * c + 1] = w4.y; gw32[4 * c + 2] = w4.z; gw32[4 * c + 3] = w4.w; }
        u32x4 co[4], cg[4], no[4], ng[4];
#define P14_LOAD(do_, dg_, t_) do { const bf16_t* row_ = HC1 + (size_t)(t_) * LD1; _Pragma("unroll") for (int c = 0; c < 4; ++c) { do_[c] = *(const u32x4*)(row_ + C1_V + 32 * lane + 8 * c); dg_[c] = *(const u32x4*)(row_ + C1_G + 32 * lane + 8 * c); } } while (0)
        if (gw < T) P14_LOAD(co, cg, gw);
        for (int t = gw; t < T; t += F.NGW) {
            const int tn = t + F.NGW;
            if (tn < T) P14_LOAD(no, ng, tn);
            float o[32]; float s = 0.f;
#pragma unroll
            for (int c = 0; c < 4; ++c) { float x[8]; unpack8(co[c], x);
#pragma unroll
                for (int e = 0; e < 8; ++e) { o[8 * c + e] = x[e]; s += x[e]; } }
            s += __shfl_xor(s, 1); s += __shfl_xor(s, 2); s += __shfl_xor(s, 4); s += __shfl_xor(s, 8);
            const float mu = s * (1.f / 512.f); float q = 0.f;
#pragma unroll
            for (int e = 0; e < 32; ++e) { o[e] -= mu; q += o[e] * o[e]; }
            q += __shfl_xor(q, 1); q += __shfl_xor(q, 2); q += __shfl_xor(q, 4); q += __shfl_xor(q, 8);
            const float rs = 1.f / sqrtf(q * (1.f / 512.f) + GN_EPS);
            u32x4* gp = (u32x4*)(HC1 + (size_t)t * LD1 + C1_G + 32 * lane);
#pragma unroll
            for (int c = 0; c < 4; ++c) { float g[8], r[8]; unpack8(cg[c], g);
#pragma unroll
                for (int e = 0; e < 8; ++e) r[e] = o[8 * c + e] * rs * gw32[8 * c + e] * g[e] * __builtin_amdgcn_rcpf(1.f + __expf(-g[e]));
                gp[c] = (u32x4){pk2(r[0], r[1]), pk2(r[2], r[3]), pk2(r[4], r[5]), pk2(r[6], r[7])}; }
#pragma unroll
            for (int c = 0; c < 4; ++c) { co[c] = no[c]; cg[c] = ng[c]; }
        }
#undef P14_LOAD
    }
    SEAM(14);

    if (IN(15)) { PHASE_IDS;
        pg8::DenseOrder S; S.init(T, D, F.G, (int)blockIdx.x); pg8::PlainMap MP; pg8::EpiResB<false> E{nullptr, R, R, D};
        pg8::gemm_phase(F.lds, HC1 + C1_G, LD1, (const bf16_t*)(F.ws + WS_WOUT1), MIX1, S, MP, E);
    }
    SEAM(15);

    constexpr int WED_IDN = (FFE / 64) * (D / 32), NWED = NEXP * WED_IDN, WED_Q = 8, WED_P16 = 6144;
#define WED_ITEM(it_) ([&](int it2) -> TItem { const int e = it2 / WED_IDN, r = it2 % WED_IDN; \
        return titem_ktile(inptr(I_WED) + (size_t)e * FFE * D, FFE, D, (bf16_t*)(big + B_WED) + (size_t)e * D * FFE, r); })(it_)
    if (IN(16)) { PHASE_IDS;
        LAS float* scr = (LAS float*)(F.lds + wave * 9216);
        LAS float* wrs = (LAS float*)(F.lds + 73728);
        LAS float* rowb = (LAS float*)(F.lds + 106496 + wave * 4096);
        { const float* wr_ = inptr(I_WROUTER); for (int i = tid; i < D * 8 / 4; i += NTHREADS) ((LAS f32x4*)wrs)[i] = ((const f32x4*)wr_)[i]; }
        LAS unsigned* mcnt = (LAS unsigned*)(F.lds + LDSCTL_OFF + 1024);
        if (tid < 32) mcnt[tid] = 0u;
        __syncthreads();
        constexpr int IGU = (D / 64) * (2 * FFE / 32), IDN = (FFE / 64) * (D / 32);
#define P16_ITEM(it_) ([&](int it2) -> TItem { if (it2 >= NEXP * IGU) return WED_ITEM(it2 - NEXP * IGU); const int e = it2 / IGU, r = it2 % IGU; \
            return titem_gateup(inptr(I_WEG) + (size_t)e * D * FFE, inptr(I_WEU) + (size_t)e * D * FFE, D, FFE, (bf16_t*)(big + B_WEGU) + (size_t)e * 2 * FFE * D, r); })(it_)
        constexpr int NITEMS = NEXP * IGU + WED_P16; (void)IDN;
        int* rowtok = (int*)(F.ws + WS_ROUTE + R_ROWTOK); float* rowgate = (float*)(F.ws + WS_ROUTE + R_ROWGATE);
        for (int i = gtid; i < 2 * MOE_ROWS; i += NT) { rowtok[i] = -1; rowgate[i] = 0.f; }
        f32x4* tokinfo = (f32x4*)(F.ws + WS_ROUTE + R_TOKINFO);
        f32x4 cur[4], nxt[4], wv16[4];
        norm_w_load(inptr(I_FN1), lane, wv16);
        if (gw < T) row_load(R + (size_t)gw * D, lane, cur);
        int it = gw;
        f32x4 tv[8]; TItem I;
#pragma unroll 1
        for (int m = gw; m < T || it < NITEMS; m += F.NGW) {
          const bool has = it < NITEMS;
          if (m < T) {
            const int mn = m + F.NGW;
            if (mn < T) row_load(R + (size_t)mn * D, lane, nxt);
            rmsnorm_finish(wv16, XN + (size_t)m * D, lane, cur); }
          if (has) { I = P16_ITEM(it); titem_load(I, lane, tv); }
          if (m < T) {
#pragma unroll
            for (int j = 0; j < 4; ++j) *(LAS f32x4*)(rowb + 256 * j + 4 * lane) = cur[j];
            float a[8];
#pragma unroll
            for (int r = 0; r < 8; ++r) a[r] = 0.f;
#pragma unroll 4
            for (int i = 0; i < 16; ++i) { const int c = 64 * i + lane; const float xv = rowb[c]; const f32x4 w0 = *(const LAS f32x4*)(wrs + c * 8), w1 = *(const LAS f32x4*)(wrs + c * 8 + 4);
                a[0] += xv * w0.x; a[1] += xv * w0.y; a[2] += xv * w0.z; a[3] += xv * w0.w; a[4] += xv * w1.x; a[5] += xv * w1.y; a[6] += xv * w1.z; a[7] += xv * w1.w; }
            { float b4[4], b2[2], b1;
#pragma unroll
              for (int r = 0; r < 4; ++r) { const float keep = (lane & 1) ? a[2 * r + 1] : a[2 * r], give = (lane & 1) ? a[2 * r] : a[2 * r + 1]; b4[r] = keep + __shfl_xor(give, 1); }
#pragma unroll
              for (int r = 0; r < 2; ++r) { const float keep = (lane & 2) ? b4[2 * r + 1] : b4[2 * r], give = (lane & 2) ? b4[2 * r] : b4[2 * r + 1]; b2[r] = keep + __shfl_xor(give, 2); }
              { const float keep = (lane & 4) ? b2[1] : b2[0], give = (lane & 4) ? b2[0] : b2[1]; b1 = keep + __shfl_xor(give, 4); }
              b1 += __shfl_xor(b1, 8); b1 += __shfl_xor(b1, 16); b1 += __shfl_xor(b1, 32);
#pragma unroll
              for (int r = 0; r < 8; ++r) a[r] = __shfl(b1, r); }
            int e0 = 0; float l0 = a[0];
#pragma unroll
            for (int r = 1; r < 8; ++r) if (a[r] > l0) { l0 = a[r]; e0 = r; }
            int e1 = -1; float l1 = -3.4e38f;
#pragma unroll
            for (int r = 0; r < 8; ++r) if (r != e0 && a[r] > l1) { l1 = a[r]; e1 = r; }
            const float g0 = 1.f / (1.f + __expf(l1 - l0));
            if (lane == 0) { const unsigned r0 = __hip_atomic_fetch_add(mcnt + e0, 1u, __ATOMIC_RELAXED, __HIP_MEMORY_SCOPE_WORKGROUP);
                const unsigned r1 = __hip_atomic_fetch_add(mcnt + 8 + e1, 1u, __ATOMIC_RELAXED, __HIP_MEMORY_SCOPE_WORKGROUP);
                tokinfo[m] = (f32x4){__int_as_float(e0 | (e1 << 4)), __uint_as_float(r0), __uint_as_float(r1), g0}; }
#pragma unroll
            for (int j = 0; j < 4; ++j) cur[j] = nxt[j]; }
          if (has) { titem_finish(I, scr, lane, tv); it += F.NGW; }
        }
#undef P16_ITEM
        asm volatile("s_waitcnt vmcnt(0)" ::: "memory");
        __syncthreads();
        if (tid < 16) mcnt[16 + tid] = __hip_atomic_fetch_add((unsigned*)(F.ctl + CW_MOE + 64 * tid), mcnt[tid], __ATOMIC_RELAXED, __HIP_MEMORY_SCOPE_AGENT);
        __syncthreads();
        for (int r = tid; r < (T + F.NGW - 1) / F.NGW * NWAVES; r += NTHREADS) { const int m = (int)blockIdx.x * NWAVES + (r % NWAVES) + F.NGW * (r / NWAVES);
            if (m < T) { f32x4 ti = tokinfo[m]; const int ee = __float_as_int(ti.x); ti.y = __uint_as_float(__float_as_uint(ti.y) + mcnt[16 + (ee & 15)]); ti.z = __uint_as_float(__float_as_uint(ti.z) + mcnt[24 + (ee >> 4)]); tokinfo[m] = ti; } }
    }
    SEAM(16);

    if (IN(17)) { PHASE_IDS;
        const f32x4* tokinfo = (const f32x4*)(F.ws + WS_ROUTE + R_TOKINFO);
        int* rowtok = (int*)(F.ws + WS_ROUTE + R_ROWTOK); float* rowgate = (float*)(F.ws + WS_ROUTE + R_ROWGATE);
        int* blkexp = (int*)(F.ws + WS_ROUTE + R_BLKEXP); int* nblk = (int*)(F.ws + WS_ROUTE + R_NBLK);
        LAS int* pst = (LAS int*)F.lds;
        if (tid < 2) { int ps = 0, nb = 0;
            for (int e = 0; e < 8; ++e) { pst[tid * 8 + e] = ps; const int c = (int)__hip_atomic_load((unsigned*)(F.ctl + CW_MOE + 64 * (tid * 8 + e)), __ATOMIC_RELAXED, __HIP_MEMORY_SCOPE_AGENT), bl = (c + 255) >> 8;
                if (blockIdx.x == 0) for (int j = 0; j < bl; ++j) blkexp[tid * MOE_BLKS + nb + j] = e;
                nb += bl; ps += bl * 256; }
            if (blockIdx.x == 0) nblk[tid] = nb; }
        __syncthreads();
        for (int tok = gtid; tok < T; tok += NT) { const f32x4 ti = tokinfo[tok]; const int ee = __float_as_int(ti.x), e0 = ee & 15, e1 = ee >> 4;
            const int r0 = pst[e0] + (int)__float_as_uint(ti.y), r1 = pst[8 + e1] + (int)__float_as_uint(ti.z);
            rowtok[r0] = tok; rowgate[r0] = ti.w; rowtok[MOE_ROWS + r1] = tok; rowgate[MOE_ROWS + r1] = 1.f - ti.w; }
        __syncthreads();
    }
    SEAM(17);

#pragma unroll
    for (int slot = 0; slot < 2; ++slot) {
        if (IN(18 + 2 * slot)) { PHASE_IDS;
            const int* rowtok = (const int*)(F.ws + WS_ROUTE + R_ROWTOK) + slot * MOE_ROWS; const int* blkexp = (const int*)(F.ws + WS_ROUTE + R_BLKEXP) + slot * MOE_BLKS;
            const int nb = ((const int*)(F.ws + WS_ROUTE + R_NBLK))[slot];
            MoeOrder S; S.init(nb, 2 * FFE / 256, F.G, (int)blockIdx.x); pg8::MoeMap MP{rowtok, blkexp, 2 * FFE, 256, 0u, 0}; pg8::EpiSwiGLU E{(bf16_t*)(big + B_HMOE), FFE};
            pg8::gemm_phase(F.lds, XN, D, (const bf16_t*)(big + B_WEGU), D, S, MP, E);
            if (slot == 1) { const int nb0 = ((const int*)(F.ws + WS_ROUTE + R_NBLK))[0];
                if (nb0 > 128) {
                    const int rem = (nb * (2 * FFE / 256)) % F.G, nidle = rem ? F.G - rem : F.G, me = rem ? (int)blockIdx.x - rem : (int)blockIdx.x;
                    if (me >= 0) ovf_reduce_b<false>((const float*)(F.ws + WS_WIN0), (nb0 - 128) * 4, (const int*)(F.ws + WS_ROUTE + R_ROWTOK), (const float*)(F.ws + WS_ROUTE + R_ROWGATE), R, F.out, me * NTHREADS + tid, nidle * NTHREADS); } }
            if (slot == 0) {
                const int rem = (nb * (2 * FFE / 256)) % F.G, nidle = rem ? F.G - rem : 0, me = (int)blockIdx.x - rem, NW = nidle * NWAVES;
                const int covered = WED_P16 + (NW * WED_Q < NWED - WED_P16 ? NW * WED_Q : NWED - WED_P16);
                if (rem && me >= 0) { LAS float* scr = (LAS float*)(F.lds + wave * 9216); const int wi = me * NWAVES + wave;
                    f32x4 ta[8], tb[8]; TItem Ia, Ib; int it = WED_P16 + wi;
                    if (it < covered) { Ia = WED_ITEM(it); titem_load(Ia, lane, ta); }
#pragma unroll 1
                    for (; it < covered; it += 2 * NW) {
                        const bool hb = it + NW < covered;
                        if (hb) { Ib = WED_ITEM(it + NW); titem_load(Ib, lane, tb); }
                        titem_finish(Ia, scr, lane, ta);
                        if (it + 2 * NW < covered) { Ia = WED_ITEM(it + 2 * NW); titem_load(Ia, lane, ta); }
                        if (hb) titem_finish(Ib, scr, lane, tb); } }
                { LAS float* scr = (LAS float*)(F.lds + wave * 9216);
                  for (int it = covered + gw; it < NWED; it += F.NGW) { const TItem I = WED_ITEM(it); f32x4 tv[8]; titem_load(I, lane, tv); titem_finish(I, scr, lane, tv); } } }
        }
        SEAM(18 + 2 * slot);
        if (IN(19 + 2 * slot)) { PHASE_IDS;
            const int* rowtok = (const int*)(F.ws + WS_ROUTE + R_ROWTOK) + slot * MOE_ROWS; const float* rowgate = (const float*)(F.ws + WS_ROUTE + R_ROWGATE) + slot * MOE_ROWS;
            const int* blkexp = (const int*)(F.ws + WS_ROUTE + R_BLKEXP) + slot * MOE_BLKS; const int nb = ((const int*)(F.ws + WS_ROUTE + R_NBLK))[slot];
            const int nmain = nb < 128 ? nb : 128;
            { MoeOrder S; S.init(nmain, D / 256, F.G, (int)blockIdx.x); pg8::MoeMap MP{nullptr, blkexp, (FFE / 64) * D, (FFE / 64) * 256, 0u, 0};
              if (slot == 0) { pg8::EpiMoeDownB<false> E{R, F.out, rowtok, rowgate}; pg8::gemm_phase(F.lds, (const bf16_t*)(big + B_HMOE), 64, (const bf16_t*)(big + B_WED), FFE, S, MP, E, 64, (size_t)256 * 128, (size_t)D * 128); }
              else { pg8::EpiMoeDownB<true> E{R, F.out, rowtok, rowgate}; pg8::gemm_phase(F.lds, (const bf16_t*)(big + B_HMOE), 64, (const bf16_t*)(big + B_WED), FFE, S, MP, E, 64, (size_t)256 * 128, (size_t)D * 128); } }
            if (nb > 128) { const int nov = (nb - 128) * (D / 256), nks = ovf_nks(nov), ovk = FFE / nks;
              OvfOrder S{nov, F.G, (int)blockIdx.x, nks}; pg8::MoeMap MP{nullptr, blkexp, (FFE / 64) * D, (FFE / 64) * 256, (unsigned)(ovk / 64) * 256u * 128u, (size_t)(ovk / 64) * D * 128}; pg8::EpiPartial E{(float*)(F.ws + WS_WIN0), nks};
              pg8::gemm_phase(F.lds, (const bf16_t*)(big + B_HMOE), 64, (const bf16_t*)(big + B_WED), ovk, S, MP, E, 64, (size_t)256 * 128, (size_t)D * 128); }
        }
        SEAM(19 + 2 * slot);
    }
#undef WED_ITEM
    if (IN(22)) { PHASE_IDS; const int nb1 = ((const int*)(F.ws + WS_ROUTE + R_NBLK))[1];
        if (nb1 > 128) ovf_reduce_b<true>((const float*)(F.ws + WS_WIN0), (nb1 - 128) * 4, (const int*)(F.ws + WS_ROUTE + R_ROWTOK) + MOE_ROWS, (const float*)(F.ws + WS_ROUTE + R_ROWGATE) + MOE_ROWS, R, F.out, gtid, NT); }
    if ((PROBE_M1 | PROBE_M2) && blockIdx.x == 0 && threadIdx.x == 0) {
        STAMP(23);
        volatile LAS unsigned long long* ts = (volatile LAS unsigned long long*)(F.lds + LDSCTL_OFF + 512);
        unsigned long long t1 = 0, t2 = 0;
        for (int k = 0; k < 23; ++k) { const unsigned long long dt = ts[k + 1] - ts[k]; if ((PROBE_M1 >> k) & 1) t1 += dt; if ((PROBE_M2 >> k) & 1) t2 += dt; }
        const unsigned long long wait = 16ull * t1 + 0ull * t2, t0 = __builtin_amdgcn_s_memrealtime();
        while (__builtin_amdgcn_s_memrealtime() - t0 < wait) __builtin_amdgcn_s_sleep(8);
    }
#undef IN
#undef SEAM
}

#ifndef N_LAUNCH_MODE
#define N_LAUNCH_MODE 1
#endif
extern "C" void kernel_launch(void* const* d_in, const int* in_sizes, int n_in, void* d_out, int out_size, void* d_ws, size_t ws_size, hipStream_t stream) {
    static int grid = 0;
    if (grid == 0) {
        if (n_in != 22 || out_size != T * D || ws_size < WS_END) { fprintf(stderr, "kernel_launch: unexpected shapes (n_in %d out %d ws %zu need %zu)\n", n_in, out_size, ws_size, (size_t)WS_END); grid = -1; return; }
        int dev = 0, cus = 0, per_cu = 0;
        if (hipGetDevice(&dev) != hipSuccess || hipDeviceGetAttribute(&cus, hipDeviceAttributeMultiprocessorCount, dev) != hipSuccess) { grid = -1; return; }
        if (hipFuncSetAttribute((const void*)fwd_kernel, hipFuncAttributeMaxDynamicSharedMemorySize, LDS_BYTES) != hipSuccess) { fprintf(stderr, "kernel_launch: hipFuncSetAttribute failed\n"); grid = -1; return; }
        if (hipOccupancyMaxActiveBlocksPerMultiprocessor(&per_cu, (const void*)fwd_kernel, NTHREADS, LDS_BYTES) != hipSuccess || per_cu < 1) { fprintf(stderr, "kernel_launch: occupancy query says %d\n", per_cu); (void)hipGetLastError(); grid = -1; return; }
        grid = cus & ~3;
    }
    if (grid < 0) return;
    (void)hipMemsetAsync((char*)d_ws + WS_CTL, 0, CTL_ZERO_BYTES, stream);
    Args a{};
    for (int i = 0; i < 22; ++i) a.in[i] = (const float*)d_in[i];
    a.out = (float*)d_out; a.ws = (unsigned char*)d_ws;
#if N_LAUNCH_MODE == 1
    a.ph_lo = 0; a.ph_hi = NPHASE;
    hipLaunchKernelGGL(fwd_kernel, dim3(grid), dim3(NTHREADS), LDS_BYTES, stream, a);
#else
    for (int p = 0; p < NPHASE; ++p) { a.ph_lo = p; a.ph_hi = p + 1; hipLaunchKernelGGL(fwd_kernel, dim3(grid), dim3(NTHREADS), LDS_BYTES, stream, a); }
#endif
}
```
